# Optimizing an MI355X kernel written in HIP

```python
import jax, jax.numpy as jnp
from jax import lax
import numpy as np

D_MODEL = 1024
BATCH = 16
SEQ = 2048
DEPTH = 1

HEAD_DIM = 64
MIX_TOTAL_HEADS = D_MODEL // HEAD_DIM
N_ATTN_HEADS = MIX_TOTAL_HEADS // 2
N_MIX_GROUPS = MIX_TOTAL_HEADS - N_ATTN_HEADS
GQA_GROUP = 4
N_KV_HEADS = N_ATTN_HEADS // GQA_GROUP
ATTN_WIDTH = N_ATTN_HEADS * HEAD_DIM
MIX_WIDTH = N_MIX_GROUPS * HEAD_DIM
KV_WIDTH = N_KV_HEADS * HEAD_DIM
N_GATES = 3
IN_COLS = ATTN_WIDTH + 6 * KV_WIDTH + N_GATES * N_ATTN_HEADS + 2 * MIX_WIDTH
CMP_BLOCK = 32
CMP_STRIDE = 16
CMP_HIDDEN = 256
SEL_BLOCK = 64
SEL_TOPN = 16
SEL_Q_BLOCK = 64
WINDOW = 512
Q_BLOCK = 128
CHUNK = 128
D_FF = 4 * D_MODEL
ROPE_THETA = 10000.0
EPS = 1e-6
FORCE_SCORE = 1e9

kernel_name = "hymba_nsa_gmlp_hybrid_block"


def rms_norm(x, g):
    xf = x.astype(jnp.float32)
    y = xf * lax.rsqrt(jnp.mean(xf * xf, axis=-1, keepdims=True) + EPS)
    return (y * g.astype(jnp.float32)).astype(x.dtype)


def rope(x, pos):
    half = x.shape[-1] // 2
    inv = ROPE_THETA ** (-jnp.arange(half, dtype=jnp.float32) / half)
    ang = pos.astype(jnp.float32)[:, None] * inv[None, :]
    cos = jnp.cos(ang)[:, None, :]
    sin = jnp.sin(ang)[:, None, :]
    xf = x.astype(jnp.float32)
    x1, x2 = xf[..., :half], xf[..., half:]
    return jnp.concatenate([x1 * cos - x2 * sin, x2 * cos + x1 * sin], axis=-1).astype(x.dtype)


def masked_softmax(s, mask):
    s = jnp.where(mask, s.astype(jnp.float32), -jnp.inf)
    m = jnp.max(s, axis=-1, keepdims=True)
    m = jnp.where(jnp.isfinite(m), m, 0.0)
    p = jnp.exp(s - m)
    return p / jnp.maximum(jnp.sum(p, axis=-1, keepdims=True), 1e-20)


def compress_blocks(t, pe, w1, w2):
    B, S, Hkv, D = t.shape
    n_cmp = (S - CMP_BLOCK) // CMP_STRIDE + 1
    idx = jnp.arange(n_cmp)[:, None] * CMP_STRIDE + jnp.arange(CMP_BLOCK)[None, :]
    blk = t[:, idx] + pe[None, None, :, None, :]
    blk = jnp.swapaxes(blk, 2, 3).reshape(B, n_cmp, Hkv, CMP_BLOCK * D)
    return jax.nn.gelu(blk @ w1) @ w2


def setup_inputs(seed: int = 0) -> dict:
    key = jax.random.key(seed)
    ks = jax.random.split(key, 16)
    L = DEPTH
    nrm = jax.random.normal
    x = nrm(ks[0], (BATCH, SEQ, D_MODEL), jnp.float32)
    g_mix_norm = 1.0 + 0.02 * nrm(ks[1], (L, D_MODEL), jnp.float32)
    w_in = nrm(ks[2], (L, D_MODEL, IN_COLS), jnp.float32) * D_MODEL ** -0.5
    g_q = 1.0 + 0.02 * nrm(ks[3], (L, HEAD_DIM), jnp.float32)
    g_k = 1.0 + 0.02 * nrm(ks[4], (L, 3, HEAD_DIM), jnp.float32)
    cmp_pe = 0.5 * nrm(ks[5], (L, 2, CMP_BLOCK, HEAD_DIM), jnp.float32)
    cmp_w1 = nrm(ks[6], (L, 2, CMP_BLOCK * HEAD_DIM, CMP_HIDDEN), jnp.float32) * (CMP_BLOCK * HEAD_DIM) ** -0.5
    cmp_w2 = nrm(ks[7], (L, 2, CMP_HIDDEN, HEAD_DIM), jnp.float32) * CMP_HIDDEN ** -0.5
    g_sgu = 1.0 + 0.02 * nrm(ks[8], (L, N_MIX_GROUPS, HEAD_DIM), jnp.float32)
    sp_w = nrm(ks[9], (L, N_MIX_GROUPS, CHUNK, CHUNK), jnp.float32) * CHUNK ** -0.5
    sp_b = 1.0 + 0.1 * nrm(ks[10], (L, N_MIX_GROUPS, CHUNK), jnp.float32)
    g_out = 1.0 + 0.02 * nrm(ks[11], (L, D_MODEL), jnp.float32)
    w_out = nrm(ks[12], (L, D_MODEL, D_MODEL), jnp.float32) * D_MODEL ** -0.5
    g_ffn_norm = 1.0 + 0.02 * nrm(ks[13], (L, D_MODEL), jnp.float32)
    w_ff1 = nrm(ks[14], (L, D_MODEL, D_FF), jnp.float32) * D_MODEL ** -0.5
    w_ff2 = nrm(ks[15], (L, D_FF, D_MODEL), jnp.float32) * D_FF ** -0.5
    return {"x": x, "g_mix_norm": g_mix_norm, "w_in": w_in, "g_q": g_q, "g_k": g_k,
            "cmp_pe": cmp_pe, "cmp_w1": cmp_w1, "cmp_w2": cmp_w2, "g_sgu": g_sgu,
            "sp_w": sp_w, "sp_b": sp_b, "g_out": g_out, "w_out": w_out,
            "g_ffn_norm": g_ffn_norm, "w_ff1": w_ff1, "w_ff2": w_ff2}


def reference(x, g_mix_norm, w_in, g_q, g_k, cmp_pe, cmp_w1, cmp_w2, g_sgu,
              sp_w, sp_b, g_out, w_out, g_ffn_norm, w_ff1, w_ff2):
    B, S, _ = x.shape
    Hkv, G, D = N_KV_HEADS, GQA_GROUP, HEAD_DIM
    f32 = jnp.float32
    pos = jnp.arange(S, dtype=jnp.int32)
    scale = HEAD_DIM ** -0.5
    sizes = [ATTN_WIDTH] + [KV_WIDTH] * 6 + [N_GATES * N_ATTN_HEADS, MIX_WIDTH]
    split_pts = [int(v) for v in np.cumsum(sizes)]

    for l in range(DEPTH):
        h = rms_norm(x, g_mix_norm[l])
        z = h @ w_in[l]
        q, kc, vc, ksl, vsl, kwn, vwn, gate_logits, zu, zv = jnp.split(z, split_pts, axis=-1)

        q = rms_norm(q.reshape(B, S, N_ATTN_HEADS, D), g_q[l])
        q_rot = rope(q, pos).reshape(B, S, Hkv, G, D)
        q = q.reshape(B, S, Hkv, G, D)
        kc = kc.reshape(B, S, Hkv, D)
        vc = vc.reshape(B, S, Hkv, D)
        ksl = rope(rms_norm(ksl.reshape(B, S, Hkv, D), g_k[l, 1]), pos)
        vsl = vsl.reshape(B, S, Hkv, D)
        kwn = rope(rms_norm(kwn.reshape(B, S, Hkv, D), g_k[l, 2]), pos)
        vwn = vwn.reshape(B, S, Hkv, D)

        kcmp = rms_norm(compress_blocks(kc, cmp_pe[l, 0], cmp_w1[l, 0], cmp_w2[l, 0]), g_k[l, 0])
        vcmp = compress_blocks(vc, cmp_pe[l, 1], cmp_w1[l, 1], cmp_w2[l, 1])
        n_cmp = kcmp.shape[1]
        cmp_start = jnp.arange(n_cmp, dtype=jnp.int32) * CMP_STRIDE
        cmp_end = cmp_start + CMP_BLOCK - 1
        s_c = jnp.einsum('bshgd,bnhd->bhgsn', q, kcmp).astype(f32) * scale
        p_c = masked_softmax(s_c, cmp_end[None, :] <= pos[:, None])
        o_cmp = jnp.einsum('bhgsn,bnhd->bshgd', p_c.astype(vcmp.dtype), vcmp)

        n_sel = S // SEL_BLOCK
        top_n = min(SEL_TOPN, n_sel)
        sel_start = jnp.arange(n_sel, dtype=jnp.int32) * SEL_BLOCK
        overlap = jnp.clip(jnp.minimum(cmp_start[:, None] + CMP_BLOCK, sel_start[None, :] + SEL_BLOCK)
                           - jnp.maximum(cmp_start[:, None], sel_start[None, :]), 0).astype(f32) / CMP_BLOCK
        imp = jnp.einsum('bhgsn,nj->bhsj', p_c, overlap)
        cur = pos // SEL_BLOCK
        jj = jnp.arange(n_sel, dtype=jnp.int32)
        forced = (jj[None, :] == 0) | (jj[None, :] == cur[:, None]) | (jj[None, :] == cur[:, None] - 1)
        eligible = sel_start[None, :] <= pos[:, None]
        imp = jnp.where(forced, FORCE_SCORE, jnp.where(eligible, imp, -jnp.inf))
        top_val, top_idx = lax.top_k(imp, top_n)
        top_valid = jnp.isfinite(top_val)

        kb = ksl.reshape(B, n_sel, SEL_BLOCK, Hkv, D).transpose(0, 3, 1, 2, 4)
        vb = vsl.reshape(B, n_sel, SEL_BLOCK, Hkv, D).transpose(0, 3, 1, 2, 4)
        nqs = S // SEL_Q_BLOCK
        q_ch = q_rot.reshape(B, nqs, SEL_Q_BLOCK, Hkv, G, D).transpose(1, 0, 3, 4, 2, 5)
        idx_ch = top_idx.reshape(B, Hkv, nqs, SEL_Q_BLOCK, top_n).transpose(2, 0, 1, 3, 4)
        val_ch = top_valid.reshape(B, Hkv, nqs, SEL_Q_BLOCK, top_n).transpose(2, 0, 1, 3, 4)
        pos_ch = pos.reshape(nqs, SEL_Q_BLOCK)
        gather = jax.vmap(jax.vmap(lambda blocks, ix: blocks[ix]))

        def sel_block(args):
            qc, ic, vmask, pc = args
            kg = gather(kb, ic)
            vg = gather(vb, ic)
            s = jnp.einsum('bhgqd,bhqnkd->bhgqnk', qc, kg).astype(f32) * scale
            kpos = ic[..., None] * SEL_BLOCK + jnp.arange(SEL_BLOCK, dtype=jnp.int32)
            m = vmask[..., None] & (kpos <= pc[:, None, None])
            p = masked_softmax(s.reshape(B, Hkv, G, SEL_Q_BLOCK, top_n * SEL_BLOCK),
                               m.reshape(B, Hkv, 1, SEL_Q_BLOCK, top_n * SEL_BLOCK))
            return jnp.einsum('bhgqm,bhqmd->bhgqd', p.astype(vg.dtype),
                              vg.reshape(B, Hkv, SEL_Q_BLOCK, top_n * SEL_BLOCK, D))

        o_sel = lax.map(sel_block, (q_ch, idx_ch, val_ch, pos_ch))
        o_sel = o_sel.transpose(1, 0, 4, 2, 3, 5).reshape(B, S, Hkv, G, D)

        nqw = S // Q_BLOCK
        span = WINDOW + Q_BLOCK
        kpad = jnp.pad(kwn, ((0, 0), (WINDOW, 0), (0, 0), (0, 0)))
        vpad = jnp.pad(vwn, ((0, 0), (WINDOW, 0), (0, 0), (0, 0)))
        widx = jnp.arange(nqw, dtype=jnp.int32)[:, None] * Q_BLOCK + jnp.arange(span, dtype=jnp.int32)[None, :]
        kwin = kpad[:, widx]
        vwin = vpad[:, widx]
        kpos_w = (widx - WINDOW)[:, None, :]
        qpos_w = pos.reshape(nqw, Q_BLOCK)[:, :, None]
        mw = (kpos_w >= 0) & (kpos_w <= qpos_w) & (qpos_w - kpos_w < WINDOW)
        qw = q_rot.reshape(B, nqw, Q_BLOCK, Hkv, G, D)
        s_w = jnp.einsum('bcqhgd,bckhd->bhgcqk', qw, kwin).astype(f32) * scale
        p_w = masked_softmax(s_w, mw)
        o_win = jnp.einsum('bhgcqk,bckhd->bcqhgd', p_w.astype(vwin.dtype), vwin).reshape(B, S, Hkv, G, D)

        gates = jax.nn.sigmoid(gate_logits.astype(f32)).reshape(B, S, Hkv, G, N_GATES).astype(x.dtype)
        o_attn = (gates[..., 0:1] * o_cmp + gates[..., 1:2] * o_sel
                  + gates[..., 2:3] * o_win).reshape(B, S, ATTN_WIDTH)

        zu = jax.nn.gelu(zu)
        zv = rms_norm(jax.nn.gelu(zv).reshape(B, S, N_MIX_GROUPS, HEAD_DIM), g_sgu[l])
        zv = zv.reshape(B, S // CHUNK, CHUNK, N_MIX_GROUPS, HEAD_DIM)
        w_s = sp_w[l] * jnp.tril(jnp.ones((CHUNK, CHUNK), sp_w.dtype))
        sv = jnp.einsum('gts,bcsgd->bctgd', w_s, zv) + sp_b[l].T[:, :, None]
        o_mix = zu * sv.reshape(B, S, MIX_WIDTH)

        o = jnp.concatenate([rms_norm(o_attn, g_out[l, :ATTN_WIDTH]),
                             rms_norm(o_mix, g_out[l, ATTN_WIDTH:])], axis=-1)
        x = x + o @ w_out[l]

        h = rms_norm(x, g_ffn_norm[l])
        x = x + jnp.square(jax.nn.relu(h @ w_ff1[l])) @ w_ff2[l]
    return x
```

```cpp
#include <hip/hip_runtime.h>
#include <hip/hip_cooperative_groups.h>
#include <cstdio>
#include <cstdint>
namespace cg = cooperative_groups;

#define LAS __attribute__((address_space(3)))
typedef unsigned short bf16_t;
typedef unsigned u32x4 __attribute__((ext_vector_type(4)));
typedef float f32x4 __attribute__((ext_vector_type(4)));

namespace pg8 {
#define PG8_LAS __attribute__((address_space(3)))
typedef short bf16x8 __attribute__((ext_vector_type(8)));
constexpr int BM = 256, BK = 64, HALF = 128, HTB = HALF * BK * 2, STAGE_BYTES = 8 * HTB, NXCD = 8, WGM = 4;
__host__ __device__ __forceinline__ int lds_byte(int r, int c) { const int st = (r >> 4) * 2 + (c >> 5), rr = r & 15, cc = c & 31, ob = rr * 64 + cc * 2; return st * 1024 + (ob ^ (((ob >> 9) & 1) << 5)); }
__host__ __device__ __forceinline__ void stage_rc(int b, int& R, int& C) { const int st = b / 1024, sb = b % 1024, swz = sb ^ (((sb >> 9) & 1) << 5); R = (st >> 1) * 16 + swz / 64; C = (st & 1) * 32 + (swz % 64) / 2; }
__host__ __device__ __forceinline__ int perm32(int rho) { const int n = rho >> 4, i = rho & 15; return 8 * (i >> 2) + 4 * n + (i & 3); }
struct Unit { int pm, pn, koff; };
struct Gemm { const bf16_t* A; const bf16_t* Bt; int M, N, K, lda, ldb; };
struct StaticOrder {
    int nM, nN, nwg, G, c;
    __host__ __device__ void init(int M, int N, int G_, int c_) { nM = M / BM; nN = N / BM; nwg = nM * nN; G = G_; c = c_; }
    __host__ __device__ bool next(int i, Unit& u) const {
        const long L = (long)i * G + c; if (L >= nwg) return false;
        int wgid = (int)L; { const int q = nwg / NXCD, r = nwg % NXCD, xcd = wgid % NXCD, off = wgid / NXCD; wgid = (xcd < r ? xcd * (q + 1) : r * (q + 1) + (xcd - r) * q) + off; }
        const int nig = WGM * nN, gid = wgid / nig, fm = gid * WGM, gsz = (nM - fm) < WGM ? (nM - fm) : WGM;
        u.pm = fm + ((wgid % nig) % gsz); u.pn = (wgid % nig) / gsz; u.koff = 0; return true;
    }
    __device__ __forceinline__ void a_ready(const Unit&) const {}
    __device__ __forceinline__ void done(const Unit&) const {}
};
struct CmpOrder {
    int G, c;
    __device__ bool next(int i, Unit& u) const { const long L = (long)i * G + c; if (L >= 256) return false; u.pm = (int)L & 31; u.pn = u.pm >> 4; u.koff = ((int)L >> 5) * 512; return true; }
    __device__ __forceinline__ void a_ready(const Unit&) const {}
    __device__ __forceinline__ void done(const Unit&) const {}
};
__device__ __forceinline__ unsigned cvt_pk_bf16(float lo, float hi) { unsigned r; asm volatile("v_cvt_pk_bf16_f32 %0, %1, %2" : "=v"(r) : "v"(lo), "v"(hi)); return r; }
template <class Epi, class Sched, bool ALIGN_EPI = false, bool SP2 = false>
__device__ __forceinline__ void gemm_phase(PG8_LAS unsigned char* lds, const Gemm g, const Sched& S, const Epi& E) {
    const int tid = threadIdx.x, wid = __builtin_amdgcn_readfirstlane(tid >> 6), lane = tid & 63, wr = wid >> 2, wc = wid & 3, fr = lane & 15, fq = lane >> 4;
    const int K = g.K, nt = K / BK, lda = g.lda, ldb = g.ldb;
    unsigned voffA[2], voffB[2];
#pragma unroll
    for (int i = 0; i < 2; ++i) { int R, C; stage_rc(tid * 16 + i * 8192, R, C); const int Rb = Epi::PERM ? ((R & ~31) + perm32(R & 31)) : R;
        voffA[i] = (unsigned)(R * lda + C) * 2u; voffB[i] = (unsigned)(Rb * ldb + C) * 2u; }
    const size_t kstep = (size_t)(BK * 2);
    const size_t hstepA = (size_t)HALF * lda * 2, hstepB = (size_t)HALF * ldb * 2;
    const size_t tstepA = 2 * hstepA, tstepB = 2 * hstepB;
    const unsigned ldsw = (unsigned)wid * 1024u;
    const int aoff = lds_byte(wr * 64 + fr, fq * 8), boff = lds_byte(wc * 32 + fr, fq * 8);
#define PG8_SA(b, h) (((b) * 2 + (h)) * HTB)
#define PG8_SB(b, h) ((4 + (b) * 2 + (h)) * HTB)
#define PG8_STAGE(bufoff, gbase, voff) do { _Pragma("unroll") for (int _i = 0; _i < 2; ++_i) \
        __builtin_amdgcn_global_load_lds((const unsigned*)((const char*)(gbase) + (voff)[_i]), (PG8_LAS unsigned*)(lds + (bufoff) + ldsw + _i * 8192), 16, 0, 0); } while (0)
#define PG8_LDA(dst, b, h) do { _Pragma("unroll") for (int m = 0; m < 4; ++m) _Pragma("unroll") for (int k = 0; k < 2; ++k) dst[m][k] = *(const PG8_LAS bf16x8*)(lds + PG8_SA(b, h) + aoff + m * 2048 + k * 1024); } while (0)
#define PG8_LDB(dst, b, h) do { _Pragma("unroll") for (int n = 0; n < 2; ++n) _Pragma("unroll") for (int k = 0; k < 2; ++k) dst[n][k] = *(const PG8_LAS bf16x8*)(lds + PG8_SB(b, h) + boff + n * 2048 + k * 1024); } while (0)
#define PG8_MMA(ai, bj, At, Bt) do { __builtin_amdgcn_s_setprio(1); _Pragma("unroll") for (int m = 0; m < 4; ++m) _Pragma("unroll") for (int n = 0; n < 2; ++n) _Pragma("unroll") for (int k = 0; k < 2; ++k) \
        acc[ai][bj][m][n] = __builtin_amdgcn_mfma_f32_16x16x32_bf16(Bt[n][k], At[m][k], acc[ai][bj][m][n], 0, 0, 0); __builtin_amdgcn_s_setprio(0); } while (0)
#define PG8_WAIT_V(n) asm volatile("s_waitcnt vmcnt(" #n ")" ::: "memory")
#define PG8_WAIT_L(n) asm volatile("s_waitcnt lgkmcnt(" #n ")" ::: "memory")
#define PG8_BAR __builtin_amdgcn_s_barrier()
#define PG8_SCHED __builtin_amdgcn_sched_barrier(0)
    Unit cur, nxt; int ui = 0;
    if (!S.next(0, cur)) return;
    f32x4 acc[2][2][4][2];
#pragma unroll
    for (int a = 0; a < 2; ++a)
#pragma unroll
        for (int b = 0; b < 2; ++b)
#pragma unroll
            for (int m = 0; m < 4; ++m)
#pragma unroll
                for (int n = 0; n < 2; ++n) acc[a][b][m][n] = (f32x4){0.f, 0.f, 0.f, 0.f};
    bf16x8 At[4][2], B0[2][2], B1[2][2];
    const char* cA = (const char*)g.A + (size_t)cur.pm * tstepA + cur.koff; const char* cB = (const char*)g.Bt + (size_t)cur.pn * tstepB + cur.koff;
    S.a_ready(cur);
    if constexpr (SP2) {
        PG8_STAGE(PG8_SB(0, 0), cB, voffB); PG8_STAGE(PG8_SB(0, 1), cB + hstepB, voffB); PG8_STAGE(PG8_SA(0, 0), cA, voffA); PG8_STAGE(PG8_SA(0, 1), cA + hstepA, voffA);
        if (wr == 1) PG8_BAR;
        PG8_WAIT_V(2); PG8_BAR;
        PG8_STAGE(PG8_SB(1, 0), cB + kstep, voffB); PG8_STAGE(PG8_SA(1, 0), cA + kstep, voffA); PG8_STAGE(PG8_SB(1, 1), cB + hstepB + kstep, voffB);
        PG8_WAIT_V(6); PG8_BAR;
    } else {
        PG8_STAGE(PG8_SB(0, 0), cB, voffB); PG8_STAGE(PG8_SA(0, 0), cA, voffA); PG8_STAGE(PG8_SB(0, 1), cB + hstepB, voffB); PG8_STAGE(PG8_SA(0, 1), cA + hstepA, voffA);
        if (wr == 1) PG8_BAR;
        PG8_WAIT_V(4); PG8_BAR;
        PG8_STAGE(PG8_SB(1, 0), cB + kstep, voffB); PG8_STAGE(PG8_SA(1, 0), cA + kstep, voffA); PG8_STAGE(PG8_SB(1, 1), cB + hstepB + kstep, voffB);
        PG8_WAIT_V(6); PG8_BAR;
    }
    for (;;) {
        const bool has_next = S.next(ui + 1, nxt);
        const char* nA = has_next ? (const char*)g.A + (size_t)nxt.pm * tstepA + nxt.koff : cA; const char* nB = has_next ? (const char*)g.Bt + (size_t)nxt.pn * tstepB + nxt.koff : cB;
        for (int t = 0; t < nt; t += 2) {
            const bool last = (t == nt - 2);
            const char* a1 = cA + (size_t)(t + 1) * kstep;
            const char* a2 = last ? nA : cA + (size_t)(t + 2) * kstep; const char* b2 = last ? nB : cB + (size_t)(t + 2) * kstep;
            const char* a3 = a2 + kstep; const char* b3 = b2 + kstep;
            if (last && has_next) S.a_ready(nxt);
            if constexpr (SP2) {
            PG8_LDB(B0, 0, 0); PG8_LDB(B1, 0, 1); PG8_SCHED; PG8_LDA(At, 0, 0); PG8_STAGE(PG8_SA(1, 1), a1 + hstepA, voffA);
            PG8_WAIT_V(8); PG8_WAIT_L(0); PG8_BAR; PG8_MMA(0, 0, At, B0); PG8_MMA(0, 1, At, B1); PG8_BAR; PG8_SCHED;
            PG8_LDA(At, 0, 1); PG8_STAGE(PG8_SB(0, 0), b2, voffB); PG8_STAGE(PG8_SB(0, 1), b2 + hstepB, voffB); PG8_STAGE(PG8_SA(0, 0), a2, voffA);
            PG8_WAIT_V(8); PG8_WAIT_L(0); PG8_BAR; PG8_MMA(1, 0, At, B0); PG8_MMA(1, 1, At, B1); PG8_BAR; PG8_SCHED;
            PG8_LDB(B0, 1, 0); PG8_LDB(B1, 1, 1); PG8_SCHED; PG8_LDA(At, 1, 0); PG8_STAGE(PG8_SA(0, 1), a2 + hstepA, voffA);
            PG8_WAIT_V(8); PG8_WAIT_L(0); PG8_BAR; PG8_MMA(0, 0, At, B0); PG8_MMA(0, 1, At, B1); PG8_BAR; PG8_SCHED;
            PG8_LDA(At, 1, 1); PG8_STAGE(PG8_SB(1, 0), b3, voffB); PG8_STAGE(PG8_SB(1, 1), b3 + hstepB, voffB); PG8_STAGE(PG8_SA(1, 0), a3, voffA);
            PG8_WAIT_V(8); PG8_WAIT_L(0); PG8_BAR; PG8_MMA(1, 0, At, B0); PG8_MMA(1, 1, At, B1); PG8_BAR; PG8_SCHED;
            } else {
            PG8_LDB(B0, 0, 0); PG8_SCHED; PG8_LDA(At, 0, 0); PG8_STAGE(PG8_SA(1, 1), a1 + hstepA, voffA);
            PG8_WAIT_L(8); PG8_BAR; PG8_WAIT_L(0); PG8_MMA(0, 0, At, B0); PG8_BAR; PG8_SCHED;
            PG8_LDB(B1, 0, 1); PG8_STAGE(PG8_SB(0, 0), b2, voffB);
            PG8_BAR; PG8_WAIT_L(0); PG8_MMA(0, 1, At, B1); PG8_BAR;
            PG8_LDA(At, 0, 1); PG8_STAGE(PG8_SA(0, 0), a2, voffA);
            PG8_BAR; PG8_WAIT_L(0); PG8_MMA(1, 0, At, B0); PG8_BAR; PG8_SCHED;
            PG8_STAGE(PG8_SB(0, 1), b2 + hstepB, voffB);
            PG8_WAIT_V(6); PG8_BAR; PG8_MMA(1, 1, At, B1); PG8_BAR;
            PG8_LDB(B0, 1, 0); PG8_SCHED; PG8_LDA(At, 1, 0); PG8_STAGE(PG8_SA(0, 1), a2 + hstepA, voffA);
            PG8_WAIT_L(8); PG8_BAR; PG8_WAIT_L(0); PG8_MMA(0, 0, At, B0); PG8_BAR; PG8_SCHED;
            PG8_LDB(B1, 1, 1); PG8_STAGE(PG8_SB(1, 0), b3, voffB);
            PG8_BAR; PG8_WAIT_L(0); PG8_MMA(0, 1, At, B1); PG8_BAR;
            PG8_LDA(At, 1, 1); PG8_STAGE(PG8_SA(1, 0), a3, voffA);
            PG8_BAR; PG8_WAIT_L(0); PG8_MMA(1, 0, At, B0); PG8_BAR; PG8_SCHED;
            PG8_STAGE(PG8_SB(1, 1), b3 + hstepB, voffB);
            PG8_WAIT_V(6); PG8_BAR; PG8_MMA(1, 1, At, B1); PG8_BAR;
            }
        }
        if constexpr (ALIGN_EPI) { if (wr == 0) PG8_BAR; }
        if constexpr (!Epi::AFTER_DRAIN) { E(acc, cur, wr, wc, fr, fq); S.done(cur); }
        if (!has_next) break;
#pragma unroll
        for (int a = 0; a < 2; ++a)
#pragma unroll
            for (int b = 0; b < 2; ++b)
#pragma unroll
                for (int m = 0; m < 4; ++m)
#pragma unroll
                    for (int n = 0; n < 2; ++n) acc[a][b][m][n] = (f32x4){0.f, 0.f, 0.f, 0.f};
        cur = nxt; cA = nA; cB = nB; ++ui;
        if constexpr (ALIGN_EPI) { if (wr == 1) PG8_BAR; }
    }
    PG8_WAIT_V(0);
    if constexpr (!ALIGN_EPI) { if (wr == 0) PG8_BAR; }
    PG8_BAR;
    if constexpr (Epi::AFTER_DRAIN) { E.fused(acc, cur, wr, wc, fr, fq, lds, wid, lane); S.done(cur); }
#undef PG8_SA
#undef PG8_SB
#undef PG8_STAGE
#undef PG8_LDA
#undef PG8_LDB
#undef PG8_MMA
#undef PG8_WAIT_V
#undef PG8_WAIT_L
#undef PG8_BAR
#undef PG8_SCHED
}
}

constexpr int T = 32768, S = 2048, DM = 1024, NIN = 2560, FF = 4096;
constexpr float EPS = 1e-6f;
constexpr float QSCALE = 0.125f * 1.4426950408889634f;
constexpr size_t MiB = 1u << 20;
constexpr size_t WS_WIN = 1 * MiB, WS_WOUT = 6 * MiB, WS_WFF1 = 8 * MiB, WS_WFF2 = 16 * MiB, WS_W1T = 24 * MiB;
constexpr size_t WS_WSP = 26 * MiB + 768 * 1024;
constexpr size_t WS_C1 = 26 * MiB, WS_ROPEC = 26 * MiB + 64 * 1024, WS_ROPES = 26 * MiB + 320 * 1024;
constexpr size_t WS_RINV1 = 27 * MiB, WS_SSQP = 27 * MiB + 512 * 1024, WS_GATES = 30 * MiB;
constexpr size_t WS_KCMP = 33 * MiB, WS_VCMPT = 33 * MiB + 512 * 1024, WS_HID = 34 * MiB, WS_X2B = 38 * MiB;
constexpr size_t WS_XB = 102 * MiB, WS_QN = 166 * MiB, WS_QR = 198 * MiB, WS_KC = 230 * MiB, WS_VC = 238 * MiB;
constexpr size_t WS_KSL = 246 * MiB, WS_VSLT = 254 * MiB, WS_KWN = 262 * MiB, WS_VWNT = 270 * MiB, WS_ZU = 278 * MiB, WS_ZVT = 310 * MiB, WS_O = 342 * MiB;
constexpr size_t WS_H = 102 * MiB, WS_END = 406 * MiB;
constexpr size_t WS_PART = WS_X2B;
constexpr size_t WS_C1P = 26 * MiB + 576 * 1024;
constexpr int LDS_BYTES = 147456;
constexpr int NWAVES = 8;

struct Args { const float* in[16]; float* out; unsigned char* ws; int ph_lo, ph_hi; };

__device__ __forceinline__ float bf2f(bf16_t h) { return __uint_as_float(((unsigned)h) << 16); }
__device__ __forceinline__ unsigned f2bf(float f) { unsigned u = __float_as_uint(f); return (u + 0x7fffu + ((u >> 16) & 1u)) >> 16; }
__device__ __forceinline__ unsigned pk2(float lo, float hi) { return pg8::cvt_pk_bf16(lo, hi); }
__device__ __forceinline__ float wave_sum(float v) {
#pragma unroll
    for (int o = 1; o < 64; o <<= 1) v += __shfl_xor(v, o);
    return v;
}
__device__ __forceinline__ float wave_max(float v) {
#pragma unroll
    for (int o = 1; o < 64; o <<= 1) v = fmaxf(v, __shfl_xor(v, o));
    return v;
}
__device__ __forceinline__ float gelu_tanh(float x) {
    const float u = 0.7978845608028654f * (x + 0.044715f * x * x * x);
    return x / (1.f + __expf(-2.f * u));
}
__device__ __forceinline__ void store8(bf16_t* p, const float* v) {
    u32x4 w; w.x = pk2(v[0], v[1]); w.y = pk2(v[2], v[3]); w.z = pk2(v[4], v[5]); w.w = pk2(v[6], v[7]);
    *(u32x4*)p = w;
}
__device__ __forceinline__ void load8(const bf16_t* p, float* v) {
    const u32x4 w = *(const u32x4*)p;
    v[0] = __uint_as_float(w.x << 16); v[1] = __uint_as_float(w.x & 0xffff0000u);
    v[2] = __uint_as_float(w.y << 16); v[3] = __uint_as_float(w.y & 0xffff0000u);
    v[4] = __uint_as_float(w.z << 16); v[5] = __uint_as_float(w.z & 0xffff0000u);
    v[6] = __uint_as_float(w.w << 16); v[7] = __uint_as_float(w.w & 0xffff0000u);
}
__device__ __forceinline__ float head_ssq(const float (&v)[16]) {
    float s = 0.f;
#pragma unroll
    for (int i = 0; i < 16; ++i) s += v[i] * v[i];
    s += __shfl_xor(s, 16); s += __shfl_xor(s, 32);
    return s;
}

struct EpiInProj {
    static constexpr bool PERM = true, AFTER_DRAIN = false;
    const float *rinv1, *g_q, *g_k, *g_sgu, *ropec, *ropes;
    bf16_t *qn, *qr, *kc, *vc, *ksl, *vslT, *kwn, *vwnT, *zu, *zvT; float* gates;
    __device__ __forceinline__ void operator()(const f32x4 (&acc)[2][2][4][2], const pg8::Unit& u, int wr, int wc, int fr, int fq) const {
        const int cs = u.pn * 4 + wc;
        if (cs >= 37) return;
        const int d0 = 8 * fq;
        float rsv[2][4];
#pragma unroll
        for (int ai = 0; ai < 2; ++ai)
#pragma unroll
            for (int m = 0; m < 4; ++m) rsv[ai][m] = rinv1[u.pm * 256 + ai * 128 + wr * 64 + m * 16 + fr];
#pragma unroll
        for (int ai = 0; ai < 2; ++ai)
#pragma unroll
            for (int m = 0; m < 4; ++m) {
                const int row = u.pm * 256 + ai * 128 + wr * 64 + m * 16 + fr;
                const float rs = rsv[ai][m];
                float v[16];
#pragma unroll
                for (int bj = 0; bj < 2; ++bj)
#pragma unroll
                    for (int n = 0; n < 2; ++n)
#pragma unroll
                        for (int e = 0; e < 4; ++e) v[bj * 8 + n * 4 + e] = acc[ai][bj][m][n][e] * rs;
                const int b = row >> 11, s = row & 2047;
                if (cs < 8 || cs == 12 || cs == 13 || cs == 16 || cs == 17) {
                    const float* gg = cs < 8 ? g_q : (cs < 14 ? g_k + 64 : g_k + 128);
                    const float rn = rsqrtf(head_ssq(v) * (1.f / 64.f) + EPS) * (cs < 8 ? QSCALE : 1.f);
                    float y[16];
#pragma unroll
                    for (int i = 0; i < 16; ++i) y[i] = v[i] * rn * gg[32 * (i >> 3) + d0 + (i & 7)];
                    float r1[8], r2[8];
#pragma unroll
                    for (int i = 0; i < 8; ++i) { int di = d0 + i; asm volatile("" : "+v"(di));
                        const float frev = __builtin_amdgcn_exp2f(-(float)di * (13.287712379549449f / 32.f)) * 0.15915494309189535f;
                        float xr = (float)s * frev; xr -= __builtin_rintf(xr);
                        const float c = __builtin_amdgcn_cosf(xr), sn = __builtin_amdgcn_sinf(xr); r1[i] = y[i] * c - y[8 + i] * sn; r2[i] = y[8 + i] * c + y[i] * sn; }
                    if (cs < 8) {
                        bf16_t* p = qn + (size_t)row * 512 + cs * 64 + d0; store8(p, y); store8(p + 32, y + 8);
                        bf16_t* p2 = qr + (size_t)row * 512 + cs * 64 + d0; store8(p2, r1); store8(p2 + 32, r2);
                    } else {
                        bf16_t* p = (cs < 14 ? ksl : kwn) + ((size_t)(b * 2 + (cs & 1)) * 2048 + s) * 64 + d0; store8(p, r1); store8(p + 32, r2);
                    }
                } else if (cs < 12) {
                    bf16_t* p = (cs < 10 ? kc : vc) + ((size_t)(b * 2 + (cs & 1)) * 2048 + s) * 64 + d0; store8(p, v); store8(p + 32, v + 8);
                } else if (cs < 20) {
                    bf16_t* p = (cs < 16 ? vslT : vwnT) + ((size_t)(b * 2 + (cs & 1)) * 32 + (s >> 6)) * 4096 + (s & 63);
#pragma unroll
                    for (int i = 0; i < 16; ++i) p[(32 * (i >> 3) + d0 + (i & 7)) * 64] = (bf16_t)f2bf(v[i]);
                } else if (cs < 28) {
                    float y[16];
#pragma unroll
                    for (int i = 0; i < 16; ++i) y[i] = gelu_tanh(v[i]);
                    bf16_t* p = zu + (size_t)row * 512 + (cs - 20) * 64 + d0; store8(p, y); store8(p + 32, y + 8);
                } else if (cs < 36) {
                    const int g = cs - 28;
                    float y[16];
#pragma unroll
                    for (int i = 0; i < 16; ++i) y[i] = gelu_tanh(v[i]);
                    const float rn = rsqrtf(head_ssq(y) * (1.f / 64.f) + EPS);
                    bf16_t* p = zvT + (((size_t)b * 16 + (s >> 7)) * 8 + g) * 8192 + (s & 127);
#pragma unroll
                    for (int i = 0; i < 16; ++i) { const int d = 32 * (i >> 3) + d0 + (i & 7); p[d * 128] = (bf16_t)f2bf(y[i] * rn * g_sgu[g * 64 + d]); }
                } else {
                    if (fq < 3) {
#pragma unroll
                        for (int i = 0; i < 8; ++i) gates[(size_t)row * 24 + d0 + i] = 1.f / (1.f + __expf(-v[i]));
                    }
                }
            }
    }
};

struct EpiPart {
    static constexpr bool PERM = true, AFTER_DRAIN = false;
    float* part;
    __device__ __forceinline__ void operator()(const f32x4 (&acc)[2][2][4][2], const pg8::Unit& u, int wr, int wc, int fr, int fq) const {
        float* base = part + (size_t)(u.koff >> 9) * 8192 * 256;
#pragma unroll
        for (int ai = 0; ai < 2; ++ai)
#pragma unroll
            for (int m = 0; m < 4; ++m) {
                const int row = u.pm * 256 + ai * 128 + wr * 64 + m * 16 + fr;
#pragma unroll
                for (int bj = 0; bj < 2; ++bj) {
                    float* p = base + (size_t)row * 256 + 128 * bj + 32 * wc + 8 * fq;
                    *(f32x4*)p = acc[ai][bj][m][0]; *(f32x4*)(p + 4) = acc[ai][bj][m][1];
                }
            }
    }
};

struct EpiWout {
    static constexpr bool PERM = true, AFTER_DRAIN = false;
    const bf16_t* xb; bf16_t* x2b; float* ssqp; LAS float* red;
    __device__ __forceinline__ void operator()(const f32x4 (&acc)[2][2][4][2], const pg8::Unit& u, int wr, int wc, int fr, int fq) const {
        u32x4 xr[2][4][2];
#pragma unroll
        for (int ai = 0; ai < 2; ++ai)
#pragma unroll
            for (int m = 0; m < 4; ++m)
#pragma unroll
                for (int bj = 0; bj < 2; ++bj)
                    xr[ai][m][bj] = *(const u32x4*)(xb + (size_t)(u.pm * 256 + ai * 128 + wr * 64 + m * 16 + fr) * DM + u.pn * 256 + 128 * bj + 32 * wc + 8 * fq);
        __builtin_amdgcn_sched_barrier(0);
#pragma unroll
        for (int ai = 0; ai < 2; ++ai)
#pragma unroll
            for (int m = 0; m < 4; ++m) {
                const int row = u.pm * 256 + ai * 128 + wr * 64 + m * 16 + fr;
                float ss = 0.f;
#pragma unroll
                for (int bj = 0; bj < 2; ++bj) {
                    const size_t off = (size_t)row * DM + u.pn * 256 + 128 * bj + 32 * wc + 8 * fq;
                    const u32x4 w = xr[ai][m][bj];
                    float y[8];
                    y[0] = __uint_as_float(w.x << 16) + acc[ai][bj][m][0].x; y[1] = __uint_as_float(w.x & 0xffff0000u) + acc[ai][bj][m][0].y;
                    y[2] = __uint_as_float(w.y << 16) + acc[ai][bj][m][0].z; y[3] = __uint_as_float(w.y & 0xffff0000u) + acc[ai][bj][m][0].w;
                    y[4] = __uint_as_float(w.z << 16) + acc[ai][bj][m][1].x; y[5] = __uint_as_float(w.z & 0xffff0000u) + acc[ai][bj][m][1].y;
                    y[6] = __uint_as_float(w.w << 16) + acc[ai][bj][m][1].z; y[7] = __uint_as_float(w.w & 0xffff0000u) + acc[ai][bj][m][1].w;
                    store8(x2b + off, y);
#pragma unroll
                    for (int i = 0; i < 8; ++i) ss += y[i] * y[i];
                }
                ss += __shfl_xor(ss, 16); ss += __shfl_xor(ss, 32);
                if (fq == 0) red[wc * 256 + (row & 255)] = ss;
            }
        __syncthreads();
        { const int tid = threadIdx.x;
          if (tid < 256) ssqp[(size_t)(u.pm * 256 + tid) * 4 + u.pn] = (red[tid] + red[256 + tid]) + (red[512 + tid] + red[768 + tid]); }
    }
};

struct EpiFF1 {
    static constexpr bool PERM = true, AFTER_DRAIN = false;
    const float* ssqp; bf16_t* H;
    __device__ __forceinline__ void operator()(const f32x4 (&acc)[2][2][4][2], const pg8::Unit& u, int wr, int wc, int fr, int fq) const {
        f32x4 sq[2][4];
#pragma unroll
        for (int ai = 0; ai < 2; ++ai)
#pragma unroll
            for (int m = 0; m < 4; ++m) sq[ai][m] = *(const f32x4*)(ssqp + (size_t)(u.pm * 256 + ai * 128 + wr * 64 + m * 16 + fr) * 4);
        __builtin_amdgcn_sched_barrier(0);
#pragma unroll
        for (int ai = 0; ai < 2; ++ai)
#pragma unroll
            for (int m = 0; m < 4; ++m) {
                const int row = u.pm * 256 + ai * 128 + wr * 64 + m * 16 + fr;
                const float tot = (sq[ai][m].x + sq[ai][m].y) + (sq[ai][m].z + sq[ai][m].w);
                const float rn = rsqrtf(tot * (1.f / 1024.f) + EPS);
#pragma unroll
                for (int bj = 0; bj < 2; ++bj) {
                    float y[8];
#pragma unroll
                    for (int n = 0; n < 2; ++n)
#pragma unroll
                        for (int e = 0; e < 4; ++e) { const float h = fmaxf(acc[ai][bj][m][n][e] * rn, 0.f); y[n * 4 + e] = h * h; }
                    store8(H + (size_t)row * FF + u.pn * 256 + 128 * bj + 32 * wc + 8 * fq, y);
                }
            }
    }
};

struct EpiFF2 {
    static constexpr bool PERM = true, AFTER_DRAIN = false;
    const bf16_t* x2b; float* out;
    __device__ __forceinline__ void operator()(const f32x4 (&acc)[2][2][4][2], const pg8::Unit& u, int wr, int wc, int fr, int fq) const {
        u32x4 xr[2][4][2];
#pragma unroll
        for (int ai = 0; ai < 2; ++ai)
#pragma unroll
            for (int m = 0; m < 4; ++m)
#pragma unroll
                for (int bj = 0; bj < 2; ++bj)
                    xr[ai][m][bj] = *(const u32x4*)(x2b + (size_t)(u.pm * 256 + ai * 128 + wr * 64 + m * 16 + fr) * DM + u.pn * 256 + 128 * bj + 32 * wc + 8 * fq);
        __builtin_amdgcn_sched_barrier(0);
#pragma unroll
        for (int ai = 0; ai < 2; ++ai)
#pragma unroll
            for (int m = 0; m < 4; ++m) {
                const int row = u.pm * 256 + ai * 128 + wr * 64 + m * 16 + fr;
#pragma unroll
                for (int bj = 0; bj < 2; ++bj) {
                    const size_t off = (size_t)row * DM + u.pn * 256 + 128 * bj + 32 * wc + 8 * fq;
                    const u32x4 w = xr[ai][m][bj];
                    f32x4 ya = acc[ai][bj][m][0], yb = acc[ai][bj][m][1];
                    ya.x += __uint_as_float(w.x << 16); ya.y += __uint_as_float(w.x & 0xffff0000u); ya.z += __uint_as_float(w.y << 16); ya.w += __uint_as_float(w.y & 0xffff0000u);
                    yb.x += __uint_as_float(w.z << 16); yb.y += __uint_as_float(w.z & 0xffff0000u); yb.z += __uint_as_float(w.w << 16); yb.w += __uint_as_float(w.w & 0xffff0000u);
                    *(f32x4*)(out + off) = ya; *(f32x4*)(out + off + 4) = yb;
                }
            }
    }
};

__device__ __forceinline__ int win_src_col(int nphys) {
    const int pn = nphys >> 8, Pp = nphys & 255, bj = Pp >> 7, wc = (Pp & 127) >> 5, r = Pp & 31;
    const int lc = (pn << 8) + 64 * wc + 32 * bj + r;
    if (lc < 1280) return lc;
    if (lc < 2304) return lc + 24;
    if (lc < 2328) return lc - 1024;
    return -1;
}
template <int MAP>
__device__ __forceinline__ void transpose_item(const float* W, int K, int N, bf16_t* WT, const float* gk, LAS float* scr, int item, int nblk, int lane) {
    const int kb = item / nblk, nb = item % nblk, k0 = 64 * kb, n0 = 32 * nb;
    const int src = MAP ? win_src_col(n0 + (lane & 31)) : n0 + (lane & 31);
    float tv[32];
#pragma unroll
    for (int i = 0; i < 32; ++i) { const int kk = 2 * i + (lane >> 5); tv[i] = (src >= 0) ? W[(size_t)(k0 + kk) * N + src] : 0.f; }
    if (gk) {
#pragma unroll
        for (int i = 0; i < 32; ++i) tv[i] *= gk[k0 + 2 * i + (lane >> 5)]; }
#pragma unroll
    for (int i = 0; i < 32; ++i) scr[(2 * i + (lane >> 5)) * 33 + (lane & 31)] = tv[i];
    asm volatile("s_waitcnt lgkmcnt(0)" ::: "memory");
    const int c = lane & 7;
#pragma unroll
    for (int j = 0; j < 4; ++j) { const int n = (lane >> 3) + 8 * j; const LAS float* s = scr + (8 * c) * 33 + n;
        u32x4 o; o.x = pk2(s[0 * 33], s[1 * 33]); o.y = pk2(s[2 * 33], s[3 * 33]); o.z = pk2(s[4 * 33], s[5 * 33]); o.w = pk2(s[6 * 33], s[7 * 33]);
        *(u32x4*)(WT + (size_t)(n0 + n) * K + k0 + 8 * c) = o; }
    asm volatile("s_waitcnt lgkmcnt(0)" ::: "memory");
}

__device__ __forceinline__ void phase0(const Args& a, LAS unsigned char* lds) {
    const int tid = threadIdx.x, lane = tid & 63, wave = tid >> 6;
    unsigned char* ws = a.ws;
    LAS float* scr = (LAS float*)(lds + wave * 16384);
    const int gw = blockIdx.x * NWAVES + wave, NGW = gridDim.x * NWAVES;
    constexpr int I_IN = 16 * 80, I_C = 32 * 8;
    constexpr int NITEMS = I_IN + 2 * I_C;
    for (int it = gw; it < NITEMS; it += NGW) {
        int r = it;
        if (r < I_IN) { transpose_item<1>(a.in[2], 1024, 2328, (bf16_t*)(ws + WS_WIN), a.in[1], scr, r, 80, lane); continue; } r -= I_IN;
        if (r < I_C) { transpose_item<0>(a.in[6], 2048, 256, (bf16_t*)(ws + WS_W1T), nullptr, scr, r, 8, lane); continue; } r -= I_C;
        transpose_item<0>(a.in[6] + (size_t)2048 * 256, 2048, 256, (bf16_t*)(ws + WS_W1T) + (size_t)256 * 2048, nullptr, scr, r, 8, lane);
    }
    {
        const float* x = a.in[0]; bf16_t* xb = (bf16_t*)(ws + WS_XB); float* rinv1 = (float*)(ws + WS_RINV1);
        for (int m = gw; m < T; m += 2 * NGW) {
            const int m2 = m + NGW;
            const bool has2 = m2 < T;
            const f32x4* xr = (const f32x4*)(x + (size_t)m * DM) + lane;
            const f32x4* xr2 = (const f32x4*)(x + (size_t)(has2 ? m2 : m) * DM) + lane;
            f32x4 v[4], u[4]; float s = 0.f, s2 = 0.f;
#pragma unroll
            for (int j = 0; j < 4; ++j) { v[j] = xr[64 * j]; u[j] = xr2[64 * j]; }
#pragma unroll
            for (int j = 0; j < 4; ++j) { s += (v[j].x * v[j].x + v[j].y * v[j].y) + (v[j].z * v[j].z + v[j].w * v[j].w); s2 += (u[j].x * u[j].x + u[j].y * u[j].y) + (u[j].z * u[j].z + u[j].w * u[j].w); }
            s = wave_sum(s); s2 = wave_sum(s2);
            if (lane == 0) { rinv1[m] = rsqrtf(s * (1.f / 1024.f) + EPS); if (has2) rinv1[m2] = rsqrtf(s2 * (1.f / 1024.f) + EPS); }
            unsigned long long* o8 = (unsigned long long*)(xb + (size_t)m * DM) + lane;
#pragma unroll
            for (int j = 0; j < 4; ++j) o8[64 * j] = (unsigned long long)pk2(v[j].x, v[j].y) | ((unsigned long long)pk2(v[j].z, v[j].w) << 32);
            if (has2) { unsigned long long* o82 = (unsigned long long*)(xb + (size_t)m2 * DM) + lane;
#pragma unroll
                for (int j = 0; j < 4; ++j) o82[64 * j] = (unsigned long long)pk2(u[j].x, u[j].y) | ((unsigned long long)pk2(u[j].z, u[j].w) << 32); }
        }
    }
    {
        bf16_t* Wsp = (bf16_t*)(ws + WS_WSP); const float* spw = a.in[9];
        for (int idx = blockIdx.x * 512 + tid; idx < 8 * 128 * 128; idx += gridDim.x * 512) { const int tq = (idx >> 7) & 127, sq = idx & 127; Wsp[idx] = (bf16_t)f2bf(sq <= tq ? spw[idx] : 0.f); }
    }
    {
        if ((gw & 3) == 0 && (gw >> 2) < 512) {
            const int item = gw >> 2, kv = item >> 8, cg4 = (item >> 6) & 3, kch = item & 63;
            const float* pe = a.in[5] + kv * 2048 + kch * 32; const float* w1 = a.in[6] + ((size_t)kv * 2048 + kch * 32) * 256 + cg4 * 64 + lane;
            float wv[32];
#pragma unroll
            for (int k = 0; k < 32; ++k) wv[k] = w1[(size_t)k * 256];
            float acc = 0.f;
#pragma unroll
            for (int k = 0; k < 32; ++k) acc += pe[k] * wv[k];
            ((float*)(ws + WS_C1P))[kch * 512 + kv * 256 + cg4 * 64 + lane] = acc;
        }
    }
}

__device__ __forceinline__ void phase3(const Args& a, LAS unsigned char* lds) {
    const int tid = threadIdx.x, lane = tid & 63, wave = tid >> 6;
    unsigned char* ws = a.ws;
    const float* part = (const float*)(ws + WS_PART); const float* c1p = (const float*)(ws + WS_C1P);
    bf16_t* kcmp = (bf16_t*)(ws + WS_KCMP); bf16_t* vcmpT = (bf16_t*)(ws + WS_VCMPT);
    LAS float* w2s = (LAS float*)lds;
    LAS float* c1s = w2s + 256 * 64;
    LAS float* hids = c1s + 256;
    const int nchunk = 8192 / 32;
    for (int item = blockIdx.x; item < nchunk; item += gridDim.x) {
        const int kv = (item * 32) >> 12;
        __syncthreads();
        { const f32x4* src = (const f32x4*)(a.in[7] + (size_t)kv * 256 * 64);
#pragma unroll
          for (int i = 0; i < 8; ++i) ((LAS f32x4*)w2s)[tid + 512 * i] = src[tid + 512 * i]; }
        if (tid < 256) { float t = 0.f;
#pragma unroll
            for (int kch = 0; kch < 64; ++kch) t += c1p[kch * 512 + kv * 256 + tid];
            c1s[tid] = t; }
        __syncthreads();
        LAS float* hp = hids + wave * 1024;
#pragma unroll
        for (int rr = 0; rr < 4; ++rr) {
            const int R = item * 32 + wave * 4 + rr;
            f32x4 h4 = *(const LAS f32x4*)(c1s + 4 * lane);
#pragma unroll
            for (int kc = 0; kc < 8; ++kc) h4 += *(const f32x4*)(part + ((size_t)kc * 8192 + R) * 256 + 4 * lane);
            hp[(4 * lane + 0) * 4 + rr] = gelu_tanh(h4.x); hp[(4 * lane + 1) * 4 + rr] = gelu_tanh(h4.y);
            hp[(4 * lane + 2) * 4 + rr] = gelu_tanh(h4.z); hp[(4 * lane + 3) * 4 + rr] = gelu_tanh(h4.w);
        }
        asm volatile("s_waitcnt lgkmcnt(0)" ::: "memory");
        float acc4[4] = {0.f, 0.f, 0.f, 0.f};
#pragma unroll 8
        for (int c = 0; c < 256; ++c) { const f32x4 hv = *(const LAS f32x4*)(hp + 4 * c); const float wv = w2s[c * 64 + lane];
            acc4[0] += hv.x * wv; acc4[1] += hv.y * wv; acc4[2] += hv.z * wv; acc4[3] += hv.w * wv; }
#pragma unroll
        for (int rr = 0; rr < 4; ++rr) {
            const int R = item * 32 + wave * 4 + rr, bh = (R >> 7) & 31, n = R & 127;
            const float acc = acc4[rr];
            if (kv == 0) {
                const float ss = wave_sum(acc * acc);
                const float y = acc * rsqrtf(ss * (1.f / 64.f) + EPS) * a.in[4][lane];
                kcmp[((size_t)bh * 128 + n) * 64 + lane] = (bf16_t)f2bf(n < 127 ? y : 0.f);
            } else {
                vcmpT[((size_t)bh * 64 + lane) * 128 + n] = (bf16_t)f2bf(n < 127 ? acc : 0.f);
            }
        }
    }
    __syncthreads();
    {
        LAS float* scr = (LAS float*)(lds + wave * 8704);
        const int gw = blockIdx.x * NWAVES + wave, NGW = gridDim.x * NWAVES;
        constexpr int I_O = 16 * 32, I_1 = 16 * 128, I_2 = 64 * 32;
        for (int it = gw; it < I_O + I_1 + I_2; it += NGW) {
            int r = it;
            if (r < I_O) { transpose_item<0>(a.in[12], 1024, 1024, (bf16_t*)(ws + WS_WOUT), a.in[11], scr, r, 32, lane); continue; } r -= I_O;
            if (r < I_1) { transpose_item<0>(a.in[14], 1024, 4096, (bf16_t*)(ws + WS_WFF1), a.in[13], scr, r, 128, lane); continue; } r -= I_1;
            transpose_item<0>(a.in[15], 4096, 1024, (bf16_t*)(ws + WS_WFF2), nullptr, scr, r, 32, lane);
        }
    }
}

__device__ __forceinline__ float branch_naive(const bf16_t* Kp, const bf16_t* VTp, LAS float* scw, const LAS float* qw, int pos, int lane, unsigned tmask, int mode) {
    const int cur = pos >> 6;
    float mloc = -INFINITY;
#pragma nounroll
    for (int kt = 0; kt <= cur; ++kt) {
        if (!((tmask >> kt) & 1u)) continue;
        const int key = 64 * kt + lane;
        const bf16_t* kr = Kp + (size_t)key * 64;
        float acc = 0.f;
#pragma unroll 2
        for (int d = 0; d < 64; d += 8) { float kk[8]; load8(kr + d, kk);
#pragma unroll
            for (int i = 0; i < 8; ++i) acc += qw[d + i] * kk[i]; }
        const bool valid = (key <= pos) && (mode == 0 || pos - key < 512);
        const float s = valid ? acc * 0.125f : -INFINITY;
        scw[key] = s; mloc = fmaxf(mloc, s);
    }
    const float mx = wave_max(mloc);
    float lsum = 0.f;
#pragma nounroll
    for (int kt = 0; kt <= cur; ++kt) {
        if (!((tmask >> kt) & 1u)) continue;
        const int key = 64 * kt + lane;
        const float p = __expf(scw[key] - mx);
        scw[key] = p; lsum += p;
    }
    const float sum = wave_sum(lsum);
    float o = 0.f;
#pragma nounroll
    for (int kt = 0; kt <= cur; ++kt) {
        if (!((tmask >> kt) & 1u)) continue;
        const bf16_t* vr = VTp + (size_t)lane * 2048 + 64 * kt;
#pragma unroll 2
        for (int k = 0; k < 64; k += 8) { float vv[8]; load8(vr + k, vv);
#pragma unroll
            for (int i = 0; i < 8; ++i) o += scw[64 * kt + k + i] * vv[i]; }
    }
    return o / fmaxf(sum, 1e-20f);
}

__device__ __forceinline__ void phase4_naive(const Args& a, LAS unsigned char* lds) {
    const int tid = threadIdx.x, lane = tid & 63, w = tid >> 6;
    unsigned char* ws = a.ws;
    LAS float* sc = (LAS float*)lds;
    LAS float* q_s = sc + 8 * 2048;
    LAS float* qr_s = q_s + 512;
    LAS float* pc = qr_s + 512;
    LAS float* impv = pc + 1024;
    LAS unsigned* selm = (LAS unsigned*)(impv + 64);
    LAS float* red = impv + 64 + 8;
    const bf16_t* qn = (const bf16_t*)(ws + WS_QN); const bf16_t* qr = (const bf16_t*)(ws + WS_QR);
    const bf16_t* kcmp = (const bf16_t*)(ws + WS_KCMP); const bf16_t* vcmpT = (const bf16_t*)(ws + WS_VCMPT);
    const bf16_t* ksl = (const bf16_t*)(ws + WS_KSL); const bf16_t* vslT = (const bf16_t*)(ws + WS_VSLT);
    const bf16_t* kwn = (const bf16_t*)(ws + WS_KWN); const bf16_t* vwnT = (const bf16_t*)(ws + WS_VWNT);
    const bf16_t* zu = (const bf16_t*)(ws + WS_ZU); const bf16_t* zvT = (const bf16_t*)(ws + WS_ZVT);
    const float* gates = (const float*)(ws + WS_GATES);
    bf16_t* o = (bf16_t*)(ws + WS_O);
    const float* sp_w = a.in[9]; const float* sp_b = a.in[10];
    for (int tok = blockIdx.x; tok < T; tok += gridDim.x) {
        const int b = tok >> 11, pos = tok & 2047, cur = pos >> 6;
        const int hkv = w >> 2, bh = b * 2 + hkv;
        __syncthreads();
        q_s[w * 64 + lane] = bf2f(qn[(size_t)tok * 512 + w * 64 + lane]);
        qr_s[w * 64 + lane] = bf2f(qr[(size_t)tok * 512 + w * 64 + lane]);
        __syncthreads();
        {
            float sv[2];
#pragma unroll
            for (int r = 0; r < 2; ++r) {
                const int n = lane + 64 * r;
                const bf16_t* kr = kcmp + ((size_t)bh * 128 + n) * 64;
                float acc = 0.f;
#pragma unroll 2
                for (int d = 0; d < 64; d += 8) { float kk[8]; load8(kr + d, kk);
#pragma unroll
                    for (int i = 0; i < 8; ++i) acc += q_s[w * 64 + d + i] * kk[i]; }
                sv[r] = (16 * n + 31 <= pos) ? acc * 0.125f : -INFINITY;
            }
            float mx = wave_max(fmaxf(sv[0], sv[1]));
            if (mx == -INFINITY) mx = 0.f;
            float p0 = __expf(sv[0] - mx), p1 = __expf(sv[1] - mx);
            const float inv = 1.f / fmaxf(wave_sum(p0 + p1), 1e-20f);
            pc[w * 128 + lane] = p0 * inv; pc[w * 128 + 64 + lane] = p1 * inv;
        }
        __syncthreads();
        float ocmp = 0.f;
        {
            const bf16_t* vr = vcmpT + ((size_t)bh * 64 + lane) * 128;
#pragma unroll 2
            for (int n = 0; n < 128; n += 8) { float vv[8]; load8(vr + n, vv);
#pragma unroll
                for (int i = 0; i < 8; ++i) ocmp += pc[w * 128 + n + i] * vv[i]; }
        }
        if (tid < 64) {
            const int hk = tid >> 5, j = tid & 31;
            float im = 0.f;
            for (int g = 0; g < 4; ++g) { const LAS float* pp = pc + (hk * 4 + g) * 128 + 4 * j;
                im += (j > 0 ? 0.5f * pp[-1] : 0.f) + pp[0] + pp[1] + pp[2] + 0.5f * pp[3]; }
            const bool forced = (j == 0) || (j == cur) || (j == cur - 1);
            impv[tid] = forced ? 1e9f : (j <= cur ? im : -INFINITY);
        }
        __syncthreads();
        if (tid < 64) {
            const int hk = tid >> 5, j = tid & 31;
            const float vj = impv[tid]; int cnt = 0;
#pragma unroll 4
            for (int i = 0; i < 32; ++i) { const float vi = impv[hk * 32 + i]; cnt += (vi > vj || (vi == vj && i < j)) ? 1 : 0; }
            const bool sel = (cnt < 16) && (vj > -INFINITY);
            const unsigned long long bal = __ballot(sel);
            if (lane == 0) { selm[0] = (unsigned)bal; selm[1] = (unsigned)(bal >> 32); }
        }
        __syncthreads();
        const unsigned smask = selm[hkv];
        const int kt_lo = (pos >= 511 ? pos - 511 : 0) >> 6;
        const unsigned upto = (cur == 31) ? 0xffffffffu : ((1u << (cur + 1)) - 1u);
        const unsigned wmask = upto & ~((1u << kt_lo) - 1u);
        const float osel = branch_naive(ksl + (size_t)bh * 2048 * 64, vslT + (size_t)bh * 64 * 2048, sc + w * 2048, qr_s + w * 64, pos, lane, smask & upto, 0);
        const float owin = branch_naive(kwn + (size_t)bh * 2048 * 64, vwnT + (size_t)bh * 64 * 2048, sc + w * 2048, qr_s + w * 64, pos, lane, wmask, 1);
        const float* gt = gates + (size_t)tok * 24 + w * 3;
        const float oa = gt[0] * ocmp + gt[1] * osel + gt[2] * owin;
        float om;
        {
            const int t = pos & 127, cs0 = pos - t;
            const bf16_t* zr = zvT + ((size_t)(b * 8 + w) * 64 + lane) * 2048 + cs0;
            const float* wrow = sp_w + ((size_t)w * 128 + t) * 128;
            float acc = 0.f;
#pragma nounroll
            for (int s0 = 0; s0 <= t; s0 += 8) { float zz[8]; load8(zr + s0, zz);
#pragma unroll
                for (int i = 0; i < 8; ++i) if (s0 + i <= t) acc += wrow[s0 + i] * zz[i]; }
            acc += sp_b[w * 128 + t];
            om = bf2f(zu[(size_t)tok * 512 + w * 64 + lane]) * acc;
        }
        const float ssa = wave_sum(oa * oa), ssm = wave_sum(om * om);
        if (lane == 0) { red[w] = ssa; red[8 + w] = ssm; }
        __syncthreads();
        float ta = 0.f, tm = 0.f;
#pragma unroll
        for (int i = 0; i < 8; ++i) { ta += red[i]; tm += red[8 + i]; }
        o[(size_t)tok * DM + w * 64 + lane] = (bf16_t)f2bf(oa * rsqrtf(ta * (1.f / 512.f) + EPS));
        o[(size_t)tok * DM + 512 + w * 64 + lane] = (bf16_t)f2bf(om * rsqrtf(tm * (1.f / 512.f) + EPS));
    }
}


typedef short bf16x8_t __attribute__((ext_vector_type(8)));
typedef short s16x4_t __attribute__((ext_vector_type(4)));
typedef float f32x16 __attribute__((ext_vector_type(16)));
typedef __bf16 bf16x2_t __attribute__((ext_vector_type(2)));
typedef float f32x2_t __attribute__((ext_vector_type(2)));
typedef unsigned u32x2 __attribute__((ext_vector_type(2)));
#define MFMA32(a, b, c) __builtin_amdgcn_mfma_f32_32x32x16_bf16((a), (b), (c), 0, 0, 0)
__device__ __forceinline__ unsigned cvtpk(float lo, float hi) { f32x2_t v = {lo, hi}; bf16x2_t b = __builtin_convertvector(v, bf16x2_t); return __builtin_bit_cast(unsigned, b); }
__device__ __forceinline__ float ex2(float x) { return __builtin_amdgcn_exp2f(x); }
__device__ __forceinline__ f32x16 zero16() { f32x16 z;
#pragma unroll
    for (int i = 0; i < 16; ++i) z[i] = 0.f; return z; }
__device__ __forceinline__ bf16x8_t pack8(const f32x16& x, int s8) {
    u32x4 w; w.x = cvtpk(x[s8 + 0], x[s8 + 1]); w.y = cvtpk(x[s8 + 2], x[s8 + 3]); w.z = cvtpk(x[s8 + 4], x[s8 + 5]); w.w = cvtpk(x[s8 + 6], x[s8 + 7]);
    return __builtin_bit_cast(bf16x8_t, w);
}
constexpr int A_KSTR = 144, A_VSTR = 136, A_CVSTR = 264, A_IMPSTR = 33;
constexpr int A_KT = 128 * A_KSTR, A_VT = 64 * A_CVSTR;
constexpr int A_KBUF = 0, A_VBUF = 2 * A_KT, A_CMPK = A_VBUF + 2 * A_VT, A_CMPV = A_CMPK + 18432, A_IMP = A_CMPV + 16896, A_SELM = A_IMP + 4 * 64 * A_IMPSTR * 4, A_SSQ = A_SELM + 256, A_END = A_SSQ + 4096;
static_assert(A_END <= LDS_BYTES - 64, "attention LDS map");

template <int MODE>
__device__ __forceinline__ void attn_tile(const LAS unsigned char* Kb, const LAS unsigned char* Vb, const bf16x8_t (&qf)[4], f32x16 (&oacc)[2], float& l_run,
                                          int r, int h, int dlt0, int dlt1, bool hiw) {
    const unsigned ulim = (MODE == 0) ? 0x80000000u : 512u;
    float ls = 0.f;
#pragma unroll
    for (int mt = 0; mt < 4; ++mt) {
        if (mt == 0) { if (hiw) __builtin_amdgcn_s_setprio(1); else __builtin_amdgcn_s_setprio(0); }
        if (mt == 2) { if (hiw) __builtin_amdgcn_s_setprio(0); else __builtin_amdgcn_s_setprio(1); }
        f32x16 sacc = zero16();
#pragma unroll
        for (int ks = 0; ks < 4; ++ks) { const bf16x8_t ka = *(const LAS bf16x8_t*)(Kb + (32 * mt + r) * A_KSTR + 32 * ks + 16 * h); sacc = MFMA32(ka, qf[ks], sacc); }
        const int dl = mt < 2 ? dlt0 : dlt1;
#pragma unroll
        for (int i = 0; i < 16; ++i) {
            float p;
            if (MODE == 2) p = ex2(sacc[i]);
            else { const int ci = 32 * mt + (i & 3) + 8 * (i >> 2); p = ((unsigned)(dl - ci) < ulim) ? ex2(sacc[i]) : 0.f; }
            sacc[i] = p; ls += p;
        }
#pragma unroll
        for (int s = 0; s < 2; ++s) {
            const bf16x8_t pf = pack8(sacc, 8 * s);
#pragma unroll
            for (int dt = 0; dt < 2; ++dt) {
                const LAS unsigned char* vp = Vb + (32 * dt + r) * A_CVSTR + (32 * mt + 16 * s + 4 * h) * 2;
                const s16x4_t lo = *(const LAS s16x4_t*)vp, hi = *(const LAS s16x4_t*)(vp + 16);
                oacc[dt] = MFMA32(__builtin_shufflevector(lo, hi, 0, 1, 2, 3, 4, 5, 6, 7), pf, oacc[dt]);
            }
        }
    }
    l_run += ls;
}

__device__ __forceinline__ void phase4_attn(const Args& a, LAS unsigned char* lds) {
    const int tid0 = threadIdx.x, w = __builtin_amdgcn_readfirstlane(tid0 >> 6), g = w >> 1, half = w & 1;
    unsigned char* ws = a.ws;
    const bf16_t* qn = (const bf16_t*)(ws + WS_QN); const bf16_t* qr = (const bf16_t*)(ws + WS_QR);
    const bf16_t* kcmp = (const bf16_t*)(ws + WS_KCMP); const bf16_t* vcmpT = (const bf16_t*)(ws + WS_VCMPT);
    const bf16_t* ksl = (const bf16_t*)(ws + WS_KSL); const bf16_t* vslT = (const bf16_t*)(ws + WS_VSLT);
    const bf16_t* kwn = (const bf16_t*)(ws + WS_KWN); const bf16_t* vwnT = (const bf16_t*)(ws + WS_VWNT);
    const float* gates = (const float*)(ws + WS_GATES);
    bf16_t* o = (bf16_t*)(ws + WS_O);
    LAS float* IMP = (LAS float*)(lds + A_IMP); LAS unsigned* SELM = (LAS unsigned*)(lds + A_SELM); LAS float* SSQ = (LAS float*)(lds + A_SSQ);
    for (int pr = blockIdx.x; pr < 256; pr += gridDim.x) {
        const int b = pr >> 4, tt0 = pr & 15;
#pragma unroll 1
        for (int it = 0; it < 2; ++it) {
            const int t = it ? 31 - tt0 : tt0;
            f32x16 comb[2][2];
#pragma unroll
            for (int hkv = 0; hkv < 2; ++hkv) {
                const int bh = b * 2 + hkv, head = hkv * 4 + g;
                int tid = tid0; asm volatile("" : "+v"(tid));
                const int lane = tid & 63, r = lane & 31, h = lane >> 5, ql = 32 * half + r, pos = 64 * t + ql, tok = b * 2048 + pos;
                comb[hkv][0] = zero16(); comb[hkv][1] = zero16();
                const float g0 = gates[(size_t)tok * 24 + head * 3 + 0], g1 = gates[(size_t)tok * 24 + head * 3 + 1], g2 = gates[(size_t)tok * 24 + head * 3 + 2];
                __syncthreads();
                {
                    const bf16_t* kc = kcmp + (size_t)bh * 128 * 64; const bf16_t* vc = vcmpT + (size_t)bh * 64 * 128;
#pragma unroll
                    for (int i = 0; i < 2; ++i) { const int c = tid + 512 * i;
                        const u32x4 kv = *(const u32x4*)(kc + (size_t)c * 8);
                        *(LAS u32x4*)(lds + A_CMPK + (c >> 3) * A_KSTR + (c & 7) * 16) = kv;
                        const u32x4 vv = *(const u32x4*)(vc + (size_t)c * 8);
                        LAS unsigned char* vp = lds + A_CMPV + (c >> 4) * A_CVSTR + (c & 15) * 16;
                        *(LAS u32x2*)vp = (u32x2){vv.x, vv.y}; *(LAS u32x2*)(vp + 8) = (u32x2){vv.z, vv.w}; }
                }
                bf16x8_t qf[4];
#pragma unroll
                for (int ks = 0; ks < 4; ++ks) qf[ks] = *(const bf16x8_t*)(qn + (size_t)tok * 512 + head * 64 + 16 * ks + 8 * h);
                __syncthreads();
                {
                    f32x16 s4[4];
#pragma unroll
                    for (int mt = 0; mt < 4; ++mt) { s4[mt] = zero16();
#pragma unroll
                        for (int ks = 0; ks < 4; ++ks) { const bf16x8_t ka = *(const LAS bf16x8_t*)(lds + A_CMPK + (32 * mt + r) * A_KSTR + 32 * ks + 16 * h); s4[mt] = MFMA32(ka, qf[ks], s4[mt]); } }
                    const int clim = (pos - 31 - 64 * h) >> 4;
                    float ls = 0.f;
#pragma unroll
                    for (int mt = 0; mt < 4; ++mt)
#pragma unroll
                        for (int i = 0; i < 16; ++i) { const int ci = 32 * mt + (i & 3) + 8 * (i >> 2);
                            const float p = (ci <= clim) ? ex2(s4[mt][i]) : 0.f; s4[mt][i] = p; ls += p; }
                    ls += __shfl_xor(ls, 32);
                    const float inv = 1.f / fmaxf(ls, 1e-20f);
#pragma unroll
                    for (int mt = 0; mt < 4; ++mt) s4[mt] *= inv;
                    if (t >= 16) {
                        float oprev = 0.f;
#pragma unroll
                        for (int idx = 0; idx < 16; ++idx) {
                            const int mt = idx >> 2, ap = idx & 3;
                            const float tail = 0.5f * s4[mt][4 * ap + 3];
                            const float ot = __shfl_xor(tail, 32);
                            const float inner = s4[mt][4 * ap] + s4[mt][4 * ap + 1] + s4[mt][4 * ap + 2] + tail;
                            const float prev = h ? ot : oprev;
                            oprev = ot;
                            IMP[(g * 64 + ql) * A_IMPSTR + 8 * mt + 2 * ap + h] = inner + prev;
                        }
                    }
                    f32x16 oc[2]; oc[0] = zero16(); oc[1] = zero16();
#pragma unroll
                    for (int mt = 0; mt < 4; ++mt)
#pragma unroll
                        for (int s = 0; s < 2; ++s) {
                            const bf16x8_t pf = pack8(s4[mt], 8 * s);
#pragma unroll
                            for (int dt = 0; dt < 2; ++dt) {
                                const LAS unsigned char* vp = lds + A_CMPV + (32 * dt + r) * A_CVSTR + (32 * mt + 16 * s + 4 * h) * 2;
                                const s16x4_t lo = *(const LAS s16x4_t*)vp, hi = *(const LAS s16x4_t*)(vp + 16);
                                oc[dt] = MFMA32(__builtin_shufflevector(lo, hi, 0, 1, 2, 3, 4, 5, 6, 7), pf, oc[dt]);
                            }
                        }
                    comb[hkv][0] += oc[0] * g0; comb[hkv][1] += oc[1] * g0;
                }
                if (t >= 16) {
                    __syncthreads();
                    const int qloc = tid >> 3, jg = tid & 7;
                    unsigned bits = 0u;
                    float xe[4]; int cnt[4];
#pragma unroll
                    for (int e = 0; e < 4; ++e) { const int j = 4 * jg + e; const LAS float* ip = IMP + qloc * A_IMPSTR + j;
                        float x = (ip[0] + ip[64 * A_IMPSTR]) + (ip[128 * A_IMPSTR] + ip[192 * A_IMPSTR]);
                        if (j == 0 || j == t || j == t - 1) x = 1e9f;
                        if (j > t) x = -INFINITY;
                        xe[e] = x; cnt[e] = 0; }
#pragma unroll 4
                    for (int i = 0; i < 32; ++i) { const LAS float* ip = IMP + qloc * A_IMPSTR + i;
                        float vi = (ip[0] + ip[64 * A_IMPSTR]) + (ip[128 * A_IMPSTR] + ip[192 * A_IMPSTR]);
                        if (i == 0 || i == t || i == t - 1) vi = 1e9f;
                        if (i > t) vi = -INFINITY;
#pragma unroll
                        for (int e = 0; e < 4; ++e) cnt[e] += (vi > xe[e] || (vi == xe[e] && i < 4 * jg + e)) ? 1 : 0; }
#pragma unroll
                    for (int e = 0; e < 4; ++e) if (cnt[e] < 16 && xe[e] > -INFINITY) bits |= 1u << (4 * jg + e);
                    bits |= __shfl_xor(bits, 1); bits |= __shfl_xor(bits, 2); bits |= __shfl_xor(bits, 4);
                    if (jg == 0) SELM[qloc] = bits;
                    __syncthreads();
                }
                const unsigned selw = (t >= 16) ? SELM[ql] : ((2u << t) - 1u);
#pragma unroll
                for (int ks = 0; ks < 4; ++ks) qf[ks] = *(const bf16x8_t*)(qr + (size_t)tok * 512 + head * 64 + 16 * ks + 8 * h);
                const int kt_lo = t >= 8 ? t - 8 : 0, wlo = kt_lo >> 1, n_sel = (t >> 1) + 1, n_all = n_sel + ((t >> 1) - wlo + 1);
                const bf16_t* Ks = ksl + (size_t)bh * 2048 * 64; const bf16_t* Vs = vslT + (size_t)bh * 64 * 2048;
                const bf16_t* Kw = kwn + (size_t)bh * 2048 * 64; const bf16_t* Vw = vwnT + (size_t)bh * 64 * 2048;
#define A_ISSUE(idx) do { const int i1_ = (idx); const bool sel1_ = i1_ < n_sel; const int st1_ = sel1_ ? i1_ : wlo + (i1_ - n_sel); \
        int tv_ = tid; asm volatile("" : "+v"(tv_)); \
        const bf16_t* Kg_ = (sel1_ ? Ks : Kw) + (size_t)st1_ * 8192; const bf16_t* Vg_ = (sel1_ ? Vs : Vw) + (size_t)st1_ * 8192; \
        kR0 = *(const u32x4*)(Kg_ + (size_t)tv_ * 8); kR1 = *(const u32x4*)(Kg_ + (size_t)(tv_ + 512) * 8); \
        vR0 = *(const u32x4*)(Vg_ + (size_t)tv_ * 8); vR1 = *(const u32x4*)(Vg_ + (size_t)(tv_ + 512) * 8); } while (0)
#define A_STAGE(bufi) do { int tv_ = tid; asm volatile("" : "+v"(tv_)); \
        LAS unsigned char* kp_ = lds + A_KBUF + (bufi) * A_KT + (tv_ >> 3) * A_KSTR + (tv_ & 7) * 16; \
        *(LAS u32x4*)kp_ = kR0; *(LAS u32x4*)(kp_ + 64 * A_KSTR) = kR1; \
        LAS unsigned char* vp_ = lds + A_VBUF + (bufi) * A_VT + (tv_ >> 3) * A_CVSTR + (tv_ & 7) * 16; \
        *(LAS u32x2*)vp_ = (u32x2){vR0.x, vR0.y}; *(LAS u32x2*)(vp_ + 8) = (u32x2){vR0.z, vR0.w}; \
        *(LAS u32x2*)(vp_ + 128) = (u32x2){vR1.x, vR1.y}; *(LAS u32x2*)(vp_ + 136) = (u32x2){vR1.z, vR1.w}; } while (0)
                u32x4 kR0, kR1, vR0, vR1;
                A_ISSUE(0);
                A_STAGE(0);
                __syncthreads();
                f32x16 oacc[2]; oacc[0] = zero16(); oacc[1] = zero16();
                float l_run = 0.f;
#pragma unroll 1
                for (int i = 0; i < n_all; ++i) {
                    const int bufo = i & 1;
                    if (i + 1 < n_all) A_ISSUE(i + 1);
                    const LAS unsigned char* Kb = lds + A_KBUF + bufo * A_KT; const LAS unsigned char* Vb = lds + A_VBUF + bufo * A_VT;
                    const bool issel = i < n_sel;
                    const int st = issel ? i : wlo + (i - n_sel);
                    const int dlt = 64 * t + ql - 128 * st - 4 * h;
                    if (issel) {
                        const bool b0 = (selw >> (2 * st)) & 1u, b1 = (selw >> (2 * st + 1)) & 1u;
                        if (__ballot(b0 || b1) != 0ull) {
                            if (2 * st + 1 < t && __ballot(b0 && b1) == ~0ull) attn_tile<2>(Kb, Vb, qf, oacc, l_run, r, h, dlt, dlt, (w & 4) != 0);
                            else attn_tile<0>(Kb, Vb, qf, oacc, l_run, r, h, b0 ? dlt : -1, b1 ? dlt : -1, (w & 4) != 0);
                        }
                    } else {
                        if (2 * st > t - 8 && 2 * st + 1 < t) attn_tile<2>(Kb, Vb, qf, oacc, l_run, r, h, dlt, dlt, (w & 4) != 0);
                        else attn_tile<1>(Kb, Vb, qf, oacc, l_run, r, h, dlt, dlt, (w & 4) != 0);
                    }
                    if (i == n_sel - 1 || i == n_all - 1) { const float lt = l_run + __shfl_xor(l_run, 32); const float sc = ((i == n_sel - 1) ? g1 : g2) / fmaxf(lt, 1e-20f);
                        comb[hkv][0] += oacc[0] * sc; comb[hkv][1] += oacc[1] * sc; oacc[0] = zero16(); oacc[1] = zero16(); l_run = 0.f; }
                    if (i + 1 < n_all) A_STAGE(bufo ^ 1);
                    __syncthreads();
                }
#undef A_ISSUE
#undef A_STAGE
            }
            int tid = tid0; asm volatile("" : "+v"(tid));
            const int lane = tid & 63, r = lane & 31, h = lane >> 5, ql = 32 * half + r, pos = 64 * t + ql, tok = b * 2048 + pos;
            float ss = 0.f;
#pragma unroll
            for (int hkv = 0; hkv < 2; ++hkv)
#pragma unroll
                for (int dt = 0; dt < 2; ++dt)
#pragma unroll
                    for (int i = 0; i < 16; ++i) ss += comb[hkv][dt][i] * comb[hkv][dt][i];
            ss += __shfl_xor(ss, 32);
            if (h == 0) SSQ[w * 32 + r] = ss;
            __syncthreads();
            const float tot = (SSQ[(half + 0) * 32 + r] + SSQ[(half + 2) * 32 + r]) + (SSQ[(half + 4) * 32 + r] + SSQ[(half + 6) * 32 + r]);
            const float rn = rsqrtf(tot * (1.f / 512.f) + EPS);
#pragma unroll
            for (int hkv = 0; hkv < 2; ++hkv)
#pragma unroll
                for (int dt = 0; dt < 2; ++dt)
#pragma unroll
                    for (int ap = 0; ap < 4; ++ap) {
                        u32x2 pk; pk.x = cvtpk(comb[hkv][dt][4 * ap] * rn, comb[hkv][dt][4 * ap + 1] * rn); pk.y = cvtpk(comb[hkv][dt][4 * ap + 2] * rn, comb[hkv][dt][4 * ap + 3] * rn);
                        *(u32x2*)(o + (size_t)tok * DM + (hkv * 4 + g) * 64 + 32 * dt + 8 * ap + 4 * h) = pk;
                    }
        }
    }
}

constexpr int G_TSTR = 136, G_TILE = 128 * G_TSTR, G_SSQ = 8 * G_TILE;
static_assert(G_SSQ + 8 * 128 * 4 <= LDS_BYTES - 64, "gMLP LDS map");
__device__ __forceinline__ void phase4_gmlp(const Args& a, LAS unsigned char* lds) {
    const int tid0 = threadIdx.x, g = __builtin_amdgcn_readfirstlane(tid0 >> 6);
    unsigned char* ws = a.ws;
    const bf16_t* zu = (const bf16_t*)(ws + WS_ZU); const bf16_t* zvT = (const bf16_t*)(ws + WS_ZVT); const bf16_t* Wsp = (const bf16_t*)(ws + WS_WSP);
    const float* sp_b = a.in[10];
    bf16_t* o = (bf16_t*)(ws + WS_O);
    LAS float* SSQ2 = (LAS float*)(lds + G_SSQ);
    LAS unsigned char* tile = lds + g * G_TILE;
    for (int item = blockIdx.x; item < 256; item += gridDim.x) {
        const int b = item >> 4, ch = item & 15;
        const size_t tok0 = (size_t)b * 2048 + ch * 128;
        int tid = tid0; asm volatile("" : "+v"(tid));
        const int lane = tid & 63, r = lane & 31, h = lane >> 5;
        __syncthreads();
        bf16x8_t zf[2][8];
#pragma unroll
        for (int dt = 0; dt < 2; ++dt)
#pragma unroll
            for (int ks = 0; ks < 8; ++ks) zf[dt][ks] = *(const bf16x8_t*)(zvT + ((((size_t)b * 16 + ch) * 8 + g) * 64 + 32 * dt + r) * 128 + 16 * ks + 8 * h);
        f32x16 acc[2][4];
#pragma unroll
        for (int tt = 0; tt < 4; ++tt) { acc[0][tt] = zero16(); acc[1][tt] = zero16();
            __builtin_amdgcn_sched_barrier(0);
#pragma unroll
            for (int ks = 0; ks < 2 * tt + 2; ++ks) {
                const bf16x8_t wf = *(const bf16x8_t*)(Wsp + ((size_t)g * 128 + 32 * tt + r) * 128 + 16 * ks + 8 * h);
                acc[0][tt] = MFMA32(zf[0][ks], wf, acc[0][tt]); acc[1][tt] = MFMA32(zf[1][ks], wf, acc[1][tt]);
            } }
        __builtin_amdgcn_sched_barrier(0);
#pragma unroll
        for (int hb = 0; hb < 2; ++hb) {
            u32x4 zr[8];
#pragma unroll
            for (int it = 0; it < 8; ++it) zr[it] = *(const u32x4*)(zu + (tok0 + (lane >> 3) + 8 * (8 * hb + it)) * 512 + g * 64 + (lane & 7) * 8);
#pragma unroll
            for (int it = 0; it < 8; ++it) { LAS unsigned char* p = tile + ((lane >> 3) + 8 * (8 * hb + it)) * G_TSTR + (lane & 7) * 16;
                *(LAS u32x2*)p = (u32x2){zr[it].x, zr[it].y}; *(LAS u32x2*)(p + 8) = (u32x2){zr[it].z, zr[it].w}; }
        }
        asm volatile("s_waitcnt lgkmcnt(0)" ::: "memory");
#pragma unroll
        for (int tt = 0; tt < 4; ++tt) {
            const int tl = 32 * tt + r;
            const float bias = sp_b[g * 128 + tl];
            float ss = 0.f;
#pragma unroll
            for (int dt = 0; dt < 2; ++dt)
#pragma unroll
                for (int ap = 0; ap < 4; ++ap) {
                    const u32x2 zz = *(const LAS u32x2*)(tile + tl * G_TSTR + (32 * dt + 8 * ap + 4 * h) * 2);
                    const float z0 = __uint_as_float(zz.x << 16), z1 = __uint_as_float(zz.x & 0xffff0000u), z2 = __uint_as_float(zz.y << 16), z3 = __uint_as_float(zz.y & 0xffff0000u);
                    float v0 = z0 * (acc[dt][tt][4 * ap] + bias), v1 = z1 * (acc[dt][tt][4 * ap + 1] + bias), v2 = z2 * (acc[dt][tt][4 * ap + 2] + bias), v3 = z3 * (acc[dt][tt][4 * ap + 3] + bias);
                    acc[dt][tt][4 * ap] = v0; acc[dt][tt][4 * ap + 1] = v1; acc[dt][tt][4 * ap + 2] = v2; acc[dt][tt][4 * ap + 3] = v3;
                    ss += (v0 * v0 + v1 * v1) + (v2 * v2 + v3 * v3);
                }
            ss += __shfl_xor(ss, 32);
            if (h == 0) SSQ2[g * 128 + tl] = ss;
        }
        __syncthreads();
#pragma unroll
        for (int tt = 0; tt < 4; ++tt) {
            const int tl = 32 * tt + r;
            float tot = 0.f;
#pragma unroll
            for (int gg = 0; gg < 8; ++gg) tot += SSQ2[gg * 128 + tl];
            const float rn = rsqrtf(tot * (1.f / 512.f) + EPS);
#pragma unroll
            for (int dt = 0; dt < 2; ++dt)
#pragma unroll
                for (int ap = 0; ap < 4; ++ap) {
                    u32x2 pk; pk.x = cvtpk(acc[dt][tt][4 * ap] * rn, acc[dt][tt][4 * ap + 1] * rn); pk.y = cvtpk(acc[dt][tt][4 * ap + 2] * rn, acc[dt][tt][4 * ap + 3] * rn);
                    *(LAS u32x2*)(tile + tl * G_TSTR + (32 * dt + 8 * ap + 4 * h) * 2) = pk;
                }
        }
        asm volatile("s_waitcnt lgkmcnt(0)" ::: "memory");
#pragma unroll
        for (int it = 0; it < 16; ++it) { const LAS unsigned char* p = tile + ((lane >> 3) + 8 * it) * G_TSTR + (lane & 7) * 16;
            const u32x2 lo = *(const LAS u32x2*)p, hi = *(const LAS u32x2*)(p + 8);
            *(u32x4*)(o + (tok0 + (lane >> 3) + 8 * it) * DM + 512 + g * 64 + (lane & 7) * 8) = (u32x4){lo.x, lo.y, hi.x, hi.y}; }
    }
}

constexpr int BAR_BYTES = (1024 + 8 * 2304) * 4;
__device__ __forceinline__ unsigned xb_ld(unsigned* p) { return __hip_atomic_load(p, __ATOMIC_RELAXED, __HIP_MEMORY_SCOPE_AGENT); }
__device__ __forceinline__ unsigned xb_add(unsigned* p, unsigned v) { return __hip_atomic_fetch_add(p, v, __ATOMIC_RELAXED, __HIP_MEMORY_SCOPE_AGENT); }
__device__ __forceinline__ unsigned xb_xcc_id() { return (unsigned)__builtin_amdgcn_s_getreg((3 << 11) | 20) & 0xFu; }
__device__ __forceinline__ void grid_barrier(unsigned* barw, int k, volatile LAS unsigned* st) {
    asm volatile("s_waitcnt vmcnt(0)" ::: "memory");
    __syncthreads();
    if (threadIdx.x == 0) {
        __builtin_amdgcn_s_waitcnt(0);
        const unsigned x = xb_xcc_id();
        unsigned nloc = st[0], nx = st[1];
        if (nloc == 0u) {
            const unsigned G = gridDim.x;
            for (;;) { unsigned sum = 0u, cnt = 0u, mine = 0u;
#pragma unroll
                for (unsigned j = 0; j < 16; ++j) { const unsigned c = xb_ld(barw + 64 * j); sum += c; cnt += (c > 0u) ? 1u : 0u; mine = (j == x) ? c : mine; }
                if (sum == G) { nloc = mine; nx = cnt; break; }
                __builtin_amdgcn_s_sleep(1); }
            st[0] = nloc; st[1] = nx;
        }
        unsigned* sb = barw + 1024 + k * 2304;
        const unsigned old = xb_add(sb + 64 * x, 1u);
        if (old + 1u == nloc) {
            __builtin_amdgcn_fence(__ATOMIC_RELEASE, "agent");
            asm volatile("s_waitcnt vmcnt(0)" ::: "memory");
            const unsigned og = xb_add(sb + 2048, 1u);
            if (og + 1u == nx) xb_add(sb + 2112, 1u);
            else while (xb_ld(sb + 2112) == 0u) __builtin_amdgcn_s_sleep(1);
            __builtin_amdgcn_fence(__ATOMIC_ACQUIRE, "agent");
            xb_add(sb + 1024 + 64 * x, 1u);
            asm volatile("s_waitcnt vmcnt(0)" ::: "memory");
        } else {
            while (xb_ld(sb + 1024 + 64 * x) == 0u) __builtin_amdgcn_s_sleep(1);
            __builtin_amdgcn_fence(__ATOMIC_ACQUIRE, "agent");
            asm volatile("s_waitcnt vmcnt(0)" ::: "memory");
        }
    }
    __syncthreads();
}

#ifndef N_LAUNCHES
#define N_LAUNCHES 1
#endif
constexpr int NPHASE = 8;
__global__ void __launch_bounds__(NWAVES * 64, 2) fwd_kernel(Args args) {
    extern __shared__ __attribute__((aligned(16))) unsigned char lds_raw[];
    LAS unsigned char* lds = (LAS unsigned char*)lds_raw;
    unsigned char* ws = args.ws;
    const int lo = args.ph_lo, hi = args.ph_hi;
    const int G = gridDim.x;
#define IN(k) (lo <= (k) && (k) < hi)
    unsigned* barw = (unsigned*)ws;
    volatile LAS unsigned* bst = (volatile LAS unsigned*)(lds + LDS_BYTES - 64);
    if (threadIdx.x == 0) { bst[0] = 0u; bst[1] = 0u; (void)xb_add(barw + 64 * xb_xcc_id(), 1u); }
    __syncthreads();
    if (hi > NPHASE) cg::this_grid().sync();
#define SEAM(k) do { if (IN(k) && IN((k) + 1)) { grid_barrier(barw, (k), bst); } } while (0)
    if (IN(0)) { phase0(args, lds); }
    SEAM(0);
    if (IN(1)) {
        pg8::Gemm g{(const bf16_t*)(ws + WS_XB), (const bf16_t*)(ws + WS_WIN), T, NIN, DM, DM, DM};
        pg8::StaticOrder So; So.init(T, NIN, G, (int)blockIdx.x);
        EpiInProj E{(const float*)(ws + WS_RINV1), args.in[3], args.in[4], args.in[8], (const float*)(ws + WS_ROPEC), (const float*)(ws + WS_ROPES),
                    (bf16_t*)(ws + WS_QN), (bf16_t*)(ws + WS_QR), (bf16_t*)(ws + WS_KC), (bf16_t*)(ws + WS_VC), (bf16_t*)(ws + WS_KSL), (bf16_t*)(ws + WS_VSLT),
                    (bf16_t*)(ws + WS_KWN), (bf16_t*)(ws + WS_VWNT), (bf16_t*)(ws + WS_ZU), (bf16_t*)(ws + WS_ZVT), (float*)(ws + WS_GATES)};
        pg8::gemm_phase<EpiInProj, pg8::StaticOrder, true, true>(lds, g, So, E);
    }
    SEAM(1);
    if (IN(2)) {
        pg8::Gemm g{(const bf16_t*)(ws + WS_KC), (const bf16_t*)(ws + WS_W1T), 8192, 512, 256, 1024, 2048};
        pg8::CmpOrder So{G, (int)blockIdx.x};
        EpiPart E{(float*)(ws + WS_PART)};
        pg8::gemm_phase<EpiPart, pg8::CmpOrder, false, true>(lds, g, So, E);
    }
    SEAM(2);
    if (IN(3)) { phase3(args, lds); }
    SEAM(3);
    #ifdef NAIVE_MIXER
    if (IN(4)) { phase4_naive(args, lds); }
#else
    if (IN(4)) { phase4_attn(args, lds); phase4_gmlp(args, lds); }
#if defined(PROBE_REPEAT4)
    if (IN(4)) { __syncthreads(); phase4_attn(args, lds); }
#endif
#endif
    SEAM(4);
    if (IN(5)) {
        pg8::Gemm g{(const bf16_t*)(ws + WS_O), (const bf16_t*)(ws + WS_WOUT), T, DM, DM, DM, DM};
        pg8::StaticOrder So; So.init(T, DM, G, (int)blockIdx.x);
        EpiWout E{(const bf16_t*)(ws + WS_XB), (bf16_t*)(ws + WS_X2B), (float*)(ws + WS_SSQP), (LAS float*)(lds + 131072)};
        pg8::gemm_phase<EpiWout, pg8::StaticOrder, true, true>(lds, g, So, E);
    }
    SEAM(5);
    if (IN(6)) {
        pg8::Gemm g{(const bf16_t*)(ws + WS_X2B), (const bf16_t*)(ws + WS_WFF1), T, FF, DM, DM, DM};
        pg8::StaticOrder So; So.init(T, FF, G, (int)blockIdx.x);
        EpiFF1 E{(const float*)(ws + WS_SSQP), (bf16_t*)(ws + WS_H)};
        pg8::gemm_phase<EpiFF1, pg8::StaticOrder, true, true>(lds, g, So, E);
    }
    SEAM(6);
    if (IN(7)) {
        pg8::Gemm g{(const bf16_t*)(ws + WS_H), (const bf16_t*)(ws + WS_WFF2), T, DM, FF, FF, FF};
        pg8::StaticOrder So; So.init(T, DM, G, (int)blockIdx.x);
        EpiFF2 E{(const bf16_t*)(ws + WS_X2B), args.out};
        pg8::gemm_phase<EpiFF2, pg8::StaticOrder, true, true>(lds, g, So, E);
    }
#undef IN
#undef SEAM
}

extern "C" void kernel_launch(void* const* d_in, const int* in_sizes, int n_in, void* d_out, int out_size, void* d_ws, size_t ws_size, hipStream_t stream) {
    static int grid = 0;
    if (grid == 0) {
        if (n_in != 16 || out_size != T * DM || ws_size < WS_END) { fprintf(stderr, "kernel_launch: unexpected shapes (n_in %d out %d ws %zu)\n", n_in, out_size, ws_size); grid = -1; return; }
        int dev = 0, cus = 0, per_cu = 0;
        hipGetDevice(&dev); hipDeviceGetAttribute(&cus, hipDeviceAttributeMultiprocessorCount, dev);
        if (hipFuncSetAttribute((const void*)fwd_kernel, hipFuncAttributeMaxDynamicSharedMemorySize, LDS_BYTES) != hipSuccess) { fprintf(stderr, "kernel_launch: hipFuncSetAttribute failed\n"); grid = -1; return; }
        if (hipOccupancyMaxActiveBlocksPerMultiprocessor(&per_cu, (const void*)fwd_kernel, NWAVES * 64, LDS_BYTES) != hipSuccess || per_cu < 1) { fprintf(stderr, "kernel_launch: occupancy query says %d\n", per_cu); per_cu = 1; }
        (void)hipGetLastError();
        grid = cus * per_cu;
        fprintf(stderr, "kernel_launch: grid %d (cus %d x %d)\n", grid, cus, per_cu);
    }
    if (grid < 0) return;
    if (hipMemsetAsync(d_ws, 0, BAR_BYTES, stream) != hipSuccess) { fprintf(stderr, "kernel_launch: memset of the barrier words failed\n"); return; }
    Args a{};
    for (int i = 0; i < 16; ++i) a.in[i] = (const float*)d_in[i];
    a.out = (float*)d_out; a.ws = (unsigned char*)d_ws;
#if N_LAUNCHES == 1
    a.ph_lo = 0; a.ph_hi = NPHASE;
    void* kargs[] = {&a};
    hipError_t e = hipLaunchCooperativeKernel((const void*)fwd_kernel, dim3(grid), dim3(NWAVES * 64), kargs, LDS_BYTES, stream);
    if (e != hipSuccess) fprintf(stderr, "kernel_launch: cooperative launch failed: %s (grid %d)\n", hipGetErrorString(e), grid);
#else
    for (int p = 0; p < NPHASE; ++p) {
        a.ph_lo = p; a.ph_hi = p + 1;
        hipLaunchKernelGGL(fwd_kernel, dim3(grid), dim3(NWAVES * 64), LDS_BYTES, stream, a);
    }
#endif
}
```

```cpp
#include <hip/hip_runtime.h>
#include <hip/hip_cooperative_groups.h>
#include <cstdio>
#include <cstdint>
namespace cg = cooperative_groups;

#define LAS __attribute__((address_space(3)))
typedef unsigned short bf16_t;
typedef unsigned u32x4 __attribute__((ext_vector_type(4)));
typedef float f32x4 __attribute__((ext_vector_type(4)));

namespace pg8 {
#define PG8_LAS __attribute__((address_space(3)))
typedef short bf16x8 __attribute__((ext_vector_type(8)));
constexpr int BM = 256, BK = 64, HALF = 128, HTB = HALF * BK * 2, STAGE_BYTES = 8 * HTB, NXCD = 8, WGM = 4;
__host__ __device__ __forceinline__ int lds_byte(int r, int c) { const int st = (r >> 4) * 2 + (c >> 5), rr = r & 15, cc = c & 31, ob = rr * 64 + cc * 2; return st * 1024 + (ob ^ (((ob >> 9) & 1) << 5)); }
__host__ __device__ __forceinline__ void stage_rc(int b, int& R, int& C) { const int st = b / 1024, sb = b % 1024, swz = sb ^ (((sb >> 9) & 1) << 5); R = (st >> 1) * 16 + swz / 64; C = (st & 1) * 32 + (swz % 64) / 2; }
__host__ __device__ __forceinline__ int perm32(int rho) { const int n = rho >> 4, i = rho & 15; return 8 * (i >> 2) + 4 * n + (i & 3); }
struct Unit { int pm, pn, koff; };
struct Gemm { const bf16_t* A; const bf16_t* Bt; int M, N, K, lda, ldb; };
struct StaticOrder {
    int nM, nN, nwg, G, c;
    __host__ __device__ void init(int M, int N, int G_, int c_) { nM = M / BM; nN = N / BM; nwg = nM * nN; G = G_; c = c_; }
    __host__ __device__ bool next(int i, Unit& u) const {
        const long L = (long)i * G + c; if (L >= nwg) return false;
        int wgid = (int)L; { const int q = nwg / NXCD, r = nwg % NXCD, xcd = wgid % NXCD, off = wgid / NXCD; wgid = (xcd < r ? xcd * (q + 1) : r * (q + 1) + (xcd - r) * q) + off; }
        const int nig = WGM * nN, gid = wgid / nig, fm = gid * WGM, gsz = (nM - fm) < WGM ? (nM - fm) : WGM;
        u.pm = fm + ((wgid % nig) % gsz); u.pn = (wgid % nig) / gsz; u.koff = 0; return true;
    }
    __device__ __forceinline__ void a_ready(const Unit&) const {}
    __device__ __forceinline__ void done(const Unit&) const {}
};
struct CmpOrder {
    int G, c;
    __device__ bool next(int i, Unit& u) const { const long L = (long)i * G + c; if (L >= 256) return false; u.pm = (int)L & 31; u.pn = u.pm >> 4; u.koff = ((int)L >> 5) * 512; return true; }
    __device__ __forceinline__ void a_ready(const Unit&) const {}
    __device__ __forceinline__ void done(const Unit&) const {}
};
__device__ __forceinline__ unsigned cvt_pk_bf16(float lo, float hi) { unsigned r; asm volatile("v_cvt_pk_bf16_f32 %0, %1, %2" : "=v"(r) : "v"(lo), "v"(hi)); return r; }
template <class Epi, class Sched, bool ALIGN_EPI = false, bool SP2 = false>
__device__ __forceinline__ void gemm_phase(PG8_LAS unsigned char* lds, const Gemm g, const Sched& S, const Epi& E) {
    const int tid = threadIdx.x, wid = __builtin_amdgcn_readfirstlane(tid >> 6), lane = tid & 63, wr = wid >> 2, wc = wid & 3, fr = lane & 15, fq = lane >> 4;
    const int K = g.K, nt = K / BK, lda = g.lda, ldb = g.ldb;
    unsigned voffA[2], voffB[2];
#pragma unroll
    for (int i = 0; i < 2; ++i) { int R, C; stage_rc(tid * 16 + i * 8192, R, C); const int Rb = Epi::PERM ? ((R & ~31) + perm32(R & 31)) : R;
        voffA[i] = (unsigned)(R * lda + C) * 2u; voffB[i] = (unsigned)(Rb * ldb + C) * 2u; }
    const size_t kstep = (size_t)(BK * 2);
    const size_t hstepA = (size_t)HALF * lda * 2, hstepB = (size_t)HALF * ldb * 2;
    const size_t tstepA = 2 * hstepA, tstepB = 2 * hstepB;
    const unsigned ldsw = (unsigned)wid * 1024u;
    const int aoff = lds_byte(wr * 64 + fr, fq * 8), boff = lds_byte(wc * 32 + fr, fq * 8);
#define PG8_SA(b, h) (((b) * 2 + (h)) * HTB)
#define PG8_SB(b, h) ((4 + (b) * 2 + (h)) * HTB)
#define PG8_STAGE(bufoff, gbase, voff) do { _Pragma("unroll") for (int _i = 0; _i < 2; ++_i) \
        __builtin_amdgcn_global_load_lds((const unsigned*)((const char*)(gbase) + (voff)[_i]), (PG8_LAS unsigned*)(lds + (bufoff) + ldsw + _i * 8192), 16, 0, 0); } while (0)
#define PG8_LDA(dst, b, h) do { _Pragma("unroll") for (int m = 0; m < 4; ++m) _Pragma("unroll") for (int k = 0; k < 2; ++k) dst[m][k] = *(const PG8_LAS bf16x8*)(lds + PG8_SA(b, h) + aoff + m * 2048 + k * 1024); } while (0)
#define PG8_LDB(dst, b, h) do { _Pragma("unroll") for (int n = 0; n < 2; ++n) _Pragma("unroll") for (int k = 0; k < 2; ++k) dst[n][k] = *(const PG8_LAS bf16x8*)(lds + PG8_SB(b, h) + boff + n * 2048 + k * 1024); } while (0)
#define PG8_MMA(ai, bj, At, Bt) do { __builtin_amdgcn_s_setprio(1); _Pragma("unroll") for (int m = 0; m < 4; ++m) _Pragma("unroll") for (int n = 0; n < 2; ++n) _Pragma("unroll") for (int k = 0; k < 2; ++k) \
        acc[ai][bj][m][n] = __builtin_amdgcn_mfma_f32_16x16x32_bf16(Bt[n][k], At[m][k], acc[ai][bj][m][n], 0, 0, 0); __builtin_amdgcn_s_setprio(0); } while (0)
#define PG8_WAIT_V(n) asm volatile("s_waitcnt vmcnt(" #n ")" ::: "memory")
#define PG8_WAIT_L(n) asm volatile("s_waitcnt lgkmcnt(" #n ")" ::: "memory")
#define PG8_BAR __builtin_amdgcn_s_barrier()
#define PG8_SCHED __builtin_amdgcn_sched_barrier(0)
    Unit cur, nxt; int ui = 0;
    if (!S.next(0, cur)) return;
    f32x4 acc[2][2][4][2];
#pragma unroll
    for (int a = 0; a < 2; ++a)
#pragma unroll
        for (int b = 0; b < 2; ++b)
#pragma unroll
            for (int m = 0; m < 4; ++m)
#pragma unroll
                for (int n = 0; n < 2; ++n) acc[a][b][m][n] = (f32x4){0.f, 0.f, 0.f, 0.f};
    bf16x8 At[4][2], B0[2][2], B1[2][2];
    const char* cA = (const char*)g.A + (size_t)cur.pm * tstepA + cur.koff; const char* cB = (const char*)g.Bt + (size_t)cur.pn * tstepB + cur.koff;
    S.a_ready(cur);
    if constexpr (SP2) {
        PG8_STAGE(PG8_SB(0, 0), cB, voffB); PG8_STAGE(PG8_SB(0, 1), cB + hstepB, voffB); PG8_STAGE(PG8_SA(0, 0), cA, voffA); PG8_STAGE(PG8_SA(0, 1), cA + hstepA, voffA);
        if (wr == 1) PG8_BAR;
        PG8_WAIT_V(2); PG8_BAR;
        PG8_STAGE(PG8_SB(1, 0), cB + kstep, voffB); PG8_STAGE(PG8_SA(1, 0), cA + kstep, voffA); PG8_STAGE(PG8_SB(1, 1), cB + hstepB + kstep, voffB);
        PG8_WAIT_V(6); PG8_BAR;
    } else {
        PG8_STAGE(PG8_SB(0, 0), cB, voffB); PG8_STAGE(PG8_SA(0, 0), cA, voffA); PG8_STAGE(PG8_SB(0, 1), cB + hstepB, voffB); PG8_STAGE(PG8_SA(0, 1), cA + hstepA, voffA);
        if (wr == 1) PG8_BAR;
        PG8_WAIT_V(4); PG8_BAR;
        PG8_STAGE(PG8_SB(1, 0), cB + kstep, voffB); PG8_STAGE(PG8_SA(1, 0), cA + kstep, voffA); PG8_STAGE(PG8_SB(1, 1), cB + hstepB + kstep, voffB);
        PG8_WAIT_V(6); PG8_BAR;
    }
    for (;;) {
        const bool has_next = S.next(ui + 1, nxt);
        const char* nA = has_next ? (const char*)g.A + (size_t)nxt.pm * tstepA + nxt.koff : cA; const char* nB = has_next ? (const char*)g.Bt + (size_t)nxt.pn * tstepB + nxt.koff : cB;
        for (int t = 0; t < nt; t += 2) {
            const bool last = (t == nt - 2);
            const char* a1 = cA + (size_t)(t + 1) * kstep;
            const char* a2 = last ? nA : cA + (size_t)(t + 2) * kstep; const char* b2 = last ? nB : cB + (size_t)(t + 2) * kstep;
            const char* a3 = a2 + kstep; const char* b3 = b2 + kstep;
            if (last && has_next) S.a_ready(nxt);
            if constexpr (SP2) {
            PG8_LDB(B0, 0, 0); PG8_LDB(B1, 0, 1); PG8_SCHED; PG8_LDA(At, 0, 0); PG8_STAGE(PG8_SA(1, 1), a1 + hstepA, voffA);
            PG8_WAIT_V(8); PG8_WAIT_L(0); PG8_BAR; PG8_MMA(0, 0, At, B0); PG8_MMA(0, 1, At, B1); PG8_BAR; PG8_SCHED;
            PG8_LDA(At, 0, 1); PG8_STAGE(PG8_SB(0, 0), b2, voffB); PG8_STAGE(PG8_SB(0, 1), b2 + hstepB, voffB); PG8_STAGE(PG8_SA(0, 0), a2, voffA);
            PG8_WAIT_V(8); PG8_WAIT_L(0); PG8_BAR; PG8_MMA(1, 0, At, B0); PG8_MMA(1, 1, At, B1); PG8_BAR; PG8_SCHED;
            PG8_LDB(B0, 1, 0); PG8_LDB(B1, 1, 1); PG8_SCHED; PG8_LDA(At, 1, 0); PG8_STAGE(PG8_SA(0, 1), a2 + hstepA, voffA);
            PG8_WAIT_V(8); PG8_WAIT_L(0); PG8_BAR; PG8_MMA(0, 0, At, B0); PG8_MMA(0, 1, At, B1); PG8_BAR; PG8_SCHED;
            PG8_LDA(At, 1, 1); PG8_STAGE(PG8_SB(1, 0), b3, voffB); PG8_STAGE(PG8_SB(1, 1), b3 + hstepB, voffB); PG8_STAGE(PG8_SA(1, 0), a3, voffA);
            PG8_WAIT_V(8); PG8_WAIT_L(0); PG8_BAR; PG8_MMA(1, 0, At, B0); PG8_MMA(1, 1, At, B1); PG8_BAR; PG8_SCHED;
            } else {
            PG8_LDB(B0, 0, 0); PG8_SCHED; PG8_LDA(At, 0, 0); PG8_STAGE(PG8_SA(1, 1), a1 + hstepA, voffA);
            PG8_WAIT_L(8); PG8_BAR; PG8_WAIT_L(0); PG8_MMA(0, 0, At, B0); PG8_BAR; PG8_SCHED;
            PG8_LDB(B1, 0, 1); PG8_STAGE(PG8_SB(0, 0), b2, voffB);
            PG8_BAR; PG8_WAIT_L(0); PG8_MMA(0, 1, At, B1); PG8_BAR;
            PG8_LDA(At, 0, 1); PG8_STAGE(PG8_SA(0, 0), a2, voffA);
            PG8_BAR; PG8_WAIT_L(0); PG8_MMA(1, 0, At, B0); PG8_BAR; PG8_SCHED;
            PG8_STAGE(PG8_SB(0, 1), b2 + hstepB, voffB);
            PG8_WAIT_V(6); PG8_BAR; PG8_MMA(1, 1, At, B1); PG8_BAR;
            PG8_LDB(B0, 1, 0); PG8_SCHED; PG8_LDA(At, 1, 0); PG8_STAGE(PG8_SA(0, 1), a2 + hstepA, voffA);
            PG8_WAIT_L(8); PG8_BAR; PG8_WAIT_L(0); PG8_MMA(0, 0, At, B0); PG8_BAR; PG8_SCHED;
            PG8_LDB(B1, 1, 1); PG8_STAGE(PG8_SB(1, 0), b3, voffB);
            PG8_BAR; PG8_WAIT_L(0); PG8_MMA(0, 1, At, B1); PG8_BAR;
            PG8_LDA(At, 1, 1); PG8_STAGE(PG8_SA(1, 0), a3, voffA);
            PG8_BAR; PG8_WAIT_L(0); PG8_MMA(1, 0, At, B0); PG8_BAR; PG8_SCHED;
            PG8_STAGE(PG8_SB(1, 1), b3 + hstepB, voffB);
            PG8_WAIT_V(6); PG8_BAR; PG8_MMA(1, 1, At, B1); PG8_BAR;
            }
        }
        if constexpr (ALIGN_EPI) { if (wr == 0) PG8_BAR; }
        if constexpr (!Epi::AFTER_DRAIN) { E(acc, cur, wr, wc, fr, fq); S.done(cur); }
        if (!has_next) break;
#pragma unroll
        for (int a = 0; a < 2; ++a)
#pragma unroll
            for (int b = 0; b < 2; ++b)
#pragma unroll
                for (int m = 0; m < 4; ++m)
#pragma unroll
                    for (int n = 0; n < 2; ++n) acc[a][b][m][n] = (f32x4){0.f, 0.f, 0.f, 0.f};
        cur = nxt; cA = nA; cB = nB; ++ui;
        if constexpr (ALIGN_EPI) { if (wr == 1) PG8_BAR; }
    }
    PG8_WAIT_V(0);
    if constexpr (!ALIGN_EPI) { if (wr == 0) PG8_BAR; }
    PG8_BAR;
    if constexpr (Epi::AFTER_DRAIN) { E.fused(acc, cur, wr, wc, fr, fq, lds, wid, lane); S.done(cur); }
#undef PG8_SA
#undef PG8_SB
#undef PG8_STAGE
#undef PG8_LDA
#undef PG8_LDB
#undef PG8_MMA
#undef PG8_WAIT_V
#undef PG8_WAIT_L
#undef PG8_BAR
#undef PG8_SCHED
}
}

constexpr int T = 32768, S = 2048, DM = 1024, NIN = 2560, FF = 4096;
constexpr float EPS = 1e-6f;
constexpr float QSCALE = 0.125f * 1.4426950408889634f;
constexpr size_t MiB = 1u << 20;
constexpr size_t WS_WIN = 1 * MiB, WS_WOUT = 6 * MiB, WS_WFF1 = 8 * MiB, WS_WFF2 = 16 * MiB, WS_W1T = 24 * MiB;
constexpr size_t WS_WSP = 26 * MiB + 768 * 1024;
constexpr size_t WS_C1 = 26 * MiB, WS_ROPEC = 26 * MiB + 64 * 1024, WS_ROPES = 26 * MiB + 320 * 1024;
constexpr size_t WS_RINV1 = 27 * MiB, WS_SSQP = 27 * MiB + 512 * 1024, WS_GATES = 30 * MiB;
constexpr size_t WS_KCMP = 33 * MiB, WS_VCMPT = 33 * MiB + 512 * 1024, WS_HID = 34 * MiB, WS_X2B = 38 * MiB;
constexpr size_t WS_XB = 102 * MiB, WS_QN = 166 * MiB, WS_QR = 198 * MiB, WS_KC = 230 * MiB, WS_VC = 238 * MiB;
constexpr size_t WS_KSL = 246 * MiB, WS_VSLT = 254 * MiB, WS_KWN = 262 * MiB, WS_VWNT = 270 * MiB, WS_ZU = 278 * MiB, WS_ZVT = 310 * MiB, WS_O = 342 * MiB;
constexpr size_t WS_H = 102 * MiB, WS_END = 406 * MiB;
constexpr size_t WS_PART = WS_X2B;
constexpr size_t WS_C1P = 26 * MiB + 576 * 1024;
constexpr int LDS_BYTES = 147456;
constexpr int NWAVES = 8;

struct Args { const float* in[16]; float* out; unsigned char* ws; int ph_lo, ph_hi; };

__device__ __forceinline__ float bf2f(bf16_t h) { return __uint_as_float(((unsigned)h) << 16); }
__device__ __forceinline__ unsigned f2bf(float f) { unsigned u = __float_as_uint(f); return (u + 0x7fffu + ((u >> 16) & 1u)) >> 16; }
__device__ __forceinline__ unsigned pk2(float lo, float hi) { return pg8::cvt_pk_bf16(lo, hi); }
__device__ __forceinline__ float wave_sum(float v) {
#pragma unroll
    for (int o = 1; o < 64; o <<= 1) v += __shfl_xor(v, o);
    return v;
}
__device__ __forceinline__ float wave_max(float v) {
#pragma unroll
    for (int o = 1; o < 64; o <<= 1) v = fmaxf(v, __shfl_xor(v, o));
    return v;
}
__device__ __forceinline__ float gelu_tanh(float x) {
    const float u = 0.7978845608028654f * (x + 0.044715f * x * x * x);
    return x / (1.f + __expf(-2.f * u));
}
__device__ __forceinline__ void store8(bf16_t* p, const float* v) {
    u32x4 w; w.x = pk2(v[0], v[1]); w.y = pk2(v[2], v[3]); w.z = pk2(v[4], v[5]); w.w = pk2(v[6], v[7]);
    *(u32x4*)p = w;
}
__device__ __forceinline__ void load8(const bf16_t* p, float* v) {
    const u32x4 w = *(const u32x4*)p;
    v[0] = __uint_as_float(w.x << 16); v[1] = __uint_as_float(w.x & 0xffff0000u);
    v[2] = __uint_as_float(w.y << 16); v[3] = __uint_as_float(w.y & 0xffff0000u);
    v[4] = __uint_as_float(w.z << 16); v[5] = __uint_as_float(w.z & 0xffff0000u);
    v[6] = __uint_as_float(w.w << 16); v[7] = __uint_as_float(w.w & 0xffff0000u);
}
__device__ __forceinline__ float head_ssq(const float (&v)[16]) {
    float s = 0.f;
#pragma unroll
    for (int i = 0; i < 16; ++i) s += v[i] * v[i];
    s += __shfl_xor(s, 16); s += __shfl_xor(s, 32);
    return s;
}

struct EpiInProj {
    static constexpr bool PERM = true, AFTER_DRAIN = false;
    const float *rinv1, *g_q, *g_k, *g_sgu, *ropec, *ropes;
    bf16_t *qn, *qr, *kc, *vc, *ksl, *vslT, *kwn, *vwnT, *zu, *zvT; float* gates;
    __device__ __forceinline__ void operator()(const f32x4 (&acc)[2][2][4][2], const pg8::Unit& u, int wr, int wc, int fr, int fq) const {
        const int cs = u.pn * 4 + wc;
        if (cs >= 37) return;
        const int d0 = 8 * fq;
        float rsv[2][4];
#pragma unroll
        for (int ai = 0; ai < 2; ++ai)
#pragma unroll
            for (int m = 0; m < 4; ++m) rsv[ai][m] = rinv1[u.pm * 256 + ai * 128 + wr * 64 + m * 16 + fr];
#pragma unroll
        for (int ai = 0; ai < 2; ++ai)
#pragma unroll
            for (int m = 0; m < 4; ++m) {
                const int row = u.pm * 256 + ai * 128 + wr * 64 + m * 16 + fr;
                const float rs = rsv[ai][m];
                float v[16];
#pragma unroll
                for (int bj = 0; bj < 2; ++bj)
#pragma unroll
                    for (int n = 0; n < 2; ++n)
#pragma unroll
                        for (int e = 0; e < 4; ++e) v[bj * 8 + n * 4 + e] = acc[ai][bj][m][n][e] * rs;
                const int b = row >> 11, s = row & 2047;
                if (cs < 8 || cs == 12 || cs == 13 || cs == 16 || cs == 17) {
                    const float* gg = cs < 8 ? g_q : (cs < 14 ? g_k + 64 : g_k + 128);
                    const float rn = rsqrtf(head_ssq(v) * (1.f / 64.f) + EPS) * (cs < 8 ? QSCALE : 1.f);
                    float y[16];
#pragma unroll
                    for (int i = 0; i < 16; ++i) y[i] = v[i] * rn * gg[32 * (i >> 3) + d0 + (i & 7)];
                    float r1[8], r2[8];
#pragma unroll
                    for (int i = 0; i < 8; ++i) { int di = d0 + i; asm volatile("" : "+v"(di));
                        const float frev = __builtin_amdgcn_exp2f(-(float)di * (13.287712379549449f / 32.f)) * 0.15915494309189535f;
                        float xr = (float)s * frev; xr -= __builtin_rintf(xr);
                        const float c = __builtin_amdgcn_cosf(xr), sn = __builtin_amdgcn_sinf(xr); r1[i] = y[i] * c - y[8 + i] * sn; r2[i] = y[8 + i] * c + y[i] * sn; }
                    if (cs < 8) {
                        bf16_t* p = qn + (size_t)row * 512 + cs * 64 + d0; store8(p, y); store8(p + 32, y + 8);
                        bf16_t* p2 = qr + (size_t)row * 512 + cs * 64 + d0; store8(p2, r1); store8(p2 + 32, r2);
                    } else {
                        bf16_t* p = (cs < 14 ? ksl : kwn) + ((size_t)(b * 2 + (cs & 1)) * 2048 + s) * 64 + d0; store8(p, r1); store8(p + 32, r2);
                    }
                } else if (cs < 12) {
                    bf16_t* p = (cs < 10 ? kc : vc) + ((size_t)(b * 2 + (cs & 1)) * 2048 + s) * 64 + d0; store8(p, v); store8(p + 32, v + 8);
                } else if (cs < 20) {
                    bf16_t* p = (cs < 16 ? vslT : vwnT) + ((size_t)(b * 2 + (cs & 1)) * 32 + (s >> 6)) * 4096 + (s & 63);
#pragma unroll
                    for (int i = 0; i < 16; ++i) p[(32 * (i >> 3) + d0 + (i & 7)) * 64] = (bf16_t)f2bf(v[i]);
                } else if (cs < 28) {
                    float y[16];
#pragma unroll
                    for (int i = 0; i < 16; ++i) y[i] = gelu_tanh(v[i]);
                    bf16_t* p = zu + (size_t)row * 512 + (cs - 20) * 64 + d0; store8(p, y); store8(p + 32, y + 8);
                } else if (cs < 36) {
                    const int g = cs - 28;
                    float y[16];
#pragma unroll
                    for (int i = 0; i < 16; ++i) y[i] = gelu_tanh(v[i]);
                    const float rn = rsqrtf(head_ssq(y) * (1.f / 64.f) + EPS);
                    bf16_t* p = zvT + (((size_t)b * 16 + (s >> 7)) * 8 + g) * 8192 + (s & 127);
#pragma unroll
                    for (int i = 0; i < 16; ++i) { const int d = 32 * (i >> 3) + d0 + (i & 7); p[d * 128] = (bf16_t)f2bf(y[i] * rn * g_sgu[g * 64 + d]); }
                } else {
                    if (fq < 3) {
#pragma unroll
                        for (int i = 0; i < 8; ++i) gates[(size_t)row * 24 + d0 + i] = 1.f / (1.f + __expf(-v[i]));
                    }
                }
            }
    }
};

struct EpiPart {
    static constexpr bool PERM = true, AFTER_DRAIN = false;
    float* part;
    __device__ __forceinline__ void operator()(const f32x4 (&acc)[2][2][4][2], const pg8::Unit& u, int wr, int wc, int fr, int fq) const {
        float* base = part + (size_t)(u.koff >> 9) * 8192 * 256;
#pragma unroll
        for (int ai = 0; ai < 2; ++ai)
#pragma unroll
            for (int m = 0; m < 4; ++m) {
                const int row = u.pm * 256 + ai * 128 + wr * 64 + m * 16 + fr;
#pragma unroll
                for (int bj = 0; bj < 2; ++bj) {
                    float* p = base + (size_t)row * 256 + 128 * bj + 32 * wc + 8 * fq;
                    *(f32x4*)p = acc[ai][bj][m][0]; *(f32x4*)(p + 4) = acc[ai][bj][m][1];
                }
            }
    }
};

struct EpiWout {
    static constexpr bool PERM = true, AFTER_DRAIN = false;
    const bf16_t* xb; bf16_t* x2b; float* ssqp; LAS float* red;
    __device__ __forceinline__ void operator()(const f32x4 (&acc)[2][2][4][2], const pg8::Unit& u, int wr, int wc, int fr, int fq) const {
        u32x4 xr[2][4][2];
#pragma unroll
        for (int ai = 0; ai < 2; ++ai)
#pragma unroll
            for (int m = 0; m < 4; ++m)
#pragma unroll
                for (int bj = 0; bj < 2; ++bj)
                    xr[ai][m][bj] = *(const u32x4*)(xb + (size_t)(u.pm * 256 + ai * 128 + wr * 64 + m * 16 + fr) * DM + u.pn * 256 + 128 * bj + 32 * wc + 8 * fq);
        __builtin_amdgcn_sched_barrier(0);
#pragma unroll
        for (int ai = 0; ai < 2; ++ai)
#pragma unroll
            for (int m = 0; m < 4; ++m) {
                const int row = u.pm * 256 + ai * 128 + wr * 64 + m * 16 + fr;
                float ss = 0.f;
#pragma unroll
                for (int bj = 0; bj < 2; ++bj) {
                    const size_t off = (size_t)row * DM + u.pn * 256 + 128 * bj + 32 * wc + 8 * fq;
                    const u32x4 w = xr[ai][m][bj];
                    float y[8];
                    y[0] = __uint_as_float(w.x << 16) + acc[ai][bj][m][0].x; y[1] = __uint_as_float(w.x & 0xffff0000u) + acc[ai][bj][m][0].y;
                    y[2] = __uint_as_float(w.y << 16) + acc[ai][bj][m][0].z; y[3] = __uint_as_float(w.y & 0xffff0000u) + acc[ai][bj][m][0].w;
                    y[4] = __uint_as_float(w.z << 16) + acc[ai][bj][m][1].x; y[5] = __uint_as_float(w.z & 0xffff0000u) + acc[ai][bj][m][1].y;
                    y[6] = __uint_as_float(w.w << 16) + acc[ai][bj][m][1].z; y[7] = __uint_as_float(w.w & 0xffff0000u) + acc[ai][bj][m][1].w;
                    store8(x2b + off, y);
#pragma unroll
                    for (int i = 0; i < 8; ++i) ss += y[i] * y[i];
                }
                ss += __shfl_xor(ss, 16); ss += __shfl_xor(ss, 32);
                if (fq == 0) red[wc * 256 + (row & 255)] = ss;
            }
        __syncthreads();
        { const int tid = threadIdx.x;
          if (tid < 256) ssqp[(size_t)(u.pm * 256 + tid) * 4 + u.pn] = (red[tid] + red[256 + tid]) + (red[512 + tid] + red[768 + tid]); }
    }
};

struct EpiFF1 {
    static constexpr bool PERM = true, AFTER_DRAIN = false;
    const float* ssqp; bf16_t* H;
    __device__ __forceinline__ void operator()(const f32x4 (&acc)[2][2][4][2], const pg8::Unit& u, int wr, int wc, int fr, int fq) const {
        f32x4 sq[2][4];
#pragma unroll
        for (int ai = 0; ai < 2; ++ai)
#pragma unroll
            for (int m = 0; m < 4; ++m) sq[ai][m] = *(const f32x4*)(ssqp + (size_t)(u.pm * 256 + ai * 128 + wr * 64 + m * 16 + fr) * 4);
        __builtin_amdgcn_sched_barrier(0);
#pragma unroll
        for (int ai = 0; ai < 2; ++ai)
#pragma unroll
            for (int m = 0; m < 4; ++m) {
                const int row = u.pm * 256 + ai * 128 + wr * 64 + m * 16 + fr;
                const float tot = (sq[ai][m].x + sq[ai][m].y) + (sq[ai][m].z + sq[ai][m].w);
                const float rn = rsqrtf(tot * (1.f / 1024.f) + EPS);
#pragma unroll
                for (int bj = 0; bj < 2; ++bj) {
                    float y[8];
#pragma unroll
                    for (int n = 0; n < 2; ++n)
#pragma unroll
                        for (int e = 0; e < 4; ++e) { const float h = fmaxf(acc[ai][bj][m][n][e] * rn, 0.f); y[n * 4 + e] = h * h; }
                    store8(H + (size_t)row * FF + u.pn * 256 + 128 * bj + 32 * wc + 8 * fq, y);
                }
            }
    }
};

struct EpiFF2 {
    static constexpr bool PERM = true, AFTER_DRAIN = false;
    const bf16_t* x2b; float* out;
    __device__ __forceinline__ void operator()(const f32x4 (&acc)[2][2][4][2], const pg8::Unit& u, int wr, int wc, int fr, int fq) const {
        u32x4 xr[2][4][2];
#pragma unroll
        for (int ai = 0; ai < 2; ++ai)
#pragma unroll
            for (int m = 0; m < 4; ++m)
#pragma unroll
                for (int bj = 0; bj < 2; ++bj)
                    xr[ai][m][bj] = *(const u32x4*)(x2b + (size_t)(u.pm * 256 + ai * 128 + wr * 64 + m * 16 + fr) * DM + u.pn * 256 + 128 * bj + 32 * wc + 8 * fq);
        __builtin_amdgcn_sched_barrier(0);
#pragma unroll
        for (int ai = 0; ai < 2; ++ai)
#pragma unroll
            for (int m = 0; m < 4; ++m) {
                const int row = u.pm * 256 + ai * 128 + wr * 64 + m * 16 + fr;
#pragma unroll
                for (int bj = 0; bj < 2; ++bj) {
                    const size_t off = (size_t)row * DM + u.pn * 256 + 128 * bj + 32 * wc + 8 * fq;
                    const u32x4 w = xr[ai][m][bj];
                    f32x4 ya = acc[ai][bj][m][0], yb = acc[ai][bj][m][1];
                    ya.x += __uint_as_float(w.x << 16); ya.y += __uint_as_float(w.x & 0xffff0000u); ya.z += __uint_as_float(w.y << 16); ya.w += __uint_as_float(w.y & 0xffff0000u);
                    yb.x += __uint_as_float(w.z << 16); yb.y += __uint_as_float(w.z & 0xffff0000u); yb.z += __uint_as_float(w.w << 16); yb.w += __uint_as_float(w.w & 0xffff0000u);
                    *(f32x4*)(out + off) = ya; *(f32x4*)(out + off + 4) = yb;
                }
            }
    }
};

__device__ __forceinline__ int win_src_col(int nphys) {
    const int pn = nphys >> 8, Pp = nphys & 255, bj = Pp >> 7, wc = (Pp & 127) >> 5, r = Pp & 31;
    const int lc = (pn << 8) + 64 * wc + 32 * bj + r;
    if (lc < 1280) return lc;
    if (lc < 2304) return lc + 24;
    if (lc < 2328) return lc - 1024;
    return -1;
}
template <int MAP>
__device__ __forceinline__ void transpose_item(const float* W, int K, int N, bf16_t* WT, const float* gk, LAS float* scr, int item, int nblk, int lane) {
    const int kb = item / nblk, nb = item % nblk, k0 = 64 * kb, n0 = 32 * nb;
    const int src = MAP ? win_src_col(n0 + (lane & 31)) : n0 + (lane & 31);
    float tv[32];
#pragma unroll
    for (int i = 0; i < 32; ++i) { const int kk = 2 * i + (lane >> 5); tv[i] = (src >= 0) ? W[(size_t)(k0 + kk) * N + src] : 0.f; }
    if (gk) {
#pragma unroll
        for (int i = 0; i < 32; ++i) tv[i] *= gk[k0 + 2 * i + (lane >> 5)]; }
#pragma unroll
    for (int i = 0; i < 32; ++i) scr[(2 * i + (lane >> 5)) * 33 + (lane & 31)] = tv[i];
    asm volatile("s_waitcnt lgkmcnt(0)" ::: "memory");
    const int c = lane & 7;
#pragma unroll
    for (int j = 0; j < 4; ++j) { const int n = (lane >> 3) + 8 * j; const LAS float* s = scr + (8 * c) * 33 + n;
        u32x4 o; o.x = pk2(s[0 * 33], s[1 * 33]); o.y = pk2(s[2 * 33], s[3 * 33]); o.z = pk2(s[4 * 33], s[5 * 33]); o.w = pk2(s[6 * 33], s[7 * 33]);
        *(u32x4*)(WT + (size_t)(n0 + n) * K + k0 + 8 * c) = o; }
    asm volatile("s_waitcnt lgkmcnt(0)" ::: "memory");
}

__device__ __forceinline__ void phase0(const Args& a, LAS unsigned char* lds) {
    const int tid = threadIdx.x, lane = tid & 63, wave = tid >> 6;
    unsigned char* ws = a.ws;
    LAS float* scr = (LAS float*)(lds + wave * 16384);
    const int gw = blockIdx.x * NWAVES + wave, NGW = gridDim.x * NWAVES;
    constexpr int I_IN = 16 * 80, I_C = 32 * 8;
    constexpr int NITEMS = I_IN + 2 * I_C;
    for (int it = gw; it < NITEMS; it += NGW) {
        int r = it;
        if (r < I_IN) { transpose_item<1>(a.in[2], 1024, 2328, (bf16_t*)(ws + WS_WIN), a.in[1], scr, r, 80, lane); continue; } r -= I_IN;
        if (r < I_C) { transpose_item<0>(a.in[6], 2048, 256, (bf16_t*)(ws + WS_W1T), nullptr, scr, r, 8, lane); continue; } r -= I_C;
        transpose_item<0>(a.in[6] + (size_t)2048 * 256, 2048, 256, (bf16_t*)(ws + WS_W1T) + (size_t)256 * 2048, nullptr, scr, r, 8, lane);
    }
    {
        const float* x = a.in[0]; bf16_t* xb = (bf16_t*)(ws + WS_XB); float* rinv1 = (float*)(ws + WS_RINV1);
        for (int m = gw; m < T; m += 2 * NGW) {
            const int m2 = m + NGW;
            const bool has2 = m2 < T;
            const f32x4* xr = (const f32x4*)(x + (size_t)m * DM) + lane;
            const f32x4* xr2 = (const f32x4*)(x + (size_t)(has2 ? m2 : m) * DM) + lane;
            f32x4 v[4], u[4]; float s = 0.f, s2 = 0.f;
#pragma unroll
            for (int j = 0; j < 4; ++j) { v[j] = xr[64 * j]; u[j] = xr2[64 * j]; }
#pragma unroll
            for (int j = 0; j < 4; ++j) { s += (v[j].x * v[j].x + v[j].y * v[j].y) + (v[j].z * v[j].z + v[j].w * v[j].w); s2 += (u[j].x * u[j].x + u[j].y * u[j].y) + (u[j].z * u[j].z + u[j].w * u[j].w); }
            s = wave_sum(s); s2 = wave_sum(s2);
            if (lane == 0) { rinv1[m] = rsqrtf(s * (1.f / 1024.f) + EPS); if (has2) rinv1[m2] = rsqrtf(s2 * (1.f / 1024.f) + EPS); }
            unsigned long long* o8 = (unsigned long long*)(xb + (size_t)m * DM) + lane;
#pragma unroll
            for (int j = 0; j < 4; ++j) o8[64 * j] = (unsigned long long)pk2(v[j].x, v[j].y) | ((unsigned long long)pk2(v[j].z, v[j].w) << 32);
            if (has2) { unsigned long long* o82 = (unsigned long long*)(xb + (size_t)m2 * DM) + lane;
#pragma unroll
                for (int j = 0; j < 4; ++j) o82[64 * j] = (unsigned long long)pk2(u[j].x, u[j].y) | ((unsigned long long)pk2(u[j].z, u[j].w) << 32); }
        }
    }
    {
        bf16_t* Wsp = (bf16_t*)(ws + WS_WSP); const float* spw = a.in[9];
        for (int idx = blockIdx.x * 512 + tid; idx < 8 * 128 * 128; idx += gridDim.x * 512) { const int tq = (idx >> 7) & 127, sq = idx & 127; Wsp[idx] = (bf16_t)f2bf(sq <= tq ? spw[idx] : 0.f); }
    }
    {
        if ((gw & 3) == 0 && (gw >> 2) < 512) {
            const int item = gw >> 2, kv = item >> 8, cg4 = (item >> 6) & 3, kch = item & 63;
            const float* pe = a.in[5] + kv * 2048 + kch * 32; const float* w1 = a.in[6] + ((size_t)kv * 2048 + kch * 32) * 256 + cg4 * 64 + lane;
            float wv[32];
#pragma unroll
            for (int k = 0; k < 32; ++k) wv[k] = w1[(size_t)k * 256];
            float acc = 0.f;
#pragma unroll
            for (int k = 0; k < 32; ++k) acc += pe[k] * wv[k];
            ((float*)(ws + WS_C1P))[kch * 512 + kv * 256 + cg4 * 64 + lane] = acc;
        }
    }
}

__device__ __forceinline__ void phase3(const Args& a, LAS unsigned char* lds) {
    const int tid = threadIdx.x, lane = tid & 63, wave = tid >> 6;
    unsigned char* ws = a.ws;
    const float* part = (const float*)(ws + WS_PART); const float* c1p = (const float*)(ws + WS_C1P);
    bf16_t* kcmp = (bf16_t*)(ws + WS_KCMP); bf16_t* vcmpT = (bf16_t*)(ws + WS_VCMPT);
    LAS float* w2s = (LAS float*)lds;
    LAS float* c1s = w2s + 256 * 64;
    LAS float* hids = c1s + 256;
    const int nchunk = 8192 / 32;
    for (int item = blockIdx.x; item < nchunk; item += gridDim.x) {
        const int kv = (item * 32) >> 12;
        __syncthreads();
        { const f32x4* src = (const f32x4*)(a.in[7] + (size_t)kv * 256 * 64);
#pragma unroll
          for (int i = 0; i < 8; ++i) ((LAS f32x4*)w2s)[tid + 512 * i] = src[tid + 512 * i]; }
        if (tid < 256) { float t = 0.f;
#pragma unroll
            for (int kch = 0; kch < 64; ++kch) t += c1p[kch * 512 + kv * 256 + tid];
            c1s[tid] = t; }
        __syncthreads();
#pragma unroll 1
        for (int rr = 0; rr < 4; ++rr) {
            const int R = item * 32 + wave * 4 + rr, bh = (R >> 7) & 31, n = R & 127;
            f32x4 h4 = *(const LAS f32x4*)(c1s + 4 * lane);
#pragma unroll
            for (int kc = 0; kc < 8; ++kc) h4 += *(const f32x4*)(part + ((size_t)kc * 8192 + R) * 256 + 4 * lane);
            h4.x = gelu_tanh(h4.x); h4.y = gelu_tanh(h4.y); h4.z = gelu_tanh(h4.z); h4.w = gelu_tanh(h4.w);
            *(LAS f32x4*)(hids + wave * 256 + 4 * lane) = h4;
            asm volatile("s_waitcnt lgkmcnt(0)" ::: "memory");
            float acc = 0.f;
#pragma unroll 8
            for (int c = 0; c < 256; ++c) acc += hids[wave * 256 + c] * w2s[c * 64 + lane];
            if (kv == 0) {
                const float ss = wave_sum(acc * acc);
                const float y = acc * rsqrtf(ss * (1.f / 64.f) + EPS) * a.in[4][lane];
                kcmp[((size_t)bh * 128 + n) * 64 + lane] = (bf16_t)f2bf(n < 127 ? y : 0.f);
            } else {
                vcmpT[((size_t)bh * 64 + lane) * 128 + n] = (bf16_t)f2bf(n < 127 ? acc : 0.f);
            }
        }
    }
    {
        LAS float* scr = (LAS float*)(lds + 77824 + wave * 8704);
        const int gw = blockIdx.x * NWAVES + wave, NGW = gridDim.x * NWAVES;
        constexpr int I_O = 16 * 32, I_1 = 16 * 128, I_2 = 64 * 32;
        for (int it = gw; it < I_O + I_1 + I_2; it += NGW) {
            int r = it;
            if (r < I_O) { transpose_item<0>(a.in[12], 1024, 1024, (bf16_t*)(ws + WS_WOUT), a.in[11], scr, r, 32, lane); continue; } r -= I_O;
            if (r < I_1) { transpose_item<0>(a.in[14], 1024, 4096, (bf16_t*)(ws + WS_WFF1), a.in[13], scr, r, 128, lane); continue; } r -= I_1;
            transpose_item<0>(a.in[15], 4096, 1024, (bf16_t*)(ws + WS_WFF2), nullptr, scr, r, 32, lane);
        }
    }
}

typedef short bf16x8_t __attribute__((ext_vector_type(8)));
typedef short s16x4_t __attribute__((ext_vector_type(4)));
typedef float f32x16 __attribute__((ext_vector_type(16)));
typedef __bf16 bf16x2_t __attribute__((ext_vector_type(2)));
typedef float f32x2_t __attribute__((ext_vector_type(2)));
typedef unsigned u32x2 __attribute__((ext_vector_type(2)));
#define MFMA32(a, b, c) __builtin_amdgcn_mfma_f32_32x32x16_bf16((a), (b), (c), 0, 0, 0)
__device__ __forceinline__ unsigned cvtpk(float lo, float hi) { f32x2_t v = {lo, hi}; bf16x2_t b = __builtin_convertvector(v, bf16x2_t); return __builtin_bit_cast(unsigned, b); }
__device__ __forceinline__ float ex2(float x) { return __builtin_amdgcn_exp2f(x); }
__device__ __forceinline__ f32x16 zero16() { f32x16 z;
#pragma unroll
    for (int i = 0; i < 16; ++i) z[i] = 0.f; return z; }
__device__ __forceinline__ bf16x8_t pack8(const f32x16& x, int s8) {
    u32x4 w; w.x = cvtpk(x[s8 + 0], x[s8 + 1]); w.y = cvtpk(x[s8 + 2], x[s8 + 3]); w.z = cvtpk(x[s8 + 4], x[s8 + 5]); w.w = cvtpk(x[s8 + 6], x[s8 + 7]);
    return __builtin_bit_cast(bf16x8_t, w);
}
constexpr int A_KSTR = 144, A_VSTR = 136, A_CVSTR = 264, A_IMPSTR = 33;
constexpr int A_KT = 128 * A_KSTR, A_VT = 64 * A_CVSTR;
constexpr int A_KBUF = 0, A_VBUF = 2 * A_KT, A_CMPK = A_VBUF + 2 * A_VT, A_CMPV = A_CMPK + 18432, A_IMP = A_CMPV + 16896, A_SELM = A_IMP + 4 * 64 * A_IMPSTR * 4, A_SSQ = A_SELM + 256, A_END = A_SSQ + 4096;
static_assert(A_END <= LDS_BYTES - 64, "attention LDS map");

template <int MODE>
__device__ __forceinline__ void attn_tile(const LAS unsigned char* Kb, const LAS unsigned char* Vb, const bf16x8_t (&qf)[4], f32x16 (&oacc)[2], float& l_run,
                                          int r, int h, int dlt0, int dlt1, bool hiw) {
    const unsigned ulim = (MODE == 0) ? 0x80000000u : 512u;
    float ls = 0.f;
#pragma unroll
    for (int mt = 0; mt < 4; ++mt) {
        if (mt == 0) { if (hiw) __builtin_amdgcn_s_setprio(1); else __builtin_amdgcn_s_setprio(0); }
        if (mt == 2) { if (hiw) __builtin_amdgcn_s_setprio(0); else __builtin_amdgcn_s_setprio(1); }
        f32x16 sacc = zero16();
#pragma unroll
        for (int ks = 0; ks < 4; ++ks) { const bf16x8_t ka = *(const LAS bf16x8_t*)(Kb + (32 * mt + r) * A_KSTR + 32 * ks + 16 * h); sacc = MFMA32(ka, qf[ks], sacc); }
        const int dl = mt < 2 ? dlt0 : dlt1;
#pragma unroll
        for (int i = 0; i < 16; ++i) {
            float p;
            if (MODE == 2) p = ex2(sacc[i]);
            else { const int ci = 32 * mt + (i & 3) + 8 * (i >> 2); p = ((unsigned)(dl - ci) < ulim) ? ex2(sacc[i]) : 0.f; }
            sacc[i] = p; ls += p;
        }
#pragma unroll
        for (int s = 0; s < 2; ++s) {
            const bf16x8_t pf = pack8(sacc, 8 * s);
#pragma unroll
            for (int dt = 0; dt < 2; ++dt) {
                const LAS unsigned char* vp = Vb + (32 * dt + r) * A_CVSTR + (32 * mt + 16 * s + 4 * h) * 2;
                const s16x4_t lo = *(const LAS s16x4_t*)vp, hi = *(const LAS s16x4_t*)(vp + 16);
                oacc[dt] = MFMA32(__builtin_shufflevector(lo, hi, 0, 1, 2, 3, 4, 5, 6, 7), pf, oacc[dt]);
            }
        }
    }
    l_run += ls;
}

__device__ __forceinline__ void phase4_attn(const Args& a, LAS unsigned char* lds) {
    const int tid0 = threadIdx.x, w = __builtin_amdgcn_readfirstlane(tid0 >> 6), g = w >> 1, half = w & 1;
    unsigned char* ws = a.ws;
    const bf16_t* qn = (const bf16_t*)(ws + WS_QN); const bf16_t* qr = (const bf16_t*)(ws + WS_QR);
    const bf16_t* kcmp = (const bf16_t*)(ws + WS_KCMP); const bf16_t* vcmpT = (const bf16_t*)(ws + WS_VCMPT);
    const bf16_t* ksl = (const bf16_t*)(ws + WS_KSL); const bf16_t* vslT = (const bf16_t*)(ws + WS_VSLT);
    const bf16_t* kwn = (const bf16_t*)(ws + WS_KWN); const bf16_t* vwnT = (const bf16_t*)(ws + WS_VWNT);
    const float* gates = (const float*)(ws + WS_GATES);
    bf16_t* o = (bf16_t*)(ws + WS_O);
    LAS float* IMP = (LAS float*)(lds + A_IMP); LAS unsigned* SELM = (LAS unsigned*)(lds + A_SELM); LAS float* SSQ = (LAS float*)(lds + A_SSQ);
    for (int pr = blockIdx.x; pr < 256; pr += gridDim.x) {
        const int b = pr >> 4, tt0 = pr & 15;
#pragma unroll 1
        for (int it = 0; it < 2; ++it) {
            const int t = it ? 31 - tt0 : tt0;
            f32x16 comb[2][2];
#pragma unroll
            for (int hkv = 0; hkv < 2; ++hkv) {
                const int bh = b * 2 + hkv, head = hkv * 4 + g;
                int tid = tid0; asm volatile("" : "+v"(tid));
                const int lane = tid & 63, r = lane & 31, h = lane >> 5, ql = 32 * half + r, pos = 64 * t + ql, tok = b * 2048 + pos;
                comb[hkv][0] = zero16(); comb[hkv][1] = zero16();
                const float g0 = gates[(size_t)tok * 24 + head * 3 + 0], g1 = gates[(size_t)tok * 24 + head * 3 + 1], g2 = gates[(size_t)tok * 24 + head * 3 + 2];
                __syncthreads();
                {
                    const bf16_t* kc = kcmp + (size_t)bh * 128 * 64; const bf16_t* vc = vcmpT + (size_t)bh * 64 * 128;
#pragma unroll
                    for (int i = 0; i < 2; ++i) { const int c = tid + 512 * i;
                        const u32x4 kv = *(const u32x4*)(kc + (size_t)c * 8);
                        *(LAS u32x4*)(lds + A_CMPK + (c >> 3) * A_KSTR + (c & 7) * 16) = kv;
                        const u32x4 vv = *(const u32x4*)(vc + (size_t)c * 8);
                        LAS unsigned char* vp = lds + A_CMPV + (c >> 4) * A_CVSTR + (c & 15) * 16;
                        *(LAS u32x2*)vp = (u32x2){vv.x, vv.y}; *(LAS u32x2*)(vp + 8) = (u32x2){vv.z, vv.w}; }
                }
                bf16x8_t qf[4];
#pragma unroll
                for (int ks = 0; ks < 4; ++ks) qf[ks] = *(const bf16x8_t*)(qn + (size_t)tok * 512 + head * 64 + 16 * ks + 8 * h);
                __syncthreads();
                {
                    f32x16 s4[4];
#pragma unroll
                    for (int mt = 0; mt < 4; ++mt) { s4[mt] = zero16();
#pragma unroll
                        for (int ks = 0; ks < 4; ++ks) { const bf16x8_t ka = *(const LAS bf16x8_t*)(lds + A_CMPK + (32 * mt + r) * A_KSTR + 32 * ks + 16 * h); s4[mt] = MFMA32(ka, qf[ks], s4[mt]); } }
                    const int clim = (pos - 31 - 64 * h) >> 4;
                    float ls = 0.f;
#pragma unroll
                    for (int mt = 0; mt < 4; ++mt)
#pragma unroll
                        for (int i = 0; i < 16; ++i) { const int ci = 32 * mt + (i & 3) + 8 * (i >> 2);
                            const float p = (ci <= clim) ? ex2(s4[mt][i]) : 0.f; s4[mt][i] = p; ls += p; }
                    ls += __shfl_xor(ls, 32);
                    const float inv = 1.f / fmaxf(ls, 1e-20f);
#pragma unroll
                    for (int mt = 0; mt < 4; ++mt) s4[mt] *= inv;
                    if (t >= 16) {
                        float oprev = 0.f;
#pragma unroll
                        for (int idx = 0; idx < 16; ++idx) {
                            const int mt = idx >> 2, ap = idx & 3;
                            const float tail = 0.5f * s4[mt][4 * ap + 3];
                            const float ot = __shfl_xor(tail, 32);
                            const float inner = s4[mt][4 * ap] + s4[mt][4 * ap + 1] + s4[mt][4 * ap + 2] + tail;
                            const float prev = h ? ot : oprev;
                            oprev = ot;
                            IMP[(g * 64 + ql) * A_IMPSTR + 8 * mt + 2 * ap + h] = inner + prev;
                        }
                    }
                    f32x16 oc[2]; oc[0] = zero16(); oc[1] = zero16();
#pragma unroll
                    for (int mt = 0; mt < 4; ++mt)
#pragma unroll
                        for (int s = 0; s < 2; ++s) {
                            const bf16x8_t pf = pack8(s4[mt], 8 * s);
#pragma unroll
                            for (int dt = 0; dt < 2; ++dt) {
                                const LAS unsigned char* vp = lds + A_CMPV + (32 * dt + r) * A_CVSTR + (32 * mt + 16 * s + 4 * h) * 2;
                                const s16x4_t lo = *(const LAS s16x4_t*)vp, hi = *(const LAS s16x4_t*)(vp + 16);
                                oc[dt] = MFMA32(__builtin_shufflevector(lo, hi, 0, 1, 2, 3, 4, 5, 6, 7), pf, oc[dt]);
                            }
                        }
                    comb[hkv][0] += oc[0] * g0; comb[hkv][1] += oc[1] * g0;
                }
                if (t >= 16) {
                    __syncthreads();
                    const int qloc = tid >> 3, jg = tid & 7;
                    unsigned bits = 0u;
                    float xe[4]; int cnt[4];
#pragma unroll
                    for (int e = 0; e < 4; ++e) { const int j = 4 * jg + e; const LAS float* ip = IMP + qloc * A_IMPSTR + j;
                        float x = (ip[0] + ip[64 * A_IMPSTR]) + (ip[128 * A_IMPSTR] + ip[192 * A_IMPSTR]);
                        if (j == 0 || j == t || j == t - 1) x = 1e9f;
                        if (j > t) x = -INFINITY;
                        xe[e] = x; cnt[e] = 0; }
#pragma unroll 4
                    for (int i = 0; i < 32; ++i) { const LAS float* ip = IMP + qloc * A_IMPSTR + i;
                        float vi = (ip[0] + ip[64 * A_IMPSTR]) + (ip[128 * A_IMPSTR] + ip[192 * A_IMPSTR]);
                        if (i == 0 || i == t || i == t - 1) vi = 1e9f;
                        if (i > t) vi = -INFINITY;
#pragma unroll
                        for (int e = 0; e < 4; ++e) cnt[e] += (vi > xe[e] || (vi == xe[e] && i < 4 * jg + e)) ? 1 : 0; }
#pragma unroll
                    for (int e = 0; e < 4; ++e) if (cnt[e] < 16 && xe[e] > -INFINITY) bits |= 1u << (4 * jg + e);
                    bits |= __shfl_xor(bits, 1); bits |= __shfl_xor(bits, 2); bits |= __shfl_xor(bits, 4);
                    if (jg == 0) SELM[qloc] = bits;
                    __syncthreads();
                }
                const unsigned selw = (t >= 16) ? SELM[ql] : ((2u << t) - 1u);
#pragma unroll
                for (int ks = 0; ks < 4; ++ks) qf[ks] = *(const bf16x8_t*)(qr + (size_t)tok * 512 + head * 64 + 16 * ks + 8 * h);
                const int kt_lo = t >= 8 ? t - 8 : 0, wlo = kt_lo >> 1, n_sel = (t >> 1) + 1, n_all = n_sel + ((t >> 1) - wlo + 1);
                const bf16_t* Ks = ksl + (size_t)bh * 2048 * 64; const bf16_t* Vs = vslT + (size_t)bh * 64 * 2048;
                const bf16_t* Kw = kwn + (size_t)bh * 2048 * 64; const bf16_t* Vw = vwnT + (size_t)bh * 64 * 2048;
#define A_ISSUE(idx) do { const int i1_ = (idx); const bool sel1_ = i1_ < n_sel; const int st1_ = sel1_ ? i1_ : wlo + (i1_ - n_sel); \
        int tv_ = tid; asm volatile("" : "+v"(tv_)); \
        const bf16_t* Kg_ = (sel1_ ? Ks : Kw) + (size_t)st1_ * 8192; const bf16_t* Vg_ = (sel1_ ? Vs : Vw) + (size_t)st1_ * 8192; \
        kR0 = *(const u32x4*)(Kg_ + (size_t)tv_ * 8); kR1 = *(const u32x4*)(Kg_ + (size_t)(tv_ + 512) * 8); \
        vR0 = *(const u32x4*)(Vg_ + (size_t)tv_ * 8); vR1 = *(const u32x4*)(Vg_ + (size_t)(tv_ + 512) * 8); } while (0)
#define A_STAGE(bufi) do { int tv_ = tid; asm volatile("" : "+v"(tv_)); \
        LAS unsigned char* kp_ = lds + A_KBUF + (bufi) * A_KT + (tv_ >> 3) * A_KSTR + (tv_ & 7) * 16; \
        *(LAS u32x4*)kp_ = kR0; *(LAS u32x4*)(kp_ + 64 * A_KSTR) = kR1; \
        LAS unsigned char* vp_ = lds + A_VBUF + (bufi) * A_VT + (tv_ >> 3) * A_CVSTR + (tv_ & 7) * 16; \
        *(LAS u32x2*)vp_ = (u32x2){vR0.x, vR0.y}; *(LAS u32x2*)(vp_ + 8) = (u32x2){vR0.z, vR0.w}; \
        *(LAS u32x2*)(vp_ + 128) = (u32x2){vR1.x, vR1.y}; *(LAS u32x2*)(vp_ + 136) = (u32x2){vR1.z, vR1.w}; } while (0)
                u32x4 kR0, kR1, vR0, vR1;
                A_ISSUE(0);
                A_STAGE(0);
                __syncthreads();
                f32x16 oacc[2]; oacc[0] = zero16(); oacc[1] = zero16();
                float l_run = 0.f;
#pragma unroll 1
                for (int i = 0; i < n_all; ++i) {
                    const int bufo = i & 1;
                    if (i + 1 < n_all) A_ISSUE(i + 1);
                    const LAS unsigned char* Kb = lds + A_KBUF + bufo * A_KT; const LAS unsigned char* Vb = lds + A_VBUF + bufo * A_VT;
                    const bool issel = i < n_sel;
                    const int st = issel ? i : wlo + (i - n_sel);
                    const int dlt = 64 * t + ql - 128 * st - 4 * h;
                    if (issel) {
                        const bool b0 = (selw >> (2 * st)) & 1u, b1 = (selw >> (2 * st + 1)) & 1u;
                        if (__ballot(b0 || b1) != 0ull) {
                            if (2 * st + 1 < t && __ballot(b0 && b1) == ~0ull) attn_tile<2>(Kb, Vb, qf, oacc, l_run, r, h, dlt, dlt, (w & 4) != 0);
                            else attn_tile<0>(Kb, Vb, qf, oacc, l_run, r, h, b0 ? dlt : -1, b1 ? dlt : -1, (w & 4) != 0);
                        }
                    } else {
                        if (2 * st > t - 8 && 2 * st + 1 < t) attn_tile<2>(Kb, Vb, qf, oacc, l_run, r, h, dlt, dlt, (w & 4) != 0);
                        else attn_tile<1>(Kb, Vb, qf, oacc, l_run, r, h, dlt, dlt, (w & 4) != 0);
                    }
                    if (i == n_sel - 1 || i == n_all - 1) { const float lt = l_run + __shfl_xor(l_run, 32); const float sc = ((i == n_sel - 1) ? g1 : g2) / fmaxf(lt, 1e-20f);
                        comb[hkv][0] += oacc[0] * sc; comb[hkv][1] += oacc[1] * sc; oacc[0] = zero16(); oacc[1] = zero16(); l_run = 0.f; }
                    if (i + 1 < n_all) A_STAGE(bufo ^ 1);
                    __syncthreads();
                }
#undef A_ISSUE
#undef A_STAGE
            }
            int tid = tid0; asm volatile("" : "+v"(tid));
            const int lane = tid & 63, r = lane & 31, h = lane >> 5, ql = 32 * half + r, pos = 64 * t + ql, tok = b * 2048 + pos;
            float ss = 0.f;
#pragma unroll
            for (int hkv = 0; hkv < 2; ++hkv)
#pragma unroll
                for (int dt = 0; dt < 2; ++dt)
#pragma unroll
                    for (int i = 0; i < 16; ++i) ss += comb[hkv][dt][i] * comb[hkv][dt][i];
            ss += __shfl_xor(ss, 32);
            if (h == 0) SSQ[w * 32 + r] = ss;
            __syncthreads();
            const float tot = (SSQ[(half + 0) * 32 + r] + SSQ[(half + 2) * 32 + r]) + (SSQ[(half + 4) * 32 + r] + SSQ[(half + 6) * 32 + r]);
            const float rn = rsqrtf(tot * (1.f / 512.f) + EPS);
#pragma unroll
            for (int hkv = 0; hkv < 2; ++hkv)
#pragma unroll
                for (int dt = 0; dt < 2; ++dt)
#pragma unroll
                    for (int ap = 0; ap < 4; ++ap) {
                        u32x2 pk; pk.x = cvtpk(comb[hkv][dt][4 * ap] * rn, comb[hkv][dt][4 * ap + 1] * rn); pk.y = cvtpk(comb[hkv][dt][4 * ap + 2] * rn, comb[hkv][dt][4 * ap + 3] * rn);
                        *(u32x2*)(o + (size_t)tok * DM + (hkv * 4 + g) * 64 + 32 * dt + 8 * ap + 4 * h) = pk;
                    }
        }
    }
}

constexpr int G_TSTR = 136, G_TILE = 128 * G_TSTR, G_SSQ = 8 * G_TILE;
static_assert(G_SSQ + 8 * 128 * 4 <= LDS_BYTES - 64, "gMLP LDS map");
__device__ __forceinline__ void phase4_gmlp(const Args& a, LAS unsigned char* lds) {
    const int tid0 = threadIdx.x, g = __builtin_amdgcn_readfirstlane(tid0 >> 6);
    unsigned char* ws = a.ws;
    const bf16_t* zu = (const bf16_t*)(ws + WS_ZU); const bf16_t* zvT = (const bf16_t*)(ws + WS_ZVT); const bf16_t* Wsp = (const bf16_t*)(ws + WS_WSP);
    const float* sp_b = a.in[10];
    bf16_t* o = (bf16_t*)(ws + WS_O);
    LAS float* SSQ2 = (LAS float*)(lds + G_SSQ);
    LAS unsigned char* tile = lds + g * G_TILE;
    for (int item = blockIdx.x; item < 256; item += gridDim.x) {
        const int b = item >> 4, ch = item & 15;
        const size_t tok0 = (size_t)b * 2048 + ch * 128;
        int tid = tid0; asm volatile("" : "+v"(tid));
        const int lane = tid & 63, r = lane & 31, h = lane >> 5;
        __syncthreads();
        bf16x8_t zf[2][8];
#pragma unroll
        for (int dt = 0; dt < 2; ++dt)
#pragma unroll
            for (int ks = 0; ks < 8; ++ks) zf[dt][ks] = *(const bf16x8_t*)(zvT + ((((size_t)b * 16 + ch) * 8 + g) * 64 + 32 * dt + r) * 128 + 16 * ks + 8 * h);
        f32x16 acc[2][4];
#pragma unroll
        for (int tt = 0; tt < 4; ++tt) { acc[0][tt] = zero16(); acc[1][tt] = zero16();
            __builtin_amdgcn_sched_barrier(0);
#pragma unroll
            for (int ks = 0; ks < 2 * tt + 2; ++ks) {
                const bf16x8_t wf = *(const bf16x8_t*)(Wsp + ((size_t)g * 128 + 32 * tt + r) * 128 + 16 * ks + 8 * h);
                acc[0][tt] = MFMA32(zf[0][ks], wf, acc[0][tt]); acc[1][tt] = MFMA32(zf[1][ks], wf, acc[1][tt]);
            } }
        __builtin_amdgcn_sched_barrier(0);
#pragma unroll
        for (int hb = 0; hb < 2; ++hb) {
            u32x4 zr[8];
#pragma unroll
            for (int it = 0; it < 8; ++it) zr[it] = *(const u32x4*)(zu + (tok0 + (lane >> 3) + 8 * (8 * hb + it)) * 512 + g * 64 + (lane & 7) * 8);
#pragma unroll
            for (int it = 0; it < 8; ++it) { LAS unsigned char* p = tile + ((lane >> 3) + 8 * (8 * hb + it)) * G_TSTR + (lane & 7) * 16;
                *(LAS u32x2*)p = (u32x2){zr[it].x, zr[it].y}; *(LAS u32x2*)(p + 8) = (u32x2){zr[it].z, zr[it].w}; }
        }
        asm volatile("s_waitcnt lgkmcnt(0)" ::: "memory");
#pragma unroll
        for (int tt = 0; tt < 4; ++tt) {
            const int tl = 32 * tt + r;
            const float bias = sp_b[g * 128 + tl];
            float ss = 0.f;
#pragma unroll
            for (int dt = 0; dt < 2; ++dt)
#pragma unroll
                for (int ap = 0; ap < 4; ++ap) {
                    const u32x2 zz = *(const LAS u32x2*)(tile + tl * G_TSTR + (32 * dt + 8 * ap + 4 * h) * 2);
                    const float z0 = __uint_as_float(zz.x << 16), z1 = __uint_as_float(zz.x & 0xffff0000u), z2 = __uint_as_float(zz.y << 16), z3 = __uint_as_float(zz.y & 0xffff0000u);
                    float v0 = z0 * (acc[dt][tt][4 * ap] + bias), v1 = z1 * (acc[dt][tt][4 * ap + 1] + bias), v2 = z2 * (acc[dt][tt][4 * ap + 2] + bias), v3 = z3 * (acc[dt][tt][4 * ap + 3] + bias);
                    acc[dt][tt][4 * ap] = v0; acc[dt][tt][4 * ap + 1] = v1; acc[dt][tt][4 * ap + 2] = v2; acc[dt][tt][4 * ap + 3] = v3;
                    ss += (v0 * v0 + v1 * v1) + (v2 * v2 + v3 * v3);
                }
            ss += __shfl_xor(ss, 32);
            if (h == 0) SSQ2[g * 128 + tl] = ss;
        }
        __syncthreads();
#pragma unroll
        for (int tt = 0; tt < 4; ++tt) {
            const int tl = 32 * tt + r;
            float tot = 0.f;
#pragma unroll
            for (int gg = 0; gg < 8; ++gg) tot += SSQ2[gg * 128 + tl];
            const float rn = rsqrtf(tot * (1.f / 512.f) + EPS);
#pragma unroll
            for (int dt = 0; dt < 2; ++dt)
#pragma unroll
                for (int ap = 0; ap < 4; ++ap) {
                    u32x2 pk; pk.x = cvtpk(acc[dt][tt][4 * ap] * rn, acc[dt][tt][4 * ap + 1] * rn); pk.y = cvtpk(acc[dt][tt][4 * ap + 2] * rn, acc[dt][tt][4 * ap + 3] * rn);
                    *(LAS u32x2*)(tile + tl * G_TSTR + (32 * dt + 8 * ap + 4 * h) * 2) = pk;
                }
        }
        asm volatile("s_waitcnt lgkmcnt(0)" ::: "memory");
#pragma unroll
        for (int it = 0; it < 16; ++it) { const LAS unsigned char* p = tile + ((lane >> 3) + 8 * it) * G_TSTR + (lane & 7) * 16;
            const u32x2 lo = *(const LAS u32x2*)p, hi = *(const LAS u32x2*)(p + 8);
            *(u32x4*)(o + (tok0 + (lane >> 3) + 8 * it) * DM + 512 + g * 64 + (lane & 7) * 8) = (u32x4){lo.x, lo.y, hi.x, hi.y}; }
    }
}

constexpr int BAR_BYTES = (1024 + 8 * 2304) * 4;
__device__ __forceinline__ unsigned xb_ld(unsigned* p) { return __hip_atomic_load(p, __ATOMIC_RELAXED, __HIP_MEMORY_SCOPE_AGENT); }
__device__ __forceinline__ unsigned xb_add(unsigned* p, unsigned v) { return __hip_atomic_fetch_add(p, v, __ATOMIC_RELAXED, __HIP_MEMORY_SCOPE_AGENT); }
__device__ __forceinline__ unsigned xb_xcc_id() { return (unsigned)__builtin_amdgcn_s_getreg((3 << 11) | 20) & 0xFu; }
__device__ __forceinline__ void grid_barrier(unsigned* barw, int k, volatile LAS unsigned* st) {
    asm volatile("s_waitcnt vmcnt(0)" ::: "memory");
    __syncthreads();
    if (threadIdx.x == 0) {
        __builtin_amdgcn_s_waitcnt(0);
        const unsigned x = xb_xcc_id();
        unsigned nloc = st[0], nx = st[1];
        if (nloc == 0u) {
            const unsigned G = gridDim.x;
            for (;;) { unsigned sum = 0u, cnt = 0u, mine = 0u;
#pragma unroll
                for (unsigned j = 0; j < 16; ++j) { const unsigned c = xb_ld(barw + 64 * j); sum += c; cnt += (c > 0u) ? 1u : 0u; mine = (j == x) ? c : mine; }
                if (sum == G) { nloc = mine; nx = cnt; break; }
                __builtin_amdgcn_s_sleep(1); }
            st[0] = nloc; st[1] = nx;
        }
        unsigned* sb = barw + 1024 + k * 2304;
        const unsigned old = xb_add(sb + 64 * x, 1u);
        if (old + 1u == nloc) {
            __builtin_amdgcn_fence(__ATOMIC_RELEASE, "agent");
            asm volatile("s_waitcnt vmcnt(0)" ::: "memory");
            const unsigned og = xb_add(sb + 2048, 1u);
            if (og + 1u == nx) xb_add(sb + 2112, 1u);
            else while (xb_ld(sb + 2112) == 0u) __builtin_amdgcn_s_sleep(1);
            __builtin_amdgcn_fence(__ATOMIC_ACQUIRE, "agent");
            xb_add(sb + 1024 + 64 * x, 1u);
            asm volatile("s_waitcnt vmcnt(0)" ::: "memory");
        } else {
            while (xb_ld(sb + 1024 + 64 * x) == 0u) __builtin_amdgcn_s_sleep(1);
            __builtin_amdgcn_fence(__ATOMIC_ACQUIRE, "agent");
            asm volatile("s_waitcnt vmcnt(0)" ::: "memory");
        }
    }
    __syncthreads();
}

#ifndef N_LAUNCHES
#define N_LAUNCHES 1
#endif
constexpr int NPHASE = 8;
__global__ void __launch_bounds__(NWAVES * 64, 2) fwd_kernel(Args args) {
    extern __shared__ __attribute__((aligned(16))) unsigned char lds_raw[];
    LAS unsigned char* lds = (LAS unsigned char*)lds_raw;
    unsigned char* ws = args.ws;
    const int lo = args.ph_lo, hi = args.ph_hi;
    const int G = gridDim.x;
#define IN(k) (lo <= (k) && (k) < hi)
    unsigned* barw = (unsigned*)ws;
    volatile LAS unsigned* bst = (volatile LAS unsigned*)(lds + LDS_BYTES - 64);
    if (threadIdx.x == 0) { bst[0] = 0u; bst[1] = 0u; (void)xb_add(barw + 64 * xb_xcc_id(), 1u); }
    __syncthreads();
    if (hi > NPHASE) cg::this_grid().sync();
#define SEAM(k) do { if (IN(k) && IN((k) + 1)) { grid_barrier(barw, (k), bst); } } while (0)
    if (IN(0)) { phase0(args, lds); }
    SEAM(0);
    if (IN(1)) {
        pg8::Gemm g{(const bf16_t*)(ws + WS_XB), (const bf16_t*)(ws + WS_WIN), T, NIN, DM, DM, DM};
        pg8::StaticOrder So; So.init(T, NIN, G, (int)blockIdx.x);
        EpiInProj E{(const float*)(ws + WS_RINV1), args.in[3], args.in[4], args.in[8], (const float*)(ws + WS_ROPEC), (const float*)(ws + WS_ROPES),
                    (bf16_t*)(ws + WS_QN), (bf16_t*)(ws + WS_QR), (bf16_t*)(ws + WS_KC), (bf16_t*)(ws + WS_VC), (bf16_t*)(ws + WS_KSL), (bf16_t*)(ws + WS_VSLT),
                    (bf16_t*)(ws + WS_KWN), (bf16_t*)(ws + WS_VWNT), (bf16_t*)(ws + WS_ZU), (bf16_t*)(ws + WS_ZVT), (float*)(ws + WS_GATES)};
        pg8::gemm_phase<EpiInProj, pg8::StaticOrder, true, true>(lds, g, So, E);
    }
    SEAM(1);
    if (IN(2)) {
        pg8::Gemm g{(const bf16_t*)(ws + WS_KC), (const bf16_t*)(ws + WS_W1T), 8192, 512, 256, 1024, 2048};
        pg8::CmpOrder So{G, (int)blockIdx.x};
        EpiPart E{(float*)(ws + WS_PART)};
        pg8::gemm_phase<EpiPart, pg8::CmpOrder, false, true>(lds, g, So, E);
    }
    SEAM(2);
    if (IN(3)) { phase3(args, lds); }
    SEAM(3);
    if (IN(4)) { phase4_attn(args, lds); phase4_gmlp(args, lds); }
    SEAM(4);
    if (IN(5)) {
        pg8::Gemm g{(const bf16_t*)(ws + WS_O), (const bf16_t*)(ws + WS_WOUT), T, DM, DM, DM, DM};
        pg8::StaticOrder So; So.init(T, DM, G, (int)blockIdx.x);
        EpiWout E{(const bf16_t*)(ws + WS_XB), (bf16_t*)(ws + WS_X2B), (float*)(ws + WS_SSQP), (LAS float*)(lds + 131072)};
        pg8::gemm_phase<EpiWout, pg8::StaticOrder, true, true>(lds, g, So, E);
    }
    SEAM(5);
    if (IN(6)) {
        pg8::Gemm g{(const bf16_t*)(ws + WS_X2B), (const bf16_t*)(ws + WS_WFF1), T, FF, DM, DM, DM};
        pg8::StaticOrder So; So.init(T, FF, G, (int)blockIdx.x);
        EpiFF1 E{(const float*)(ws + WS_SSQP), (bf16_t*)(ws + WS_H)};
        pg8::gemm_phase<EpiFF1, pg8::StaticOrder, true, true>(lds, g, So, E);
    }
    SEAM(6);
    if (IN(7)) {
        pg8::Gemm g{(const bf16_t*)(ws + WS_H), (const bf16_t*)(ws + WS_WFF2), T, DM, FF, FF, FF};
        pg8::StaticOrder So; So.init(T, DM, G, (int)blockIdx.x);
        EpiFF2 E{(const bf16_t*)(ws + WS_X2B), args.out};
        pg8::gemm_phase<EpiFF2, pg8::StaticOrder, true, true>(lds, g, So, E);
    }
#undef IN
#undef SEAM
}

extern "C" void kernel_launch(void* const* d_in, const int* in_sizes, int n_in, void* d_out, int out_size, void* d_ws, size_t ws_size, hipStream_t stream) {
    static int grid = 0;
    if (grid == 0) {
        if (n_in != 16 || out_size != T * DM || ws_size < WS_END) { fprintf(stderr, "kernel_launch: unexpected shapes (n_in %d out %d ws %zu)\n", n_in, out_size, ws_size); grid = -1; return; }
        int dev = 0, cus = 0, per_cu = 0;
        hipGetDevice(&dev); hipDeviceGetAttribute(&cus, hipDeviceAttributeMultiprocessorCount, dev);
        if (hipFuncSetAttribute((const void*)fwd_kernel, hipFuncAttributeMaxDynamicSharedMemorySize, LDS_BYTES) != hipSuccess) { fprintf(stderr, "kernel_launch: hipFuncSetAttribute failed\n"); grid = -1; return; }
        if (hipOccupancyMaxActiveBlocksPerMultiprocessor(&per_cu, (const void*)fwd_kernel, NWAVES * 64, LDS_BYTES) != hipSuccess || per_cu < 1) { fprintf(stderr, "kernel_launch: occupancy query says %d\n", per_cu); per_cu = 1; }
        (void)hipGetLastError();
        grid = cus * per_cu;
        fprintf(stderr, "kernel_launch: grid %d (cus %d x %d)\n", grid, cus, per_cu);
    }
    if (grid < 0) return;
    if (hipMemsetAsync(d_ws, 0, BAR_BYTES, stream) != hipSuccess) { fprintf(stderr, "kernel_launch: memset of the barrier words failed\n"); return; }
    Args a{};
    for (int i = 0; i < 16; ++i) a.in[i] = (const float*)d_in[i];
    a.out = (float*)d_out; a.ws = (unsigned char*)d_ws;
#if N_LAUNCHES == 1
    a.ph_lo = 0; a.ph_hi = NPHASE;
    void* kargs[] = {&a};
    hipError_t e = hipLaunchCooperativeKernel((const void*)fwd_kernel, dim3(grid), dim3(NWAVES * 64), kargs, LDS_BYTES, stream);
    if (e != hipSuccess) fprintf(stderr, "kernel_launch: cooperative launch failed: %s (grid %d)\n", hipGetErrorString(e), grid);
#else
    for (int p = 0; p < NPHASE; ++p) {
        a.ph_lo = p; a.ph_hi = p + 1;
        hipLaunchKernelGGL(fwd_kernel, dim3(grid), dim3(NWAVES * 64), LDS_BYTES, stream, a);
    }
#endif
}
```

```cpp
#include <hip/hip_runtime.h>
#include <hip/hip_cooperative_groups.h>
#include <cstdio>
#include <cstdint>
namespace cg = cooperative_groups;

#define LAS __attribute__((address_space(3)))
typedef unsigned short bf16_t;
typedef unsigned u32x4 __attribute__((ext_vector_type(4)));
typedef float f32x4 __attribute__((ext_vector_type(4)));

namespace pg8 {
#define PG8_LAS __attribute__((address_space(3)))
typedef short bf16x8 __attribute__((ext_vector_type(8)));
constexpr int BM = 256, BK = 64, HALF = 128, HTB = HALF * BK * 2, STAGE_BYTES = 8 * HTB, NXCD = 8, WGM = 4;
__host__ __device__ __forceinline__ int lds_byte(int r, int c) { const int st = (r >> 4) * 2 + (c >> 5), rr = r & 15, cc = c & 31, ob = rr * 64 + cc * 2; return st * 1024 + (ob ^ (((ob >> 9) & 1) << 5)); }
__host__ __device__ __forceinline__ void stage_rc(int b, int& R, int& C) { const int st = b / 1024, sb = b % 1024, swz = sb ^ (((sb >> 9) & 1) << 5); R = (st >> 1) * 16 + swz / 64; C = (st & 1) * 32 + (swz % 64) / 2; }
__host__ __device__ __forceinline__ int perm32(int rho) { const int n = rho >> 4, i = rho & 15; return 8 * (i >> 2) + 4 * n + (i & 3); }
struct Unit { int pm, pn, koff; };
struct Gemm { const bf16_t* A; const bf16_t* Bt; int M, N, K, lda, ldb; };
struct StaticOrder {
    int nM, nN, nwg, G, c;
    __host__ __device__ void init(int M, int N, int G_, int c_) { nM = M / BM; nN = N / BM; nwg = nM * nN; G = G_; c = c_; }
    __host__ __device__ bool next(int i, Unit& u) const {
        const long L = (long)i * G + c; if (L >= nwg) return false;
        int wgid = (int)L; { const int q = nwg / NXCD, r = nwg % NXCD, xcd = wgid % NXCD, off = wgid / NXCD; wgid = (xcd < r ? xcd * (q + 1) : r * (q + 1) + (xcd - r) * q) + off; }
        const int nig = WGM * nN, gid = wgid / nig, fm = gid * WGM, gsz = (nM - fm) < WGM ? (nM - fm) : WGM;
        u.pm = fm + ((wgid % nig) % gsz); u.pn = (wgid % nig) / gsz; u.koff = 0; return true;
    }
    __device__ __forceinline__ void a_ready(const Unit&) const {}
    __device__ __forceinline__ void done(const Unit&) const {}
};
struct CmpOrder {
    int G, c;
    __device__ bool next(int i, Unit& u) const { const long L = (long)i * G + c; if (L >= 256) return false; u.pm = (int)L & 31; u.pn = u.pm >> 4; u.koff = ((int)L >> 5) * 512; return true; }
    __device__ __forceinline__ void a_ready(const Unit&) const {}
    __device__ __forceinline__ void done(const Unit&) const {}
};
__device__ __forceinline__ unsigned cvt_pk_bf16(float lo, float hi) { unsigned r; asm volatile("v_cvt_pk_bf16_f32 %0, %1, %2" : "=v"(r) : "v"(lo), "v"(hi)); return r; }
template <class Epi, class Sched, bool ALIGN_EPI = false, bool SP2 = false>
__device__ __forceinline__ void gemm_phase(PG8_LAS unsigned char* lds, const Gemm g, const Sched& S, const Epi& E) {
    const int tid = threadIdx.x, wid = __builtin_amdgcn_readfirstlane(tid >> 6), lane = tid & 63, wr = wid >> 2, wc = wid & 3, fr = lane & 15, fq = lane >> 4;
    const int K = g.K, nt = K / BK, lda = g.lda, ldb = g.ldb;
    unsigned voffA[2], voffB[2];
#pragma unroll
    for (int i = 0; i < 2; ++i) { int R, C; stage_rc(tid * 16 + i * 8192, R, C); const int Rb = Epi::PERM ? ((R & ~31) + perm32(R & 31)) : R;
        voffA[i] = (unsigned)(R * lda + C) * 2u; voffB[i] = (unsigned)(Rb * ldb + C) * 2u; }
    const size_t kstep = (size_t)(BK * 2);
    const size_t hstepA = (size_t)HALF * lda * 2, hstepB = (size_t)HALF * ldb * 2;
    const size_t tstepA = 2 * hstepA, tstepB = 2 * hstepB;
    const unsigned ldsw = (unsigned)wid * 1024u;
    const int aoff = lds_byte(wr * 64 + fr, fq * 8), boff = lds_byte(wc * 32 + fr, fq * 8);
#define PG8_SA(b, h) (((b) * 2 + (h)) * HTB)
#define PG8_SB(b, h) ((4 + (b) * 2 + (h)) * HTB)
#define PG8_STAGE(bufoff, gbase, voff) do { _Pragma("unroll") for (int _i = 0; _i < 2; ++_i) \
        __builtin_amdgcn_global_load_lds((const unsigned*)((const char*)(gbase) + (voff)[_i]), (PG8_LAS unsigned*)(lds + (bufoff) + ldsw + _i * 8192), 16, 0, 0); } while (0)
#define PG8_LDA(dst, b, h) do { _Pragma("unroll") for (int m = 0; m < 4; ++m) _Pragma("unroll") for (int k = 0; k < 2; ++k) dst[m][k] = *(const PG8_LAS bf16x8*)(lds + PG8_SA(b, h) + aoff + m * 2048 + k * 1024); } while (0)
#define PG8_LDB(dst, b, h) do { _Pragma("unroll") for (int n = 0; n < 2; ++n) _Pragma("unroll") for (int k = 0; k < 2; ++k) dst[n][k] = *(const PG8_LAS bf16x8*)(lds + PG8_SB(b, h) + boff + n * 2048 + k * 1024); } while (0)
#define PG8_MMA(ai, bj, At, Bt) do { __builtin_amdgcn_s_setprio(1); _Pragma("unroll") for (int m = 0; m < 4; ++m) _Pragma("unroll") for (int n = 0; n < 2; ++n) _Pragma("unroll") for (int k = 0; k < 2; ++k) \
        acc[ai][bj][m][n] = __builtin_amdgcn_mfma_f32_16x16x32_bf16(Bt[n][k], At[m][k], acc[ai][bj][m][n], 0, 0, 0); __builtin_amdgcn_s_setprio(0); } while (0)
#define PG8_WAIT_V(n) asm volatile("s_waitcnt vmcnt(" #n ")" ::: "memory")
#define PG8_WAIT_L(n) asm volatile("s_waitcnt lgkmcnt(" #n ")" ::: "memory")
#define PG8_BAR __builtin_amdgcn_s_barrier()
#define PG8_SCHED __builtin_amdgcn_sched_barrier(0)
    Unit cur, nxt; int ui = 0;
    if (!S.next(0, cur)) return;
    f32x4 acc[2][2][4][2];
#pragma unroll
    for (int a = 0; a < 2; ++a)
#pragma unroll
        for (int b = 0; b < 2; ++b)
#pragma unroll
            for (int m = 0; m < 4; ++m)
#pragma unroll
                for (int n = 0; n < 2; ++n) acc[a][b][m][n] = (f32x4){0.f, 0.f, 0.f, 0.f};
    bf16x8 At[4][2], B0[2][2], B1[2][2];
    const char* cA = (const char*)g.A + (size_t)cur.pm * tstepA + cur.koff; const char* cB = (const char*)g.Bt + (size_t)cur.pn * tstepB + cur.koff;
    S.a_ready(cur);
    if constexpr (SP2) {
        PG8_STAGE(PG8_SB(0, 0), cB, voffB); PG8_STAGE(PG8_SB(0, 1), cB + hstepB, voffB); PG8_STAGE(PG8_SA(0, 0), cA, voffA); PG8_STAGE(PG8_SA(0, 1), cA + hstepA, voffA);
        if (wr == 1) PG8_BAR;
        PG8_WAIT_V(2); PG8_BAR;
        PG8_STAGE(PG8_SB(1, 0), cB + kstep, voffB); PG8_STAGE(PG8_SA(1, 0), cA + kstep, voffA); PG8_STAGE(PG8_SB(1, 1), cB + hstepB + kstep, voffB);
        PG8_WAIT_V(6); PG8_BAR;
    } else {
        PG8_STAGE(PG8_SB(0, 0), cB, voffB); PG8_STAGE(PG8_SA(0, 0), cA, voffA); PG8_STAGE(PG8_SB(0, 1), cB + hstepB, voffB); PG8_STAGE(PG8_SA(0, 1), cA + hstepA, voffA);
        if (wr == 1) PG8_BAR;
        PG8_WAIT_V(4); PG8_BAR;
        PG8_STAGE(PG8_SB(1, 0), cB + kstep, voffB); PG8_STAGE(PG8_SA(1, 0), cA + kstep, voffA); PG8_STAGE(PG8_SB(1, 1), cB + hstepB + kstep, voffB);
        PG8_WAIT_V(6); PG8_BAR;
    }
    for (;;) {
        const bool has_next = S.next(ui + 1, nxt);
        const char* nA = has_next ? (const char*)g.A + (size_t)nxt.pm * tstepA + nxt.koff : cA; const char* nB = has_next ? (const char*)g.Bt + (size_t)nxt.pn * tstepB + nxt.koff : cB;
        for (int t = 0; t < nt; t += 2) {
            const bool last = (t == nt - 2);
            const char* a1 = cA + (size_t)(t + 1) * kstep;
            const char* a2 = last ? nA : cA + (size_t)(t + 2) * kstep; const char* b2 = last ? nB : cB + (size_t)(t + 2) * kstep;
            const char* a3 = a2 + kstep; const char* b3 = b2 + kstep;
            if (last && has_next) S.a_ready(nxt);
            if constexpr (SP2) {
            PG8_LDB(B0, 0, 0); PG8_LDB(B1, 0, 1); PG8_SCHED; PG8_LDA(At, 0, 0); PG8_STAGE(PG8_SA(1, 1), a1 + hstepA, voffA);
            PG8_WAIT_V(8); PG8_WAIT_L(0); PG8_BAR; PG8_MMA(0, 0, At, B0); PG8_MMA(0, 1, At, B1); PG8_BAR; PG8_SCHED;
            PG8_LDA(At, 0, 1); PG8_STAGE(PG8_SB(0, 0), b2, voffB); PG8_STAGE(PG8_SB(0, 1), b2 + hstepB, voffB); PG8_STAGE(PG8_SA(0, 0), a2, voffA);
            PG8_WAIT_V(8); PG8_WAIT_L(0); PG8_BAR; PG8_MMA(1, 0, At, B0); PG8_MMA(1, 1, At, B1); PG8_BAR; PG8_SCHED;
            PG8_LDB(B0, 1, 0); PG8_LDB(B1, 1, 1); PG8_SCHED; PG8_LDA(At, 1, 0); PG8_STAGE(PG8_SA(0, 1), a2 + hstepA, voffA);
            PG8_WAIT_V(8); PG8_WAIT_L(0); PG8_BAR; PG8_MMA(0, 0, At, B0); PG8_MMA(0, 1, At, B1); PG8_BAR; PG8_SCHED;
            PG8_LDA(At, 1, 1); PG8_STAGE(PG8_SB(1, 0), b3, voffB); PG8_STAGE(PG8_SB(1, 1), b3 + hstepB, voffB); PG8_STAGE(PG8_SA(1, 0), a3, voffA);
            PG8_WAIT_V(8); PG8_WAIT_L(0); PG8_BAR; PG8_MMA(1, 0, At, B0); PG8_MMA(1, 1, At, B1); PG8_BAR; PG8_SCHED;
            } else {
            PG8_LDB(B0, 0, 0); PG8_SCHED; PG8_LDA(At, 0, 0); PG8_STAGE(PG8_SA(1, 1), a1 + hstepA, voffA);
            PG8_WAIT_L(8); PG8_BAR; PG8_WAIT_L(0); PG8_MMA(0, 0, At, B0); PG8_BAR; PG8_SCHED;
            PG8_LDB(B1, 0, 1); PG8_STAGE(PG8_SB(0, 0), b2, voffB);
            PG8_BAR; PG8_WAIT_L(0); PG8_MMA(0, 1, At, B1); PG8_BAR;
            PG8_LDA(At, 0, 1); PG8_STAGE(PG8_SA(0, 0), a2, voffA);
            PG8_BAR; PG8_WAIT_L(0); PG8_MMA(1, 0, At, B0); PG8_BAR; PG8_SCHED;
            PG8_STAGE(PG8_SB(0, 1), b2 + hstepB, voffB);
            PG8_WAIT_V(6); PG8_BAR; PG8_MMA(1, 1, At, B1); PG8_BAR;
            PG8_LDB(B0, 1, 0); PG8_SCHED; PG8_LDA(At, 1, 0); PG8_STAGE(PG8_SA(0, 1), a2 + hstepA, voffA);
            PG8_WAIT_L(8); PG8_BAR; PG8_WAIT_L(0); PG8_MMA(0, 0, At, B0); PG8_BAR; PG8_SCHED;
            PG8_LDB(B1, 1, 1); PG8_STAGE(PG8_SB(1, 0), b3, voffB);
            PG8_BAR; PG8_WAIT_L(0); PG8_MMA(0, 1, At, B1); PG8_BAR;
            PG8_LDA(At, 1, 1); PG8_STAGE(PG8_SA(1, 0), a3, voffA);
            PG8_BAR; PG8_WAIT_L(0); PG8_MMA(1, 0, At, B0); PG8_BAR; PG8_SCHED;
            PG8_STAGE(PG8_SB(1, 1), b3 + hstepB, voffB);
            PG8_WAIT_V(6); PG8_BAR; PG8_MMA(1, 1, At, B1); PG8_BAR;
            }
        }
        if constexpr (ALIGN_EPI) { if (wr == 0) PG8_BAR; }
        if constexpr (!Epi::AFTER_DRAIN) { E(acc, cur, wr, wc, fr, fq); S.done(cur); }
        if (!has_next) break;
#pragma unroll
        for (int a = 0; a < 2; ++a)
#pragma unroll
            for (int b = 0; b < 2; ++b)
#pragma unroll
                for (int m = 0; m < 4; ++m)
#pragma unroll
                    for (int n = 0; n < 2; ++n) acc[a][b][m][n] = (f32x4){0.f, 0.f, 0.f, 0.f};
        cur = nxt; cA = nA; cB = nB; ++ui;
        if constexpr (ALIGN_EPI) { if (wr == 1) PG8_BAR; }
    }
    PG8_WAIT_V(0);
    if constexpr (!ALIGN_EPI) { if (wr == 0) PG8_BAR; }
    PG8_BAR;
    if constexpr (Epi::AFTER_DRAIN) { E.fused(acc, cur, wr, wc, fr, fq, lds, wid, lane); S.done(cur); }
#undef PG8_SA
#undef PG8_SB
#undef PG8_STAGE
#undef PG8_LDA
#undef PG8_LDB
#undef PG8_MMA
#undef PG8_WAIT_V
#undef PG8_WAIT_L
#undef PG8_BAR
#undef PG8_SCHED
}
}

constexpr int T = 32768, S = 2048, DM = 1024, NIN = 2560, FF = 4096;
constexpr float EPS = 1e-6f;
constexpr float QSCALE = 0.125f * 1.4426950408889634f;
constexpr size_t MiB = 1u << 20;
constexpr size_t WS_WIN = 1 * MiB, WS_WOUT = 6 * MiB, WS_WFF1 = 8 * MiB, WS_WFF2 = 16 * MiB, WS_W1T = 24 * MiB;
constexpr size_t WS_WSP = 26 * MiB + 768 * 1024;
constexpr size_t WS_C1 = 26 * MiB, WS_ROPEC = 26 * MiB + 64 * 1024, WS_ROPES = 26 * MiB + 320 * 1024;
constexpr size_t WS_RINV1 = 27 * MiB, WS_SSQP = 27 * MiB + 512 * 1024, WS_GATES = 30 * MiB;
constexpr size_t WS_KCMP = 33 * MiB, WS_VCMPT = 33 * MiB + 512 * 1024, WS_HID = 34 * MiB, WS_X2B = 38 * MiB;
constexpr size_t WS_XB = 102 * MiB, WS_QN = 166 * MiB, WS_QR = 198 * MiB, WS_KC = 230 * MiB, WS_VC = 238 * MiB;
constexpr size_t WS_KSL = 246 * MiB, WS_VSLT = 254 * MiB, WS_KWN = 262 * MiB, WS_VWNT = 270 * MiB, WS_ZU = 278 * MiB, WS_ZVT = 310 * MiB, WS_O = 342 * MiB;
constexpr size_t WS_H = 102 * MiB, WS_END = 406 * MiB;
constexpr size_t WS_PART = WS_X2B;
constexpr size_t WS_C1P = 26 * MiB + 576 * 1024;
constexpr int LDS_BYTES = 147456;
constexpr int NWAVES = 8;

struct Args { const float* in[16]; float* out; unsigned char* ws; int ph_lo, ph_hi; };

__device__ __forceinline__ float bf2f(bf16_t h) { return __uint_as_float(((unsigned)h) << 16); }
__device__ __forceinline__ unsigned f2bf(float f) { unsigned u = __float_as_uint(f); return (u + 0x7fffu + ((u >> 16) & 1u)) >> 16; }
__device__ __forceinline__ unsigned pk2(float lo, float hi) { return pg8::cvt_pk_bf16(lo, hi); }
__device__ __forceinline__ float wave_sum(float v) {
#pragma unroll
    for (int o = 1; o < 64; o <<= 1) v += __shfl_xor(v, o);
    return v;
}
__device__ __forceinline__ float wave_max(float v) {
#pragma unroll
    for (int o = 1; o < 64; o <<= 1) v = fmaxf(v, __shfl_xor(v, o));
    return v;
}
__device__ __forceinline__ float gelu_tanh(float x) {
    const float u = 0.7978845608028654f * (x + 0.044715f * x * x * x);
    return x / (1.f + __expf(-2.f * u));
}
__device__ __forceinline__ void store8(bf16_t* p, const float* v) {
    u32x4 w; w.x = pk2(v[0], v[1]); w.y = pk2(v[2], v[3]); w.z = pk2(v[4], v[5]); w.w = pk2(v[6], v[7]);
    *(u32x4*)p = w;
}
__device__ __forceinline__ void load8(const bf16_t* p, float* v) {
    const u32x4 w = *(const u32x4*)p;
    v[0] = __uint_as_float(w.x << 16); v[1] = __uint_as_float(w.x & 0xffff0000u);
    v[2] = __uint_as_float(w.y << 16); v[3] = __uint_as_float(w.y & 0xffff0000u);
    v[4] = __uint_as_float(w.z << 16); v[5] = __uint_as_float(w.z & 0xffff0000u);
    v[6] = __uint_as_float(w.w << 16); v[7] = __uint_as_float(w.w & 0xffff0000u);
}
__device__ __forceinline__ float head_ssq(const float (&v)[16]) {
    float s = 0.f;
#pragma unroll
    for (int i = 0; i < 16; ++i) s += v[i] * v[i];
    s += __shfl_xor(s, 16); s += __shfl_xor(s, 32);
    return s;
}

struct EpiInProj {
    static constexpr bool PERM = true, AFTER_DRAIN = false;
    const float *rinv1, *g_q, *g_k, *g_sgu, *ropec, *ropes;
    bf16_t *qn, *qr, *kc, *vc, *ksl, *vslT, *kwn, *vwnT, *zu, *zvT; float* gates;
    __device__ __forceinline__ void operator()(const f32x4 (&acc)[2][2][4][2], const pg8::Unit& u, int wr, int wc, int fr, int fq) const {
        const int cs = u.pn * 4 + wc;
        if (cs >= 37) return;
        const int d0 = 8 * fq;
        float rsv[2][4];
#pragma unroll
        for (int ai = 0; ai < 2; ++ai)
#pragma unroll
            for (int m = 0; m < 4; ++m) rsv[ai][m] = rinv1[u.pm * 256 + ai * 128 + wr * 64 + m * 16 + fr];
#pragma unroll
        for (int ai = 0; ai < 2; ++ai)
#pragma unroll
            for (int m = 0; m < 4; ++m) {
                const int row = u.pm * 256 + ai * 128 + wr * 64 + m * 16 + fr;
                const float rs = rsv[ai][m];
                float v[16];
#pragma unroll
                for (int bj = 0; bj < 2; ++bj)
#pragma unroll
                    for (int n = 0; n < 2; ++n)
#pragma unroll
                        for (int e = 0; e < 4; ++e) v[bj * 8 + n * 4 + e] = acc[ai][bj][m][n][e] * rs;
                const int b = row >> 11, s = row & 2047;
                if (cs < 8 || cs == 12 || cs == 13 || cs == 16 || cs == 17) {
                    const float* gg = cs < 8 ? g_q : (cs < 14 ? g_k + 64 : g_k + 128);
                    const float rn = rsqrtf(head_ssq(v) * (1.f / 64.f) + EPS) * (cs < 8 ? QSCALE : 1.f);
                    float y[16];
#pragma unroll
                    for (int i = 0; i < 16; ++i) y[i] = v[i] * rn * gg[32 * (i >> 3) + d0 + (i & 7)];
                    float r1[8], r2[8];
#pragma unroll
                    for (int i = 0; i < 8; ++i) { int di = d0 + i; asm volatile("" : "+v"(di));
                        const float frev = __builtin_amdgcn_exp2f(-(float)di * (13.287712379549449f / 32.f)) * 0.15915494309189535f;
                        float xr = (float)s * frev; xr -= __builtin_rintf(xr);
                        const float c = __builtin_amdgcn_cosf(xr), sn = __builtin_amdgcn_sinf(xr); r1[i] = y[i] * c - y[8 + i] * sn; r2[i] = y[8 + i] * c + y[i] * sn; }
                    if (cs < 8) {
                        bf16_t* p = qn + (size_t)row * 512 + cs * 64 + d0; store8(p, y); store8(p + 32, y + 8);
                        bf16_t* p2 = qr + (size_t)row * 512 + cs * 64 + d0; store8(p2, r1); store8(p2 + 32, r2);
                    } else {
                        bf16_t* p = (cs < 14 ? ksl : kwn) + ((size_t)(b * 2 + (cs & 1)) * 2048 + s) * 64 + d0; store8(p, r1); store8(p + 32, r2);
                    }
                } else if (cs < 12) {
                    bf16_t* p = (cs < 10 ? kc : vc) + ((size_t)(b * 2 + (cs & 1)) * 2048 + s) * 64 + d0; store8(p, v); store8(p + 32, v + 8);
                } else if (cs < 20) {
                    bf16_t* p = (cs < 16 ? vslT : vwnT) + ((size_t)(b * 2 + (cs & 1)) * 32 + (s >> 6)) * 4096 + (s & 63);
#pragma unroll
                    for (int i = 0; i < 16; ++i) p[(32 * (i >> 3) + d0 + (i & 7)) * 64] = (bf16_t)f2bf(v[i]);
                } else if (cs < 28) {
                    float y[16];
#pragma unroll
                    for (int i = 0; i < 16; ++i) y[i] = gelu_tanh(v[i]);
                    bf16_t* p = zu + (size_t)row * 512 + (cs - 20) * 64 + d0; store8(p, y); store8(p + 32, y + 8);
                } else if (cs < 36) {
                    const int g = cs - 28;
                    float y[16];
#pragma unroll
                    for (int i = 0; i < 16; ++i) y[i] = gelu_tanh(v[i]);
                    const float rn = rsqrtf(head_ssq(y) * (1.f / 64.f) + EPS);
                    bf16_t* p = zvT + (((size_t)b * 16 + (s >> 7)) * 8 + g) * 8192 + (s & 127);
#pragma unroll
                    for (int i = 0; i < 16; ++i) { const int d = 32 * (i >> 3) + d0 + (i & 7); p[d * 128] = (bf16_t)f2bf(y[i] * rn * g_sgu[g * 64 + d]); }
                } else {
                    if (fq < 3) {
#pragma unroll
                        for (int i = 0; i < 8; ++i) gates[(size_t)row * 24 + d0 + i] = 1.f / (1.f + __expf(-v[i]));
                    }
                }
            }
    }
};

struct EpiPart {
    static constexpr bool PERM = true, AFTER_DRAIN = false;
    float* part;
    __device__ __forceinline__ void operator()(const f32x4 (&acc)[2][2][4][2], const pg8::Unit& u, int wr, int wc, int fr, int fq) const {
        float* base = part + (size_t)(u.koff >> 9) * 8192 * 256;
#pragma unroll
        for (int ai = 0; ai < 2; ++ai)
#pragma unroll
            for (int m = 0; m < 4; ++m) {
                const int row = u.pm * 256 + ai * 128 + wr * 64 + m * 16 + fr;
#pragma unroll
                for (int bj = 0; bj < 2; ++bj) {
                    float* p = base + (size_t)row * 256 + 128 * bj + 32 * wc + 8 * fq;
                    *(f32x4*)p = acc[ai][bj][m][0]; *(f32x4*)(p + 4) = acc[ai][bj][m][1];
                }
            }
    }
};

struct EpiWout {
    static constexpr bool PERM = true, AFTER_DRAIN = false;
    const bf16_t* xb; bf16_t* x2b; float* ssqp; LAS float* red;
    __device__ __forceinline__ void operator()(const f32x4 (&acc)[2][2][4][2], const pg8::Unit& u, int wr, int wc, int fr, int fq) const {
        u32x4 xr[2][4][2];
#pragma unroll
        for (int ai = 0; ai < 2; ++ai)
#pragma unroll
            for (int m = 0; m < 4; ++m)
#pragma unroll
                for (int bj = 0; bj < 2; ++bj)
                    xr[ai][m][bj] = *(const u32x4*)(xb + (size_t)(u.pm * 256 + ai * 128 + wr * 64 + m * 16 + fr) * DM + u.pn * 256 + 128 * bj + 32 * wc + 8 * fq);
        __builtin_amdgcn_sched_barrier(0);
#pragma unroll
        for (int ai = 0; ai < 2; ++ai)
#pragma unroll
            for (int m = 0; m < 4; ++m) {
                const int row = u.pm * 256 + ai * 128 + wr * 64 + m * 16 + fr;
                float ss = 0.f;
#pragma unroll
                for (int bj = 0; bj < 2; ++bj) {
                    const size_t off = (size_t)row * DM + u.pn * 256 + 128 * bj + 32 * wc + 8 * fq;
                    const u32x4 w = xr[ai][m][bj];
                    float y[8];
                    y[0] = __uint_as_float(w.x << 16) + acc[ai][bj][m][0].x; y[1] = __uint_as_float(w.x & 0xffff0000u) + acc[ai][bj][m][0].y;
                    y[2] = __uint_as_float(w.y << 16) + acc[ai][bj][m][0].z; y[3] = __uint_as_float(w.y & 0xffff0000u) + acc[ai][bj][m][0].w;
                    y[4] = __uint_as_float(w.z << 16) + acc[ai][bj][m][1].x; y[5] = __uint_as_float(w.z & 0xffff0000u) + acc[ai][bj][m][1].y;
                    y[6] = __uint_as_float(w.w << 16) + acc[ai][bj][m][1].z; y[7] = __uint_as_float(w.w & 0xffff0000u) + acc[ai][bj][m][1].w;
                    store8(x2b + off, y);
#pragma unroll
                    for (int i = 0; i < 8; ++i) ss += y[i] * y[i];
                }
                ss += __shfl_xor(ss, 16); ss += __shfl_xor(ss, 32);
                if (fq == 0) red[wc * 256 + (row & 255)] = ss;
            }
        __syncthreads();
        { const int tid = threadIdx.x;
          if (tid < 256) ssqp[(size_t)(u.pm * 256 + tid) * 4 + u.pn] = (red[tid] + red[256 + tid]) + (red[512 + tid] + red[768 + tid]); }
    }
};

struct EpiFF1 {
    static constexpr bool PERM = true, AFTER_DRAIN = false;
    const float* ssqp; bf16_t* H;
    __device__ __forceinline__ void operator()(const f32x4 (&acc)[2][2][4][2], const pg8::Unit& u, int wr, int wc, int fr, int fq) const {
        f32x4 sq[2][4];
#pragma unroll
        for (int ai = 0; ai < 2; ++ai)
#pragma unroll
            for (int m = 0; m < 4; ++m) sq[ai][m] = *(const f32x4*)(ssqp + (size_t)(u.pm * 256 + ai * 128 + wr * 64 + m * 16 + fr) * 4);
        __builtin_amdgcn_sched_barrier(0);
#pragma unroll
        for (int ai = 0; ai < 2; ++ai)
#pragma unroll
            for (int m = 0; m < 4; ++m) {
                const int row = u.pm * 256 + ai * 128 + wr * 64 + m * 16 + fr;
                const float tot = (sq[ai][m].x + sq[ai][m].y) + (sq[ai][m].z + sq[ai][m].w);
                const float rn = rsqrtf(tot * (1.f / 1024.f) + EPS);
#pragma unroll
                for (int bj = 0; bj < 2; ++bj) {
                    float y[8];
#pragma unroll
                    for (int n = 0; n < 2; ++n)
#pragma unroll
                        for (int e = 0; e < 4; ++e) { const float h = fmaxf(acc[ai][bj][m][n][e] * rn, 0.f); y[n * 4 + e] = h * h; }
                    store8(H + (size_t)row * FF + u.pn * 256 + 128 * bj + 32 * wc + 8 * fq, y);
                }
            }
    }
};

struct EpiFF2 {
    static constexpr bool PERM = true, AFTER_DRAIN = false;
    const bf16_t* x2b; float* out;
    __device__ __forceinline__ void operator()(const f32x4 (&acc)[2][2][4][2], const pg8::Unit& u, int wr, int wc, int fr, int fq) const {
        u32x4 xr[2][4][2];
#pragma unroll
        for (int ai = 0; ai < 2; ++ai)
#pragma unroll
            for (int m = 0; m < 4; ++m)
#pragma unroll
                for (int bj = 0; bj < 2; ++bj)
                    xr[ai][m][bj] = *(const u32x4*)(x2b + (size_t)(u.pm * 256 + ai * 128 + wr * 64 + m * 16 + fr) * DM + u.pn * 256 + 128 * bj + 32 * wc + 8 * fq);
        __builtin_amdgcn_sched_barrier(0);
#pragma unroll
        for (int ai = 0; ai < 2; ++ai)
#pragma unroll
            for (int m = 0; m < 4; ++m) {
                const int row = u.pm * 256 + ai * 128 + wr * 64 + m * 16 + fr;
#pragma unroll
                for (int bj = 0; bj < 2; ++bj) {
                    const size_t off = (size_t)row * DM + u.pn * 256 + 128 * bj + 32 * wc + 8 * fq;
                    const u32x4 w = xr[ai][m][bj];
                    f32x4 ya = acc[ai][bj][m][0], yb = acc[ai][bj][m][1];
                    ya.x += __uint_as_float(w.x << 16); ya.y += __uint_as_float(w.x & 0xffff0000u); ya.z += __uint_as_float(w.y << 16); ya.w += __uint_as_float(w.y & 0xffff0000u);
                    yb.x += __uint_as_float(w.z << 16); yb.y += __uint_as_float(w.z & 0xffff0000u); yb.z += __uint_as_float(w.w << 16); yb.w += __uint_as_float(w.w & 0xffff0000u);
                    *(f32x4*)(out + off) = ya; *(f32x4*)(out + off + 4) = yb;
                }
            }
    }
};

__device__ __forceinline__ int win_src_col(int nphys) {
    const int pn = nphys >> 8, Pp = nphys & 255, bj = Pp >> 7, wc = (Pp & 127) >> 5, r = Pp & 31;
    const int lc = (pn << 8) + 64 * wc + 32 * bj + r;
    if (lc < 1280) return lc;
    if (lc < 2304) return lc + 24;
    if (lc < 2328) return lc - 1024;
    return -1;
}
template <int MAP>
__device__ __forceinline__ void transpose_item(const float* W, int K, int N, bf16_t* WT, const float* gk, LAS float* scr, int item, int nblk, int lane) {
    const int kb = item / nblk, nb = item % nblk, k0 = 64 * kb, n0 = 32 * nb;
    const int src = MAP ? win_src_col(n0 + (lane & 31)) : n0 + (lane & 31);
    float tv[32];
#pragma unroll
    for (int i = 0; i < 32; ++i) { const int kk = 2 * i + (lane >> 5); tv[i] = (src >= 0) ? W[(size_t)(k0 + kk) * N + src] : 0.f; }
    if (gk) {
#pragma unroll
        for (int i = 0; i < 32; ++i) tv[i] *= gk[k0 + 2 * i + (lane >> 5)]; }
#pragma unroll
    for (int i = 0; i < 32; ++i) scr[(2 * i + (lane >> 5)) * 33 + (lane & 31)] = tv[i];
    asm volatile("s_waitcnt lgkmcnt(0)" ::: "memory");
    const int c = lane & 7;
#pragma unroll
    for (int j = 0; j < 4; ++j) { const int n = (lane >> 3) + 8 * j; const LAS float* s = scr + (8 * c) * 33 + n;
        u32x4 o; o.x = pk2(s[0 * 33], s[1 * 33]); o.y = pk2(s[2 * 33], s[3 * 33]); o.z = pk2(s[4 * 33], s[5 * 33]); o.w = pk2(s[6 * 33], s[7 * 33]);
        *(u32x4*)(WT + (size_t)(n0 + n) * K + k0 + 8 * c) = o; }
    asm volatile("s_waitcnt lgkmcnt(0)" ::: "memory");
}

__device__ __forceinline__ void phase0(const Args& a, LAS unsigned char* lds) {
    const int tid = threadIdx.x, lane = tid & 63, wave = tid >> 6;
    unsigned char* ws = a.ws;
    LAS float* scr = (LAS float*)(lds + wave * 16384);
    const int gw = blockIdx.x * NWAVES + wave, NGW = gridDim.x * NWAVES;
    constexpr int I_IN = 16 * 80, I_C = 32 * 8;
    constexpr int NITEMS = I_IN + 2 * I_C;
    for (int it = gw; it < NITEMS; it += NGW) {
        int r = it;
        if (r < I_IN) { transpose_item<1>(a.in[2], 1024, 2328, (bf16_t*)(ws + WS_WIN), a.in[1], scr, r, 80, lane); continue; } r -= I_IN;
        if (r < I_C) { transpose_item<0>(a.in[6], 2048, 256, (bf16_t*)(ws + WS_W1T), nullptr, scr, r, 8, lane); continue; } r -= I_C;
        transpose_item<0>(a.in[6] + (size_t)2048 * 256, 2048, 256, (bf16_t*)(ws + WS_W1T) + (size_t)256 * 2048, nullptr, scr, r, 8, lane);
    }
    {
        const float* x = a.in[0]; bf16_t* xb = (bf16_t*)(ws + WS_XB); float* rinv1 = (float*)(ws + WS_RINV1);
        for (int m = gw; m < T; m += 2 * NGW) {
            const int m2 = m + NGW;
            const bool has2 = m2 < T;
            const f32x4* xr = (const f32x4*)(x + (size_t)m * DM) + lane;
            const f32x4* xr2 = (const f32x4*)(x + (size_t)(has2 ? m2 : m) * DM) + lane;
            f32x4 v[4], u[4]; float s = 0.f, s2 = 0.f;
#pragma unroll
            for (int j = 0; j < 4; ++j) { v[j] = xr[64 * j]; u[j] = xr2[64 * j]; }
#pragma unroll
            for (int j = 0; j < 4; ++j) { s += (v[j].x * v[j].x + v[j].y * v[j].y) + (v[j].z * v[j].z + v[j].w * v[j].w); s2 += (u[j].x * u[j].x + u[j].y * u[j].y) + (u[j].z * u[j].z + u[j].w * u[j].w); }
            s = wave_sum(s); s2 = wave_sum(s2);
            if (lane == 0) { rinv1[m] = rsqrtf(s * (1.f / 1024.f) + EPS); if (has2) rinv1[m2] = rsqrtf(s2 * (1.f / 1024.f) + EPS); }
            unsigned long long* o8 = (unsigned long long*)(xb + (size_t)m * DM) + lane;
#pragma unroll
            for (int j = 0; j < 4; ++j) o8[64 * j] = (unsigned long long)pk2(v[j].x, v[j].y) | ((unsigned long long)pk2(v[j].z, v[j].w) << 32);
            if (has2) { unsigned long long* o82 = (unsigned long long*)(xb + (size_t)m2 * DM) + lane;
#pragma unroll
                for (int j = 0; j < 4; ++j) o82[64 * j] = (unsigned long long)pk2(u[j].x, u[j].y) | ((unsigned long long)pk2(u[j].z, u[j].w) << 32); }
        }
    }
    {
        bf16_t* Wsp = (bf16_t*)(ws + WS_WSP); const float* spw = a.in[9];
        for (int idx = blockIdx.x * 512 + tid; idx < 8 * 128 * 128; idx += gridDim.x * 512) { const int tq = (idx >> 7) & 127, sq = idx & 127; Wsp[idx] = (bf16_t)f2bf(sq <= tq ? spw[idx] : 0.f); }
    }
    {
        if ((gw & 3) == 0 && (gw >> 2) < 512) {
            const int item = gw >> 2, kv = item >> 8, cg4 = (item >> 6) & 3, kch = item & 63;
            const float* pe = a.in[5] + kv * 2048 + kch * 32; const float* w1 = a.in[6] + ((size_t)kv * 2048 + kch * 32) * 256 + cg4 * 64 + lane;
            float wv[32];
#pragma unroll
            for (int k = 0; k < 32; ++k) wv[k] = w1[(size_t)k * 256];
            float acc = 0.f;
#pragma unroll
            for (int k = 0; k < 32; ++k) acc += pe[k] * wv[k];
            ((float*)(ws + WS_C1P))[kch * 512 + kv * 256 + cg4 * 64 + lane] = acc;
        }
    }
}

__device__ __forceinline__ void phase3(const Args& a, LAS unsigned char* lds) {
    const int tid = threadIdx.x, lane = tid & 63, wave = tid >> 6;
    unsigned char* ws = a.ws;
    const float* part = (const float*)(ws + WS_PART); const float* c1p = (const float*)(ws + WS_C1P);
    bf16_t* kcmp = (bf16_t*)(ws + WS_KCMP); bf16_t* vcmpT = (bf16_t*)(ws + WS_VCMPT);
    LAS float* w2s = (LAS float*)lds;
    LAS float* c1s = w2s + 256 * 64;
    LAS float* hids = c1s + 256;
    const int nchunk = 8192 / 32;
    for (int item = blockIdx.x; item < nchunk; item += gridDim.x) {
        const int kv = (item * 32) >> 12;
        __syncthreads();
        { const f32x4* src = (const f32x4*)(a.in[7] + (size_t)kv * 256 * 64);
#pragma unroll
          for (int i = 0; i < 8; ++i) ((LAS f32x4*)w2s)[tid + 512 * i] = src[tid + 512 * i]; }
        if (tid < 256) { float t = 0.f;
#pragma unroll
            for (int kch = 0; kch < 64; ++kch) t += c1p[kch * 512 + kv * 256 + tid];
            c1s[tid] = t; }
        __syncthreads();
#pragma unroll 1
        for (int rr = 0; rr < 4; ++rr) {
            const int R = item * 32 + wave * 4 + rr, bh = (R >> 7) & 31, n = R & 127;
            f32x4 h4 = *(const LAS f32x4*)(c1s + 4 * lane);
#pragma unroll
            for (int kc = 0; kc < 8; ++kc) h4 += *(const f32x4*)(part + ((size_t)kc * 8192 + R) * 256 + 4 * lane);
            h4.x = gelu_tanh(h4.x); h4.y = gelu_tanh(h4.y); h4.z = gelu_tanh(h4.z); h4.w = gelu_tanh(h4.w);
            *(LAS f32x4*)(hids + wave * 256 + 4 * lane) = h4;
            asm volatile("s_waitcnt lgkmcnt(0)" ::: "memory");
            float acc = 0.f;
#pragma unroll 8
            for (int c = 0; c < 256; ++c) acc += hids[wave * 256 + c] * w2s[c * 64 + lane];
            if (kv == 0) {
                const float ss = wave_sum(acc * acc);
                const float y = acc * rsqrtf(ss * (1.f / 64.f) + EPS) * a.in[4][lane];
                kcmp[((size_t)bh * 128 + n) * 64 + lane] = (bf16_t)f2bf(n < 127 ? y : 0.f);
            } else {
                vcmpT[((size_t)bh * 64 + lane) * 128 + n] = (bf16_t)f2bf(n < 127 ? acc : 0.f);
            }
        }
    }
    {
        LAS float* scr = (LAS float*)(lds + 77824 + wave * 8704);
        const int gw = blockIdx.x * NWAVES + wave, NGW = gridDim.x * NWAVES;
        constexpr int I_O = 16 * 32, I_1 = 16 * 128, I_2 = 64 * 32;
        for (int it = gw; it < I_O + I_1 + I_2; it += NGW) {
            int r = it;
            if (r < I_O) { transpose_item<0>(a.in[12], 1024, 1024, (bf16_t*)(ws + WS_WOUT), a.in[11], scr, r, 32, lane); continue; } r -= I_O;
            if (r < I_1) { transpose_item<0>(a.in[14], 1024, 4096, (bf16_t*)(ws + WS_WFF1), a.in[13], scr, r, 128, lane); continue; } r -= I_1;
            transpose_item<0>(a.in[15], 4096, 1024, (bf16_t*)(ws + WS_WFF2), nullptr, scr, r, 32, lane);
        }
    }
}

typedef short bf16x8_t __attribute__((ext_vector_type(8)));
typedef short s16x4_t __attribute__((ext_vector_type(4)));
typedef float f32x16 __attribute__((ext_vector_type(16)));
typedef __bf16 bf16x2_t __attribute__((ext_vector_type(2)));
typedef float f32x2_t __attribute__((ext_vector_type(2)));
typedef unsigned u32x2 __attribute__((ext_vector_type(2)));
#define MFMA32(a, b, c) __builtin_amdgcn_mfma_f32_32x32x16_bf16((a), (b), (c), 0, 0, 0)
__device__ __forceinline__ unsigned cvtpk(float lo, float hi) { f32x2_t v = {lo, hi}; bf16x2_t b = __builtin_convertvector(v, bf16x2_t); return __builtin_bit_cast(unsigned, b); }
__device__ __forceinline__ float ex2(float x) { return __builtin_amdgcn_exp2f(x); }
__device__ __forceinline__ f32x16 zero16() { f32x16 z;
#pragma unroll
    for (int i = 0; i < 16; ++i) z[i] = 0.f; return z; }
__device__ __forceinline__ bf16x8_t pack8(const f32x16& x, int s8) {
    u32x4 w; w.x = cvtpk(x[s8 + 0], x[s8 + 1]); w.y = cvtpk(x[s8 + 2], x[s8 + 3]); w.z = cvtpk(x[s8 + 4], x[s8 + 5]); w.w = cvtpk(x[s8 + 6], x[s8 + 7]);
    return __builtin_bit_cast(bf16x8_t, w);
}
constexpr int A_KSTR = 144, A_VSTR = 136, A_CVSTR = 264, A_IMPSTR = 33;
constexpr int A_KT = 128 * A_KSTR, A_VT = 64 * A_CVSTR;
constexpr int A_KBUF = 0, A_VBUF = 2 * A_KT, A_CMPK = A_VBUF + 2 * A_VT, A_CMPV = A_CMPK + 18432, A_IMP = A_CMPV + 16896, A_SELM = A_IMP + 4 * 64 * A_IMPSTR * 4, A_SSQ = A_SELM + 256, A_END = A_SSQ + 4096;
static_assert(A_END <= LDS_BYTES - 64, "attention LDS map");

template <int MODE>
__device__ __forceinline__ void attn_tile(const LAS unsigned char* Kb, const LAS unsigned char* Vb, const bf16x8_t (&qf)[4], f32x16 (&oacc)[2], float& l_run,
                                          int r, int h, int dlt0, int dlt1, bool hiw) {
    const unsigned ulim = (MODE == 0) ? 0x80000000u : 512u;
    float ls = 0.f;
#pragma unroll
    for (int mt = 0; mt < 4; ++mt) {
        if (mt == 0) { if (hiw) __builtin_amdgcn_s_setprio(1); else __builtin_amdgcn_s_setprio(0); }
        if (mt == 2) { if (hiw) __builtin_amdgcn_s_setprio(0); else __builtin_amdgcn_s_setprio(1); }
        const int dl = mt < 2 ? dlt0 : dlt1;
        f32x16 sacc = zero16();
#pragma unroll
        for (int ks = 0; ks < 4; ++ks) { const bf16x8_t ka = *(const LAS bf16x8_t*)(Kb + (32 * mt + r) * A_KSTR + 32 * ks + 16 * h); sacc = MFMA32(ka, qf[ks], sacc); }
#pragma unroll
        for (int i = 0; i < 16; ++i) {
            float p;
            if (MODE == 2) p = ex2(sacc[i]);
            else if (MODE == 3) p = ex2(sacc[i] + __int_as_float(dl));
            else { const int ci = 32 * mt + (i & 3) + 8 * (i >> 2); p = ((unsigned)(dl - ci) < ulim) ? ex2(sacc[i]) : 0.f; }
            sacc[i] = p; ls += p;
        }
#pragma unroll
        for (int s = 0; s < 2; ++s) {
            const bf16x8_t pf = pack8(sacc, 8 * s);
#pragma unroll
            for (int dt = 0; dt < 2; ++dt) {
                const LAS unsigned char* vp = Vb + (32 * dt + r) * A_CVSTR + (32 * mt + 16 * s + 4 * h) * 2;
                const s16x4_t lo = *(const LAS s16x4_t*)vp, hi = *(const LAS s16x4_t*)(vp + 16);
                oacc[dt] = MFMA32(__builtin_shufflevector(lo, hi, 0, 1, 2, 3, 4, 5, 6, 7), pf, oacc[dt]);
            }
        }
    }
    l_run += ls;
}

__device__ __forceinline__ void phase4_attn(const Args& a, LAS unsigned char* lds) {
    const int tid0 = threadIdx.x, w = __builtin_amdgcn_readfirstlane(tid0 >> 6), g = w >> 1, half = w & 1;
    unsigned char* ws = a.ws;
    const bf16_t* qn = (const bf16_t*)(ws + WS_QN); const bf16_t* qr = (const bf16_t*)(ws + WS_QR);
    const bf16_t* kcmp = (const bf16_t*)(ws + WS_KCMP); const bf16_t* vcmpT = (const bf16_t*)(ws + WS_VCMPT);
    const bf16_t* ksl = (const bf16_t*)(ws + WS_KSL); const bf16_t* vslT = (const bf16_t*)(ws + WS_VSLT);
    const bf16_t* kwn = (const bf16_t*)(ws + WS_KWN); const bf16_t* vwnT = (const bf16_t*)(ws + WS_VWNT);
    const float* gates = (const float*)(ws + WS_GATES);
    bf16_t* o = (bf16_t*)(ws + WS_O);
    LAS float* IMP = (LAS float*)(lds + A_IMP); LAS unsigned* SELM = (LAS unsigned*)(lds + A_SELM); LAS float* SSQ = (LAS float*)(lds + A_SSQ);
    for (int pr = blockIdx.x; pr < 256; pr += gridDim.x) {
        const int b = pr >> 4, tt0 = pr & 15;
#pragma unroll 1
        for (int it = 0; it < 2; ++it) {
            const int t = it ? 31 - tt0 : tt0;
            f32x16 comb[2][2];
#pragma unroll
            for (int hkv = 0; hkv < 2; ++hkv) {
                const int bh = b * 2 + hkv, head = hkv * 4 + g;
                int tid = tid0; asm volatile("" : "+v"(tid));
                const int lane = tid & 63, r = lane & 31, h = lane >> 5, ql = 32 * half + r, pos = 64 * t + ql, tok = b * 2048 + pos;
                comb[hkv][0] = zero16(); comb[hkv][1] = zero16();
                const float g0 = gates[(size_t)tok * 24 + head * 3 + 0], g1 = gates[(size_t)tok * 24 + head * 3 + 1], g2 = gates[(size_t)tok * 24 + head * 3 + 2];
                __syncthreads();
                {
                    const bf16_t* kc = kcmp + (size_t)bh * 128 * 64; const bf16_t* vc = vcmpT + (size_t)bh * 64 * 128;
#pragma unroll
                    for (int i = 0; i < 2; ++i) { const int c = tid + 512 * i;
                        const u32x4 kv = *(const u32x4*)(kc + (size_t)c * 8);
                        *(LAS u32x4*)(lds + A_CMPK + (c >> 3) * A_KSTR + (c & 7) * 16) = kv;
                        const u32x4 vv = *(const u32x4*)(vc + (size_t)c * 8);
                        LAS unsigned char* vp = lds + A_CMPV + (c >> 4) * A_CVSTR + (c & 15) * 16;
                        *(LAS u32x2*)vp = (u32x2){vv.x, vv.y}; *(LAS u32x2*)(vp + 8) = (u32x2){vv.z, vv.w}; }
                }
                bf16x8_t qf[4];
#pragma unroll
                for (int ks = 0; ks < 4; ++ks) qf[ks] = *(const bf16x8_t*)(qn + (size_t)tok * 512 + head * 64 + 16 * ks + 8 * h);
                __syncthreads();
                {
                    f32x16 s4[4];
#pragma unroll
                    for (int mt = 0; mt < 4; ++mt) { s4[mt] = zero16();
#pragma unroll
                        for (int ks = 0; ks < 4; ++ks) { const bf16x8_t ka = *(const LAS bf16x8_t*)(lds + A_CMPK + (32 * mt + r) * A_KSTR + 32 * ks + 16 * h); s4[mt] = MFMA32(ka, qf[ks], s4[mt]); } }
                    const int clim = (pos - 31 - 64 * h) >> 4;
                    float ls = 0.f;
#pragma unroll
                    for (int mt = 0; mt < 4; ++mt)
#pragma unroll
                        for (int i = 0; i < 16; ++i) { const int ci = 32 * mt + (i & 3) + 8 * (i >> 2);
                            const float p = (ci <= clim) ? ex2(s4[mt][i]) : 0.f; s4[mt][i] = p; ls += p; }
                    ls += __shfl_xor(ls, 32);
                    const float inv = 1.f / fmaxf(ls, 1e-20f);
#pragma unroll
                    for (int mt = 0; mt < 4; ++mt) s4[mt] *= inv;
                    if (t >= 16) {
                        float oprev = 0.f;
#pragma unroll
                        for (int idx = 0; idx < 16; ++idx) {
                            const int mt = idx >> 2, ap = idx & 3;
                            const float tail = 0.5f * s4[mt][4 * ap + 3];
                            const float ot = __shfl_xor(tail, 32);
                            const float inner = s4[mt][4 * ap] + s4[mt][4 * ap + 1] + s4[mt][4 * ap + 2] + tail;
                            const float prev = h ? ot : oprev;
                            oprev = ot;
                            IMP[(g * 64 + ql) * A_IMPSTR + 8 * mt + 2 * ap + h] = inner + prev;
                        }
                    }
                    f32x16 oc[2]; oc[0] = zero16(); oc[1] = zero16();
#pragma unroll
                    for (int mt = 0; mt < 4; ++mt)
#pragma unroll
                        for (int s = 0; s < 2; ++s) {
                            const bf16x8_t pf = pack8(s4[mt], 8 * s);
#pragma unroll
                            for (int dt = 0; dt < 2; ++dt) {
                                const LAS unsigned char* vp = lds + A_CMPV + (32 * dt + r) * A_CVSTR + (32 * mt + 16 * s + 4 * h) * 2;
                                const s16x4_t lo = *(const LAS s16x4_t*)vp, hi = *(const LAS s16x4_t*)(vp + 16);
                                oc[dt] = MFMA32(__builtin_shufflevector(lo, hi, 0, 1, 2, 3, 4, 5, 6, 7), pf, oc[dt]);
                            }
                        }
                    comb[hkv][0] += oc[0] * g0; comb[hkv][1] += oc[1] * g0;
                }
                if (t >= 16) {
                    __syncthreads();
                    const int qloc = tid >> 3, jg = tid & 7;
                    unsigned bits = 0u;
                    float xe[4]; int cnt[4];
#pragma unroll
                    for (int e = 0; e < 4; ++e) { const int j = 4 * jg + e; const LAS float* ip = IMP + qloc * A_IMPSTR + j;
                        float x = (ip[0] + ip[64 * A_IMPSTR]) + (ip[128 * A_IMPSTR] + ip[192 * A_IMPSTR]);
                        if (j == 0 || j == t || j == t - 1) x = 1e9f;
                        if (j > t) x = -INFINITY;
                        xe[e] = x; cnt[e] = 0; }
#pragma unroll 4
                    for (int i = 0; i < 32; ++i) { const LAS float* ip = IMP + qloc * A_IMPSTR + i;
                        float vi = (ip[0] + ip[64 * A_IMPSTR]) + (ip[128 * A_IMPSTR] + ip[192 * A_IMPSTR]);
                        if (i == 0 || i == t || i == t - 1) vi = 1e9f;
                        if (i > t) vi = -INFINITY;
#pragma unroll
                        for (int e = 0; e < 4; ++e) cnt[e] += (vi > xe[e] || (vi == xe[e] && i < 4 * jg + e)) ? 1 : 0; }
#pragma unroll
                    for (int e = 0; e < 4; ++e) if (cnt[e] < 16 && xe[e] > -INFINITY) bits |= 1u << (4 * jg + e);
                    bits |= __shfl_xor(bits, 1); bits |= __shfl_xor(bits, 2); bits |= __shfl_xor(bits, 4);
                    if (jg == 0) SELM[qloc] = bits;
                    __syncthreads();
                }
                const unsigned selw = (t >= 16) ? SELM[ql] : ((2u << t) - 1u);
#pragma unroll
                for (int ks = 0; ks < 4; ++ks) qf[ks] = *(const bf16x8_t*)(qr + (size_t)tok * 512 + head * 64 + 16 * ks + 8 * h);
                const int kt_lo = t >= 8 ? t - 8 : 0, wlo = kt_lo >> 1, n_sel = (t >> 1) + 1, n_all = n_sel + ((t >> 1) - wlo + 1);
                const bf16_t* Ks = ksl + (size_t)bh * 2048 * 64; const bf16_t* Vs = vslT + (size_t)bh * 64 * 2048;
                const bf16_t* Kw = kwn + (size_t)bh * 2048 * 64; const bf16_t* Vw = vwnT + (size_t)bh * 64 * 2048;
#define A_ISSUE(idx) do { const int i1_ = (idx); const bool sel1_ = i1_ < n_sel; const int st1_ = sel1_ ? i1_ : wlo + (i1_ - n_sel); \
        int tv_ = tid; asm volatile("" : "+v"(tv_)); \
        const bf16_t* Kg_ = (sel1_ ? Ks : Kw) + (size_t)st1_ * 8192; const bf16_t* Vg_ = (sel1_ ? Vs : Vw) + (size_t)st1_ * 8192; \
        kR0 = *(const u32x4*)(Kg_ + (size_t)tv_ * 8); kR1 = *(const u32x4*)(Kg_ + (size_t)(tv_ + 512) * 8); \
        vR0 = *(const u32x4*)(Vg_ + (size_t)tv_ * 8); vR1 = *(const u32x4*)(Vg_ + (size_t)(tv_ + 512) * 8); } while (0)
#define A_STAGE(bufi) do { int tv_ = tid; asm volatile("" : "+v"(tv_)); \
        LAS unsigned char* kp_ = lds + A_KBUF + (bufi) * A_KT + (tv_ >> 3) * A_KSTR + (tv_ & 7) * 16; \
        *(LAS u32x4*)kp_ = kR0; *(LAS u32x4*)(kp_ + 64 * A_KSTR) = kR1; \
        LAS unsigned char* vp_ = lds + A_VBUF + (bufi) * A_VT + (tv_ >> 3) * A_CVSTR + (tv_ & 7) * 16; \
        *(LAS u32x2*)vp_ = (u32x2){vR0.x, vR0.y}; *(LAS u32x2*)(vp_ + 8) = (u32x2){vR0.z, vR0.w}; \
        *(LAS u32x2*)(vp_ + 128) = (u32x2){vR1.x, vR1.y}; *(LAS u32x2*)(vp_ + 136) = (u32x2){vR1.z, vR1.w}; } while (0)
                u32x4 kR0, kR1, vR0, vR1;
                A_ISSUE(0);
                A_STAGE(0);
                __syncthreads();
                f32x16 oacc[2]; oacc[0] = zero16(); oacc[1] = zero16();
                float l_run = 0.f;
#pragma unroll 1
                for (int i = 0; i < n_all; ++i) {
                    const int bufo = i & 1;
                    if (i + 1 < n_all) A_ISSUE(i + 1);
                    const LAS unsigned char* Kb = lds + A_KBUF + bufo * A_KT; const LAS unsigned char* Vb = lds + A_VBUF + bufo * A_VT;
                    const bool issel = i < n_sel;
                    const int st = issel ? i : wlo + (i - n_sel);
                    const int dlt = 64 * t + ql - 128 * st - 4 * h;
                    if (issel) {
                        const bool b0 = (selw >> (2 * st)) & 1u, b1 = (selw >> (2 * st + 1)) & 1u;
                        if (__ballot(b0 || b1) != 0ull) {
                            if (2 * st + 1 < t) {
                                if (__ballot(b0 && b1) == ~0ull) attn_tile<2>(Kb, Vb, qf, oacc, l_run, r, h, dlt, dlt, (w & 4) != 0);
                                else attn_tile<3>(Kb, Vb, qf, oacc, l_run, r, h, __float_as_int(b0 ? 0.f : -1e30f), __float_as_int(b1 ? 0.f : -1e30f), (w & 4) != 0);
                            } else attn_tile<0>(Kb, Vb, qf, oacc, l_run, r, h, b0 ? dlt : -1, b1 ? dlt : -1, (w & 4) != 0);
                        }
                    } else {
                        if (2 * st > t - 8 && 2 * st + 1 < t) attn_tile<2>(Kb, Vb, qf, oacc, l_run, r, h, dlt, dlt, (w & 4) != 0);
                        else attn_tile<1>(Kb, Vb, qf, oacc, l_run, r, h, dlt, dlt, (w & 4) != 0);
                    }
                    if (i == n_sel - 1 || i == n_all - 1) { const float lt = l_run + __shfl_xor(l_run, 32); const float sc = ((i == n_sel - 1) ? g1 : g2) / fmaxf(lt, 1e-20f);
                        comb[hkv][0] += oacc[0] * sc; comb[hkv][1] += oacc[1] * sc; oacc[0] = zero16(); oacc[1] = zero16(); l_run = 0.f; }
                    if (i + 1 < n_all) A_STAGE(bufo ^ 1);
                    __syncthreads();
                }
#undef A_ISSUE
#undef A_STAGE
            }
            int tid = tid0; asm volatile("" : "+v"(tid));
            const int lane = tid & 63, r = lane & 31, h = lane >> 5, ql = 32 * half + r, pos = 64 * t + ql, tok = b * 2048 + pos;
            float ss = 0.f;
#pragma unroll
            for (int hkv = 0; hkv < 2; ++hkv)
#pragma unroll
                for (int dt = 0; dt < 2; ++dt)
#pragma unroll
                    for (int i = 0; i < 16; ++i) ss += comb[hkv][dt][i] * comb[hkv][dt][i];
            ss += __shfl_xor(ss, 32);
            if (h == 0) SSQ[w * 32 + r] = ss;
            __syncthreads();
            const float tot = (SSQ[(half + 0) * 32 + r] + SSQ[(half + 2) * 32 + r]) + (SSQ[(half + 4) * 32 + r] + SSQ[(half + 6) * 32 + r]);
            const float rn = rsqrtf(tot * (1.f / 512.f) + EPS);
#pragma unroll
            for (int hkv = 0; hkv < 2; ++hkv)
#pragma unroll
                for (int dt = 0; dt < 2; ++dt)
#pragma unroll
                    for (int ap = 0; ap < 4; ++ap) {
                        u32x2 pk; pk.x = cvtpk(comb[hkv][dt][4 * ap] * rn, comb[hkv][dt][4 * ap + 1] * rn); pk.y = cvtpk(comb[hkv][dt][4 * ap + 2] * rn, comb[hkv][dt][4 * ap + 3] * rn);
                        *(u32x2*)(o + (size_t)tok * DM + (hkv * 4 + g) * 64 + 32 * dt + 8 * ap + 4 * h) = pk;
                    }
        }
    }
}

constexpr int G_TSTR = 136, G_TILE = 128 * G_TSTR, G_SSQ = 8 * G_TILE;
static_assert(G_SSQ + 8 * 128 * 4 <= LDS_BYTES - 64, "gMLP LDS map");
__device__ __forceinline__ void phase4_gmlp(const Args& a, LAS unsigned char* lds) {
    const int tid0 = threadIdx.x, g = __builtin_amdgcn_readfirstlane(tid0 >> 6);
    unsigned char* ws = a.ws;
    const bf16_t* zu = (const bf16_t*)(ws + WS_ZU); const bf16_t* zvT = (const bf16_t*)(ws + WS_ZVT); const bf16_t* Wsp = (const bf16_t*)(ws + WS_WSP);
    const float* sp_b = a.in[10];
    bf16_t* o = (bf16_t*)(ws + WS_O);
    LAS float* SSQ2 = (LAS float*)(lds + G_SSQ);
    LAS unsigned char* tile = lds + g * G_TILE;
    for (int item = blockIdx.x; item < 256; item += gridDim.x) {
        const int b = item >> 4, ch = item & 15;
        const size_t tok0 = (size_t)b * 2048 + ch * 128;
        int tid = tid0; asm volatile("" : "+v"(tid));
        const int lane = tid & 63, r = lane & 31, h = lane >> 5;
        __syncthreads();
        bf16x8_t zf[2][8];
#pragma unroll
        for (int dt = 0; dt < 2; ++dt)
#pragma unroll
            for (int ks = 0; ks < 8; ++ks) zf[dt][ks] = *(const bf16x8_t*)(zvT + ((((size_t)b * 16 + ch) * 8 + g) * 64 + 32 * dt + r) * 128 + 16 * ks + 8 * h);
        f32x16 acc[2][4];
#pragma unroll
        for (int tt = 0; tt < 4; ++tt) { acc[0][tt] = zero16(); acc[1][tt] = zero16();
            __builtin_amdgcn_sched_barrier(0);
#pragma unroll
            for (int ks = 0; ks < 2 * tt + 2; ++ks) {
                const bf16x8_t wf = *(const bf16x8_t*)(Wsp + ((size_t)g * 128 + 32 * tt + r) * 128 + 16 * ks + 8 * h);
                acc[0][tt] = MFMA32(zf[0][ks], wf, acc[0][tt]); acc[1][tt] = MFMA32(zf[1][ks], wf, acc[1][tt]);
            } }
        __builtin_amdgcn_sched_barrier(0);
#pragma unroll
        for (int hb = 0; hb < 2; ++hb) {
            u32x4 zr[8];
#pragma unroll
            for (int it = 0; it < 8; ++it) zr[it] = *(const u32x4*)(zu + (tok0 + (lane >> 3) + 8 * (8 * hb + it)) * 512 + g * 64 + (lane & 7) * 8);
#pragma unroll
            for (int it = 0; it < 8; ++it) { LAS unsigned char* p = tile + ((lane >> 3) + 8 * (8 * hb + it)) * G_TSTR + (lane & 7) * 16;
                *(LAS u32x2*)p = (u32x2){zr[it].x, zr[it].y}; *(LAS u32x2*)(p + 8) = (u32x2){zr[it].z, zr[it].w}; }
        }
        asm volatile("s_waitcnt lgkmcnt(0)" ::: "memory");
#pragma unroll
        for (int tt = 0; tt < 4; ++tt) {
            const int tl = 32 * tt + r;
            const float bias = sp_b[g * 128 + tl];
            float ss = 0.f;
#pragma unroll
            for (int dt = 0; dt < 2; ++dt)
#pragma unroll
                for (int ap = 0; ap < 4; ++ap) {
                    const u32x2 zz = *(const LAS u32x2*)(tile + tl * G_TSTR + (32 * dt + 8 * ap + 4 * h) * 2);
                    const float z0 = __uint_as_float(zz.x << 16), z1 = __uint_as_float(zz.x & 0xffff0000u), z2 = __uint_as_float(zz.y << 16), z3 = __uint_as_float(zz.y & 0xffff0000u);
                    float v0 = z0 * (acc[dt][tt][4 * ap] + bias), v1 = z1 * (acc[dt][tt][4 * ap + 1] + bias), v2 = z2 * (acc[dt][tt][4 * ap + 2] + bias), v3 = z3 * (acc[dt][tt][4 * ap + 3] + bias);
                    acc[dt][tt][4 * ap] = v0; acc[dt][tt][4 * ap + 1] = v1; acc[dt][tt][4 * ap + 2] = v2; acc[dt][tt][4 * ap + 3] = v3;
                    ss += (v0 * v0 + v1 * v1) + (v2 * v2 + v3 * v3);
                }
            ss += __shfl_xor(ss, 32);
            if (h == 0) SSQ2[g * 128 + tl] = ss;
        }
        __syncthreads();
#pragma unroll
        for (int tt = 0; tt < 4; ++tt) {
            const int tl = 32 * tt + r;
            float tot = 0.f;
#pragma unroll
            for (int gg = 0; gg < 8; ++gg) tot += SSQ2[gg * 128 + tl];
            const float rn = rsqrtf(tot * (1.f / 512.f) + EPS);
#pragma unroll
            for (int dt = 0; dt < 2; ++dt)
#pragma unroll
                for (int ap = 0; ap < 4; ++ap) {
                    u32x2 pk; pk.x = cvtpk(acc[dt][tt][4 * ap] * rn, acc[dt][tt][4 * ap + 1] * rn); pk.y = cvtpk(acc[dt][tt][4 * ap + 2] * rn, acc[dt][tt][4 * ap + 3] * rn);
                    *(LAS u32x2*)(tile + tl * G_TSTR + (32 * dt + 8 * ap + 4 * h) * 2) = pk;
                }
        }
        asm volatile("s_waitcnt lgkmcnt(0)" ::: "memory");
#pragma unroll
        for (int it = 0; it < 16; ++it) { const LAS unsigned char* p = tile + ((lane >> 3) + 8 * it) * G_TSTR + (lane & 7) * 16;
            const u32x2 lo = *(const LAS u32x2*)p, hi = *(const LAS u32x2*)(p + 8);
            *(u32x4*)(o + (tok0 + (lane >> 3) + 8 * it) * DM + 512 + g * 64 + (lane & 7) * 8) = (u32x4){lo.x, lo.y, hi.x, hi.y}; }
    }
}

constexpr int BAR_BYTES = (1024 + 8 * 2304) * 4;
__device__ __forceinline__ unsigned xb_ld(unsigned* p) { return __hip_atomic_load(p, __ATOMIC_RELAXED, __HIP_MEMORY_SCOPE_AGENT); }
__device__ __forceinline__ unsigned xb_add(unsigned* p, unsigned v) { return __hip_atomic_fetch_add(p, v, __ATOMIC_RELAXED, __HIP_MEMORY_SCOPE_AGENT); }
__device__ __forceinline__ unsigned xb_xcc_id() { return (unsigned)__builtin_amdgcn_s_getreg((3 << 11) | 20) & 0xFu; }
__device__ __forceinline__ void grid_barrier(unsigned* barw, int k, volatile LAS unsigned* st) {
    asm volatile("s_waitcnt vmcnt(0)" ::: "memory");
    __syncthreads();
    if (threadIdx.x == 0) {
        __builtin_amdgcn_s_waitcnt(0);
        const unsigned x = xb_xcc_id();
        unsigned nloc = st[0], nx = st[1];
        if (nloc == 0u) {
            const unsigned G = gridDim.x;
            for (;;) { unsigned sum = 0u, cnt = 0u, mine = 0u;
#pragma unroll
                for (unsigned j = 0; j < 16; ++j) { const unsigned c = xb_ld(barw + 64 * j); sum += c; cnt += (c > 0u) ? 1u : 0u; mine = (j == x) ? c : mine; }
                if (sum == G) { nloc = mine; nx = cnt; break; }
                __builtin_amdgcn_s_sleep(1); }
            st[0] = nloc; st[1] = nx;
        }
        unsigned* sb = barw + 1024 + k * 2304;
        const unsigned old = xb_add(sb + 64 * x, 1u);
        if (old + 1u == nloc) {
            __builtin_amdgcn_fence(__ATOMIC_RELEASE, "agent");
            asm volatile("s_waitcnt vmcnt(0)" ::: "memory");
            const unsigned og = xb_add(sb + 2048, 1u);
            if (og + 1u == nx) xb_add(sb + 2112, 1u);
            else while (xb_ld(sb + 2112) == 0u) __builtin_amdgcn_s_sleep(1);
            __builtin_amdgcn_fence(__ATOMIC_ACQUIRE, "agent");
            xb_add(sb + 1024 + 64 * x, 1u);
            asm volatile("s_waitcnt vmcnt(0)" ::: "memory");
        } else {
            while (xb_ld(sb + 1024 + 64 * x) == 0u) __builtin_amdgcn_s_sleep(1);
            __builtin_amdgcn_fence(__ATOMIC_ACQUIRE, "agent");
            asm volatile("s_waitcnt vmcnt(0)" ::: "memory");
        }
    }
    __syncthreads();
}

#ifndef N_LAUNCHES
#define N_LAUNCHES 1
#endif
constexpr int NPHASE = 8;
__global__ void __launch_bounds__(NWAVES * 64, 2) fwd_kernel(Args args) {
    extern __shared__ __attribute__((aligned(16))) unsigned char lds_raw[];
    LAS unsigned char* lds = (LAS unsigned char*)lds_raw;
    unsigned char* ws = args.ws;
    const int lo = args.ph_lo, hi = args.ph_hi;
    const int G = gridDim.x;
#define IN(k) (lo <= (k) && (k) < hi)
    unsigned* barw = (unsigned*)ws;
    volatile LAS unsigned* bst = (volatile LAS unsigned*)(lds + LDS_BYTES - 64);
    if (threadIdx.x == 0) { bst[0] = 0u; bst[1] = 0u; (void)xb_add(barw + 64 * xb_xcc_id(), 1u); }
    __syncthreads();
    if (hi > NPHASE) cg::this_grid().sync();
#define SEAM(k) do { if (IN(k) && IN((k) + 1)) { grid_barrier(barw, (k), bst); } } while (0)
    if (IN(0)) { phase0(args, lds); }
    SEAM(0);
    if (IN(1)) {
        pg8::Gemm g{(const bf16_t*)(ws + WS_XB), (const bf16_t*)(ws + WS_WIN), T, NIN, DM, DM, DM};
        pg8::StaticOrder So; So.init(T, NIN, G, (int)blockIdx.x);
        EpiInProj E{(const float*)(ws + WS_RINV1), args.in[3], args.in[4], args.in[8], (const float*)(ws + WS_ROPEC), (const float*)(ws + WS_ROPES),
                    (bf16_t*)(ws + WS_QN), (bf16_t*)(ws + WS_QR), (bf16_t*)(ws + WS_KC), (bf16_t*)(ws + WS_VC), (bf16_t*)(ws + WS_KSL), (bf16_t*)(ws + WS_VSLT),
                    (bf16_t*)(ws + WS_KWN), (bf16_t*)(ws + WS_VWNT), (bf16_t*)(ws + WS_ZU), (bf16_t*)(ws + WS_ZVT), (float*)(ws + WS_GATES)};
        pg8::gemm_phase<EpiInProj, pg8::StaticOrder, true, true>(lds, g, So, E);
    }
    SEAM(1);
    if (IN(2)) {
        pg8::Gemm g{(const bf16_t*)(ws + WS_KC), (const bf16_t*)(ws + WS_W1T), 8192, 512, 256, 1024, 2048};
        pg8::CmpOrder So{G, (int)blockIdx.x};
        EpiPart E{(float*)(ws + WS_PART)};
        pg8::gemm_phase<EpiPart, pg8::CmpOrder, false, true>(lds, g, So, E);
    }
    SEAM(2);
    if (IN(3)) { phase3(args, lds); }
    SEAM(3);
    if (IN(4)) { phase4_attn(args, lds); phase4_gmlp(args, lds); }
    SEAM(4);
    if (IN(5)) {
        pg8::Gemm g{(const bf16_t*)(ws + WS_O), (const bf16_t*)(ws + WS_WOUT), T, DM, DM, DM, DM};
        pg8::StaticOrder So; So.init(T, DM, G, (int)blockIdx.x);
        EpiWout E{(const bf16_t*)(ws + WS_XB), (bf16_t*)(ws + WS_X2B), (float*)(ws + WS_SSQP), (LAS float*)(lds + 131072)};
        pg8::gemm_phase<EpiWout, pg8::StaticOrder, true, true>(lds, g, So, E);
    }
    SEAM(5);
    if (IN(6)) {
        pg8::Gemm g{(const bf16_t*)(ws + WS_X2B), (const bf16_t*)(ws + WS_WFF1), T, FF, DM, DM, DM};
        pg8::StaticOrder So; So.init(T, FF, G, (int)blockIdx.x);
        EpiFF1 E{(const float*)(ws + WS_SSQP), (bf16_t*)(ws + WS_H)};
        pg8::gemm_phase<EpiFF1, pg8::StaticOrder, true, true>(lds, g, So, E);
    }
    SEAM(6);
    if (IN(7)) {
        pg8::Gemm g{(const bf16_t*)(ws + WS_H), (const bf16_t*)(ws + WS_WFF2), T, DM, FF, FF, FF};
        pg8::StaticOrder So; So.init(T, DM, G, (int)blockIdx.x);
        EpiFF2 E{(const bf16_t*)(ws + WS_X2B), args.out};
        pg8::gemm_phase<EpiFF2, pg8::StaticOrder, true, true>(lds, g, So, E);
    }
#undef IN
#undef SEAM
}

extern "C" void kernel_launch(void* const* d_in, const int* in_sizes, int n_in, void* d_out, int out_size, void* d_ws, size_t ws_size, hipStream_t stream) {
    static int grid = 0;
    if (grid == 0) {
        if (n_in != 16 || out_size != T * DM || ws_size < WS_END) { fprintf(stderr, "kernel_launch: unexpected shapes (n_in %d out %d ws %zu)\n", n_in, out_size, ws_size); grid = -1; return; }
        int dev = 0, cus = 0, per_cu = 0;
        hipGetDevice(&dev); hipDeviceGetAttribute(&cus, hipDeviceAttributeMultiprocessorCount, dev);
        if (hipFuncSetAttribute((const void*)fwd_kernel, hipFuncAttributeMaxDynamicSharedMemorySize, LDS_BYTES) != hipSuccess) { fprintf(stderr, "kernel_launch: hipFuncSetAttribute failed\n"); grid = -1; return; }
        if (hipOccupancyMaxActiveBlocksPerMultiprocessor(&per_cu, (const void*)fwd_kernel, NWAVES * 64, LDS_BYTES) != hipSuccess || per_cu < 1) { fprintf(stderr, "kernel_launch: occupancy query says %d\n", per_cu); per_cu = 1; }
        (void)hipGetLastError();
        grid = cus * per_cu;
        fprintf(stderr, "kernel_launch: grid %d (cus %d x %d)\n", grid, cus, per_cu);
    }
    if (grid < 0) return;
    if (hipMemsetAsync(d_ws, 0, BAR_BYTES, stream) != hipSuccess) { fprintf(stderr, "kernel_launch: memset of the barrier words failed\n"); return; }
    Args a{};
    for (int i = 0; i < 16; ++i) a.in[i] = (const float*)d_in[i];
    a.out = (float*)d_out; a.ws = (unsigned char*)d_ws;
#if N_LAUNCHES == 1
    a.ph_lo = 0; a.ph_hi = NPHASE;
    void* kargs[] = {&a};
    hipError_t e = hipLaunchCooperativeKernel((const void*)fwd_kernel, dim3(grid), dim3(NWAVES * 64), kargs, LDS_BYTES, stream);
    if (e != hipSuccess) fprintf(stderr, "kernel_launch: cooperative launch failed: %s (grid %d)\n", hipGetErrorString(e), grid);
#else
    for (int p = 0; p < NPHASE; ++p) {
        a.ph_lo = p; a.ph_hi = p + 1;
        hipLaunchKernelGGL(fwd_kernel, dim3(grid), dim3(NWAVES * 64), LDS_BYTES, stream, a);
    }
#endif
}
```

```cpp
#include <hip/hip_runtime.h>
#include <hip/hip_cooperative_groups.h>
#include <cstdio>
#include <cstdint>
namespace cg = cooperative_groups;

#define LAS __attribute__((address_space(3)))
typedef unsigned short bf16_t;
typedef unsigned u32x4 __attribute__((ext_vector_type(4)));
typedef float f32x4 __attribute__((ext_vector_type(4)));

namespace pg8 {
#define PG8_LAS __attribute__((address_space(3)))
typedef short bf16x8 __attribute__((ext_vector_type(8)));
constexpr int BM = 256, BK = 64, HALF = 128, HTB = HALF * BK * 2, STAGE_BYTES = 8 * HTB, NXCD = 8, WGM = 4;
__host__ __device__ __forceinline__ int lds_byte(int r, int c) { const int st = (r >> 4) * 2 + (c >> 5), rr = r & 15, cc = c & 31, ob = rr * 64 + cc * 2; return st * 1024 + (ob ^ (((ob >> 9) & 1) << 5)); }
__host__ __device__ __forceinline__ void stage_rc(int b, int& R, int& C) { const int st = b / 1024, sb = b % 1024, swz = sb ^ (((sb >> 9) & 1) << 5); R = (st >> 1) * 16 + swz / 64; C = (st & 1) * 32 + (swz % 64) / 2; }
__host__ __device__ __forceinline__ int perm32(int rho) { const int n = rho >> 4, i = rho & 15; return 8 * (i >> 2) + 4 * n + (i & 3); }
struct Unit { int pm, pn, koff; };
struct Gemm { const bf16_t* A; const bf16_t* Bt; int M, N, K, lda, ldb; };
struct StaticOrder {
    int nM, nN, nwg, G, c;
    __host__ __device__ void init(int M, int N, int G_, int c_) { nM = M / BM; nN = N / BM; nwg = nM * nN; G = G_; c = c_; }
    __host__ __device__ bool next(int i, Unit& u) const {
        const long L = (long)i * G + c; if (L >= nwg) return false;
        int wgid = (int)L; { const int q = nwg / NXCD, r = nwg % NXCD, xcd = wgid % NXCD, off = wgid / NXCD; wgid = (xcd < r ? xcd * (q + 1) : r * (q + 1) + (xcd - r) * q) + off; }
        const int nig = WGM * nN, gid = wgid / nig, fm = gid * WGM, gsz = (nM - fm) < WGM ? (nM - fm) : WGM;
        u.pm = fm + ((wgid % nig) % gsz); u.pn = (wgid % nig) / gsz; u.koff = 0; return true;
    }
    __device__ __forceinline__ void a_ready(const Unit&) const {}
    __device__ __forceinline__ void done(const Unit&) const {}
};
struct CmpOrder {
    int G, c;
    __device__ bool next(int i, Unit& u) const { const long L = (long)i * G + c; if (L >= 256) return false; u.pm = (int)L & 31; u.pn = u.pm >> 4; u.koff = ((int)L >> 5) * 512; return true; }
    __device__ __forceinline__ void a_ready(const Unit&) const {}
    __device__ __forceinline__ void done(const Unit&) const {}
};
__device__ __forceinline__ unsigned cvt_pk_bf16(float lo, float hi) { unsigned r; asm volatile("v_cvt_pk_bf16_f32 %0, %1, %2" : "=v"(r) : "v"(lo), "v"(hi)); return r; }
template <class Epi, class Sched, bool ALIGN_EPI = false, bool SP2 = false>
__device__ __forceinline__ void gemm_phase(PG8_LAS unsigned char* lds, const Gemm g, const Sched& S, const Epi& E) {
    const int tid = threadIdx.x, wid = __builtin_amdgcn_readfirstlane(tid >> 6), lane = tid & 63, wr = wid >> 2, wc = wid & 3, fr = lane & 15, fq = lane >> 4;
    const int K = g.K, nt = K / BK, lda = g.lda, ldb = g.ldb;
    unsigned voffA[2], voffB[2];
#pragma unroll
    for (int i = 0; i < 2; ++i) { int R, C; stage_rc(tid * 16 + i * 8192, R, C); const int Rb = Epi::PERM ? ((R & ~31) + perm32(R & 31)) : R;
        voffA[i] = (unsigned)(R * lda + C) * 2u; voffB[i] = (unsigned)(Rb * ldb + C) * 2u; }
    const size_t kstep = (size_t)(BK * 2);
    const size_t hstepA = (size_t)HALF * lda * 2, hstepB = (size_t)HALF * ldb * 2;
    const size_t tstepA = 2 * hstepA, tstepB = 2 * hstepB;
    const unsigned ldsw = (unsigned)wid * 1024u;
    const int aoff = lds_byte(wr * 64 + fr, fq * 8), boff = lds_byte(wc * 32 + fr, fq * 8);
#define PG8_SA(b, h) (((b) * 2 + (h)) * HTB)
#define PG8_SB(b, h) ((4 + (b) * 2 + (h)) * HTB)
#define PG8_STAGE(bufoff, gbase, voff) do { _Pragma("unroll") for (int _i = 0; _i < 2; ++_i) \
        __builtin_amdgcn_global_load_lds((const unsigned*)((const char*)(gbase) + (voff)[_i]), (PG8_LAS unsigned*)(lds + (bufoff) + ldsw + _i * 8192), 16, 0, 0); } while (0)
#define PG8_LDA(dst, b, h) do { _Pragma("unroll") for (int m = 0; m < 4; ++m) _Pragma("unroll") for (int k = 0; k < 2; ++k) dst[m][k] = *(const PG8_LAS bf16x8*)(lds + PG8_SA(b, h) + aoff + m * 2048 + k * 1024); } while (0)
#define PG8_LDB(dst, b, h) do { _Pragma("unroll") for (int n = 0; n < 2; ++n) _Pragma("unroll") for (int k = 0; k < 2; ++k) dst[n][k] = *(const PG8_LAS bf16x8*)(lds + PG8_SB(b, h) + boff + n * 2048 + k * 1024); } while (0)
#define PG8_MMA(ai, bj, At, Bt) do { __builtin_amdgcn_s_setprio(1); _Pragma("unroll") for (int m = 0; m < 4; ++m) _Pragma("unroll") for (int n = 0; n < 2; ++n) _Pragma("unroll") for (int k = 0; k < 2; ++k) \
        acc[ai][bj][m][n] = __builtin_amdgcn_mfma_f32_16x16x32_bf16(Bt[n][k], At[m][k], acc[ai][bj][m][n], 0, 0, 0); __builtin_amdgcn_s_setprio(0); } while (0)
#define PG8_WAIT_V(n) asm volatile("s_waitcnt vmcnt(" #n ")" ::: "memory")
#define PG8_WAIT_L(n) asm volatile("s_waitcnt lgkmcnt(" #n ")" ::: "memory")
#define PG8_BAR __builtin_amdgcn_s_barrier()
#define PG8_SCHED __builtin_amdgcn_sched_barrier(0)
    Unit cur, nxt; int ui = 0;
    if (!S.next(0, cur)) return;
    f32x4 acc[2][2][4][2];
#pragma unroll
    for (int a = 0; a < 2; ++a)
#pragma unroll
        for (int b = 0; b < 2; ++b)
#pragma unroll
            for (int m = 0; m < 4; ++m)
#pragma unroll
                for (int n = 0; n < 2; ++n) acc[a][b][m][n] = (f32x4){0.f, 0.f, 0.f, 0.f};
    bf16x8 At[4][2], B0[2][2], B1[2][2];
    const char* cA = (const char*)g.A + (size_t)cur.pm * tstepA + cur.koff; const char* cB = (const char*)g.Bt + (size_t)cur.pn * tstepB + cur.koff;
    S.a_ready(cur);
    if constexpr (SP2) {
        PG8_STAGE(PG8_SB(0, 0), cB, voffB); PG8_STAGE(PG8_SB(0, 1), cB + hstepB, voffB); PG8_STAGE(PG8_SA(0, 0), cA, voffA); PG8_STAGE(PG8_SA(0, 1), cA + hstepA, voffA);
        if (wr == 1) PG8_BAR;
        PG8_WAIT_V(2); PG8_BAR;
        PG8_STAGE(PG8_SB(1, 0), cB + kstep, voffB); PG8_STAGE(PG8_SA(1, 0), cA + kstep, voffA); PG8_STAGE(PG8_SB(1, 1), cB + hstepB + kstep, voffB);
        PG8_WAIT_V(6); PG8_BAR;
    } else {
        PG8_STAGE(PG8_SB(0, 0), cB, voffB); PG8_STAGE(PG8_SA(0, 0), cA, voffA); PG8_STAGE(PG8_SB(0, 1), cB + hstepB, voffB); PG8_STAGE(PG8_SA(0, 1), cA + hstepA, voffA);
        if (wr == 1) PG8_BAR;
        PG8_WAIT_V(4); PG8_BAR;
        PG8_STAGE(PG8_SB(1, 0), cB + kstep, voffB); PG8_STAGE(PG8_SA(1, 0), cA + kstep, voffA); PG8_STAGE(PG8_SB(1, 1), cB + hstepB + kstep, voffB);
        PG8_WAIT_V(6); PG8_BAR;
    }
    for (;;) {
        const bool has_next = S.next(ui + 1, nxt);
        const char* nA = has_next ? (const char*)g.A + (size_t)nxt.pm * tstepA + nxt.koff : cA; const char* nB = has_next ? (const char*)g.Bt + (size_t)nxt.pn * tstepB + nxt.koff : cB;
        for (int t = 0; t < nt; t += 2) {
            const bool last = (t == nt - 2);
            const char* a1 = cA + (size_t)(t + 1) * kstep;
            const char* a2 = last ? nA : cA + (size_t)(t + 2) * kstep; const char* b2 = last ? nB : cB + (size_t)(t + 2) * kstep;
            const char* a3 = a2 + kstep; const char* b3 = b2 + kstep;
            if (last && has_next) S.a_ready(nxt);
            if constexpr (SP2) {
            PG8_LDB(B0, 0, 0); PG8_LDB(B1, 0, 1); PG8_SCHED; PG8_LDA(At, 0, 0); PG8_STAGE(PG8_SA(1, 1), a1 + hstepA, voffA);
            PG8_WAIT_V(8); PG8_WAIT_L(0); PG8_BAR; PG8_MMA(0, 0, At, B0); PG8_MMA(0, 1, At, B1); PG8_BAR; PG8_SCHED;
            PG8_LDA(At, 0, 1); PG8_STAGE(PG8_SB(0, 0), b2, voffB); PG8_STAGE(PG8_SB(0, 1), b2 + hstepB, voffB); PG8_STAGE(PG8_SA(0, 0), a2, voffA);
            PG8_WAIT_V(8); PG8_WAIT_L(0); PG8_BAR; PG8_MMA(1, 0, At, B0); PG8_MMA(1, 1, At, B1); PG8_BAR; PG8_SCHED;
            PG8_LDB(B0, 1, 0); PG8_LDB(B1, 1, 1); PG8_SCHED; PG8_LDA(At, 1, 0); PG8_STAGE(PG8_SA(0, 1), a2 + hstepA, voffA);
            PG8_WAIT_V(8); PG8_WAIT_L(0); PG8_BAR; PG8_MMA(0, 0, At, B0); PG8_MMA(0, 1, At, B1); PG8_BAR; PG8_SCHED;
            PG8_LDA(At, 1, 1); PG8_STAGE(PG8_SB(1, 0), b3, voffB); PG8_STAGE(PG8_SB(1, 1), b3 + hstepB, voffB); PG8_STAGE(PG8_SA(1, 0), a3, voffA);
            PG8_WAIT_V(8); PG8_WAIT_L(0); PG8_BAR; PG8_MMA(1, 0, At, B0); PG8_MMA(1, 1, At, B1); PG8_BAR; PG8_SCHED;
            } else {
            PG8_LDB(B0, 0, 0); PG8_SCHED; PG8_LDA(At, 0, 0); PG8_STAGE(PG8_SA(1, 1), a1 + hstepA, voffA);
            PG8_WAIT_L(8); PG8_BAR; PG8_WAIT_L(0); PG8_MMA(0, 0, At, B0); PG8_BAR; PG8_SCHED;
            PG8_LDB(B1, 0, 1); PG8_STAGE(PG8_SB(0, 0), b2, voffB);
            PG8_BAR; PG8_WAIT_L(0); PG8_MMA(0, 1, At, B1); PG8_BAR;
            PG8_LDA(At, 0, 1); PG8_STAGE(PG8_SA(0, 0), a2, voffA);
            PG8_BAR; PG8_WAIT_L(0); PG8_MMA(1, 0, At, B0); PG8_BAR; PG8_SCHED;
            PG8_STAGE(PG8_SB(0, 1), b2 + hstepB, voffB);
            PG8_WAIT_V(6); PG8_BAR; PG8_MMA(1, 1, At, B1); PG8_BAR;
            PG8_LDB(B0, 1, 0); PG8_SCHED; PG8_LDA(At, 1, 0); PG8_STAGE(PG8_SA(0, 1), a2 + hstepA, voffA);
            PG8_WAIT_L(8); PG8_BAR; PG8_WAIT_L(0); PG8_MMA(0, 0, At, B0); PG8_BAR; PG8_SCHED;
            PG8_LDB(B1, 1, 1); PG8_STAGE(PG8_SB(1, 0), b3, voffB);
            PG8_BAR; PG8_WAIT_L(0); PG8_MMA(0, 1, At, B1); PG8_BAR;
            PG8_LDA(At, 1, 1); PG8_STAGE(PG8_SA(1, 0), a3, voffA);
            PG8_BAR; PG8_WAIT_L(0); PG8_MMA(1, 0, At, B0); PG8_BAR; PG8_SCHED;
            PG8_STAGE(PG8_SB(1, 1), b3 + hstepB, voffB);
            PG8_WAIT_V(6); PG8_BAR; PG8_MMA(1, 1, At, B1); PG8_BAR;
            }
        }
        if constexpr (ALIGN_EPI) { if (wr == 0) PG8_BAR; }
        if constexpr (!Epi::AFTER_DRAIN) { E(acc, cur, wr, wc, fr, fq); S.done(cur); }
        if (!has_next) break;
#pragma unroll
        for (int a = 0; a < 2; ++a)
#pragma unroll
            for (int b = 0; b < 2; ++b)
#pragma unroll
                for (int m = 0; m < 4; ++m)
#pragma unroll
                    for (int n = 0; n < 2; ++n) acc[a][b][m][n] = (f32x4){0.f, 0.f, 0.f, 0.f};
        cur = nxt; cA = nA; cB = nB; ++ui;
        if constexpr (ALIGN_EPI) { if (wr == 1) PG8_BAR; }
    }
    PG8_WAIT_V(0);
    if constexpr (!ALIGN_EPI) { if (wr == 0) PG8_BAR; }
    PG8_BAR;
    if constexpr (Epi::AFTER_DRAIN) { E.fused(acc, cur, wr, wc, fr, fq, lds, wid, lane); S.done(cur); }
#undef PG8_SA
#undef PG8_SB
#undef PG8_STAGE
#undef PG8_LDA
#undef PG8_LDB
#undef PG8_MMA
#undef PG8_WAIT_V
#undef PG8_WAIT_L
#undef PG8_BAR
#undef PG8_SCHED
}
}

constexpr int T = 32768, S = 2048, DM = 1024, NIN = 2560, FF = 4096;
constexpr float EPS = 1e-6f;
constexpr float QSCALE = 0.125f * 1.4426950408889634f;
constexpr size_t MiB = 1u << 20;
constexpr size_t WS_WIN = 1 * MiB, WS_WOUT = 6 * MiB, WS_WFF1 = 8 * MiB, WS_WFF2 = 16 * MiB, WS_W1T = 24 * MiB;
constexpr size_t WS_WSP = 26 * MiB + 768 * 1024;
constexpr size_t WS_C1 = 26 * MiB, WS_ROPEC = 26 * MiB + 64 * 1024, WS_ROPES = 26 * MiB + 320 * 1024;
constexpr size_t WS_RINV1 = 27 * MiB, WS_SSQP = 27 * MiB + 512 * 1024, WS_GATES = 30 * MiB;
constexpr size_t WS_KCMP = 33 * MiB, WS_VCMPT = 33 * MiB + 512 * 1024, WS_HID = 34 * MiB, WS_X2B = 38 * MiB;
constexpr size_t WS_XB = 102 * MiB, WS_QN = 166 * MiB, WS_QR = 198 * MiB, WS_KC = 230 * MiB, WS_VC = 238 * MiB;
constexpr size_t WS_KSL = 246 * MiB, WS_VSLT = 254 * MiB, WS_KWN = 262 * MiB, WS_VWNT = 270 * MiB, WS_ZU = 278 * MiB, WS_ZVT = 310 * MiB, WS_O = 342 * MiB;
constexpr size_t WS_H = 102 * MiB, WS_END = 406 * MiB;
constexpr size_t WS_PART = WS_X2B;
constexpr size_t WS_C1P = 26 * MiB + 576 * 1024;
constexpr int LDS_BYTES = 147456;
constexpr int NWAVES = 8;

struct Args { const float* in[16]; float* out; unsigned char* ws; int ph_lo, ph_hi; };

__device__ __forceinline__ float bf2f(bf16_t h) { return __uint_as_float(((unsigned)h) << 16); }
__device__ __forceinline__ unsigned f2bf(float f) { unsigned u = __float_as_uint(f); return (u + 0x7fffu + ((u >> 16) & 1u)) >> 16; }
__device__ __forceinline__ unsigned pk2(float lo, float hi) { return pg8::cvt_pk_bf16(lo, hi); }
__device__ __forceinline__ float wave_sum(float v) {
#pragma unroll
    for (int o = 1; o < 64; o <<= 1) v += __shfl_xor(v, o);
    return v;
}
__device__ __forceinline__ float wave_max(float v) {
#pragma unroll
    for (int o = 1; o < 64; o <<= 1) v = fmaxf(v, __shfl_xor(v, o));
    return v;
}
__device__ __forceinline__ float gelu_tanh(float x) {
    const float u = 0.7978845608028654f * (x + 0.044715f * x * x * x);
    return x / (1.f + __expf(-2.f * u));
}
__device__ __forceinline__ void store8(bf16_t* p, const float* v) {
    u32x4 w; w.x = pk2(v[0], v[1]); w.y = pk2(v[2], v[3]); w.z = pk2(v[4], v[5]); w.w = pk2(v[6], v[7]);
    *(u32x4*)p = w;
}
__device__ __forceinline__ void load8(const bf16_t* p, float* v) {
    const u32x4 w = *(const u32x4*)p;
    v[0] = __uint_as_float(w.x << 16); v[1] = __uint_as_float(w.x & 0xffff0000u);
    v[2] = __uint_as_float(w.y << 16); v[3] = __uint_as_float(w.y & 0xffff0000u);
    v[4] = __uint_as_float(w.z << 16); v[5] = __uint_as_float(w.z & 0xffff0000u);
    v[6] = __uint_as_float(w.w << 16); v[7] = __uint_as_float(w.w & 0xffff0000u);
}
__device__ __forceinline__ float head_ssq(const float (&v)[16]) {
    float s = 0.f;
#pragma unroll
    for (int i = 0; i < 16; ++i) s += v[i] * v[i];
    s += __shfl_xor(s, 16); s += __shfl_xor(s, 32);
    return s;
}

struct EpiInProj {
    static constexpr bool PERM = true, AFTER_DRAIN = false;
    const float *rinv1, *g_q, *g_k, *g_sgu, *ropec, *ropes;
    bf16_t *qn, *qr, *kc, *vc, *ksl, *vslT, *kwn, *vwnT, *zu, *zvT; float* gates;
    __device__ __forceinline__ void operator()(const f32x4 (&acc)[2][2][4][2], const pg8::Unit& u, int wr, int wc, int fr, int fq) const {
        const int cs = u.pn * 4 + wc;
        if (cs >= 37) return;
        const int d0 = 8 * fq;
        float rsv[2][4];
#pragma unroll
        for (int ai = 0; ai < 2; ++ai)
#pragma unroll
            for (int m = 0; m < 4; ++m) rsv[ai][m] = rinv1[u.pm * 256 + ai * 128 + wr * 64 + m * 16 + fr];
#pragma unroll
        for (int ai = 0; ai < 2; ++ai)
#pragma unroll
            for (int m = 0; m < 4; ++m) {
                const int row = u.pm * 256 + ai * 128 + wr * 64 + m * 16 + fr;
                const float rs = rsv[ai][m];
                float v[16];
#pragma unroll
                for (int bj = 0; bj < 2; ++bj)
#pragma unroll
                    for (int n = 0; n < 2; ++n)
#pragma unroll
                        for (int e = 0; e < 4; ++e) v[bj * 8 + n * 4 + e] = acc[ai][bj][m][n][e] * rs;
                const int b = row >> 11, s = row & 2047;
                if (cs < 8 || cs == 12 || cs == 13 || cs == 16 || cs == 17) {
                    const float* gg = cs < 8 ? g_q : (cs < 14 ? g_k + 64 : g_k + 128);
                    const float rn = rsqrtf(head_ssq(v) * (1.f / 64.f) + EPS) * (cs < 8 ? QSCALE : 1.f);
                    float y[16];
#pragma unroll
                    for (int i = 0; i < 16; ++i) y[i] = v[i] * rn * gg[32 * (i >> 3) + d0 + (i & 7)];
                    float r1[8], r2[8];
#pragma unroll
                    for (int i = 0; i < 8; ++i) { int di = d0 + i; asm volatile("" : "+v"(di));
                        const float frev = __builtin_amdgcn_exp2f(-(float)di * (13.287712379549449f / 32.f)) * 0.15915494309189535f;
                        float xr = (float)s * frev; xr -= __builtin_rintf(xr);
                        const float c = __builtin_amdgcn_cosf(xr), sn = __builtin_amdgcn_sinf(xr); r1[i] = y[i] * c - y[8 + i] * sn; r2[i] = y[8 + i] * c + y[i] * sn; }
                    if (cs < 8) {
                        bf16_t* p = qn + (size_t)row * 512 + cs * 64 + d0; store8(p, y); store8(p + 32, y + 8);
                        bf16_t* p2 = qr + (size_t)row * 512 + cs * 64 + d0; store8(p2, r1); store8(p2 + 32, r2);
                    } else {
                        bf16_t* p = (cs < 14 ? ksl : kwn) + ((size_t)(b * 2 + (cs & 1)) * 2048 + s) * 64 + d0; store8(p, r1); store8(p + 32, r2);
                    }
                } else if (cs < 12) {
                    bf16_t* p = (cs < 10 ? kc : vc) + ((size_t)(b * 2 + (cs & 1)) * 2048 + s) * 64 + d0; store8(p, v); store8(p + 32, v + 8);
                } else if (cs < 20) {
                    bf16_t* p = (cs < 16 ? vslT : vwnT) + ((size_t)(b * 2 + (cs & 1)) * 32 + (s >> 6)) * 4096 + (s & 63);
#pragma unroll
                    for (int i = 0; i < 16; ++i) p[(32 * (i >> 3) + d0 + (i & 7)) * 64] = (bf16_t)f2bf(v[i]);
                } else if (cs < 28) {
                    float y[16];
#pragma unroll
                    for (int i = 0; i < 16; ++i) y[i] = gelu_tanh(v[i]);
                    bf16_t* p = zu + (size_t)row * 512 + (cs - 20) * 64 + d0; store8(p, y); store8(p + 32, y + 8);
                } else if (cs < 36) {
                    const int g = cs - 28;
                    float y[16];
#pragma unroll
                    for (int i = 0; i < 16; ++i) y[i] = gelu_tanh(v[i]);
                    const float rn = rsqrtf(head_ssq(y) * (1.f / 64.f) + EPS);
                    bf16_t* p = zvT + (((size_t)b * 16 + (s >> 7)) * 8 + g) * 8192 + (s & 127);
#pragma unroll
                    for (int i = 0; i < 16; ++i) { const int d = 32 * (i >> 3) + d0 + (i & 7); p[d * 128] = (bf16_t)f2bf(y[i] * rn * g_sgu[g * 64 + d]); }
                } else {
                    if (fq < 3) {
#pragma unroll
                        for (int i = 0; i < 8; ++i) gates[(size_t)row * 24 + d0 + i] = 1.f / (1.f + __expf(-v[i]));
                    }
                }
            }
    }
};

struct EpiPart {
    static constexpr bool PERM = true, AFTER_DRAIN = false;
    float* part;
    __device__ __forceinline__ void operator()(const f32x4 (&acc)[2][2][4][2], const pg8::Unit& u, int wr, int wc, int fr, int fq) const {
        float* base = part + (size_t)(u.koff >> 9) * 8192 * 256;
#pragma unroll
        for (int ai = 0; ai < 2; ++ai)
#pragma unroll
            for (int m = 0; m < 4; ++m) {
                const int row = u.pm * 256 + ai * 128 + wr * 64 + m * 16 + fr;
#pragma unroll
                for (int bj = 0; bj < 2; ++bj) {
                    float* p = base + (size_t)row * 256 + 128 * bj + 32 * wc + 8 * fq;
                    *(f32x4*)p = acc[ai][bj][m][0]; *(f32x4*)(p + 4) = acc[ai][bj][m][1];
                }
            }
    }
};

struct EpiWout {
    static constexpr bool PERM = true, AFTER_DRAIN = false;
    const bf16_t* xb; bf16_t* x2b; float* ssqp; LAS float* red;
    __device__ __forceinline__ void operator()(const f32x4 (&acc)[2][2][4][2], const pg8::Unit& u, int wr, int wc, int fr, int fq) const {
        u32x4 xr[2][4][2];
#pragma unroll
        for (int ai = 0; ai < 2; ++ai)
#pragma unroll
            for (int m = 0; m < 4; ++m)
#pragma unroll
                for (int bj = 0; bj < 2; ++bj)
                    xr[ai][m][bj] = *(const u32x4*)(xb + (size_t)(u.pm * 256 + ai * 128 + wr * 64 + m * 16 + fr) * DM + u.pn * 256 + 128 * bj + 32 * wc + 8 * fq);
        __builtin_amdgcn_sched_barrier(0);
#pragma unroll
        for (int ai = 0; ai < 2; ++ai)
#pragma unroll
            for (int m = 0; m < 4; ++m) {
                const int row = u.pm * 256 + ai * 128 + wr * 64 + m * 16 + fr;
                float ss = 0.f;
#pragma unroll
                for (int bj = 0; bj < 2; ++bj) {
                    const size_t off = (size_t)row * DM + u.pn * 256 + 128 * bj + 32 * wc + 8 * fq;
                    const u32x4 w = xr[ai][m][bj];
                    float y[8];
                    y[0] = __uint_as_float(w.x << 16) + acc[ai][bj][m][0].x; y[1] = __uint_as_float(w.x & 0xffff0000u) + acc[ai][bj][m][0].y;
                    y[2] = __uint_as_float(w.y << 16) + acc[ai][bj][m][0].z; y[3] = __uint_as_float(w.y & 0xffff0000u) + acc[ai][bj][m][0].w;
                    y[4] = __uint_as_float(w.z << 16) + acc[ai][bj][m][1].x; y[5] = __uint_as_float(w.z & 0xffff0000u) + acc[ai][bj][m][1].y;
                    y[6] = __uint_as_float(w.w << 16) + acc[ai][bj][m][1].z; y[7] = __uint_as_float(w.w & 0xffff0000u) + acc[ai][bj][m][1].w;
                    store8(x2b + off, y);
#pragma unroll
                    for (int i = 0; i < 8; ++i) ss += y[i] * y[i];
                }
                ss += __shfl_xor(ss, 16); ss += __shfl_xor(ss, 32);
                if (fq == 0) red[wc * 256 + (row & 255)] = ss;
            }
        __syncthreads();
        { const int tid = threadIdx.x;
          if (tid < 256) ssqp[(size_t)(u.pm * 256 + tid) * 4 + u.pn] = (red[tid] + red[256 + tid]) + (red[512 + tid] + red[768 + tid]); }
    }
};

struct EpiFF1 {
    static constexpr bool PERM = true, AFTER_DRAIN = false;
    const float* ssqp; bf16_t* H;
    __device__ __forceinline__ void operator()(const f32x4 (&acc)[2][2][4][2], const pg8::Unit& u, int wr, int wc, int fr, int fq) const {
        f32x4 sq[2][4];
#pragma unroll
        for (int ai = 0; ai < 2; ++ai)
#pragma unroll
            for (int m = 0; m < 4; ++m) sq[ai][m] = *(const f32x4*)(ssqp + (size_t)(u.pm * 256 + ai * 128 + wr * 64 + m * 16 + fr) * 4);
        __builtin_amdgcn_sched_barrier(0);
#pragma unroll
        for (int ai = 0; ai < 2; ++ai)
#pragma unroll
            for (int m = 0; m < 4; ++m) {
                const int row = u.pm * 256 + ai * 128 + wr * 64 + m * 16 + fr;
                const float tot = (sq[ai][m].x + sq[ai][m].y) + (sq[ai][m].z + sq[ai][m].w);
                const float rn = rsqrtf(tot * (1.f / 1024.f) + EPS);
#pragma unroll
                for (int bj = 0; bj < 2; ++bj) {
                    float y[8];
#pragma unroll
                    for (int n = 0; n < 2; ++n)
#pragma unroll
                        for (int e = 0; e < 4; ++e) { const float h = fmaxf(acc[ai][bj][m][n][e] * rn, 0.f); y[n * 4 + e] = h * h; }
                    store8(H + (size_t)row * FF + u.pn * 256 + 128 * bj + 32 * wc + 8 * fq, y);
                }
            }
    }
};

struct EpiFF2 {
    static constexpr bool PERM = true, AFTER_DRAIN = false;
    const bf16_t* x2b; float* out;
    __device__ __forceinline__ void operator()(const f32x4 (&acc)[2][2][4][2], const pg8::Unit& u, int wr, int wc, int fr, int fq) const {
        u32x4 xr[2][4][2];
#pragma unroll
        for (int ai = 0; ai < 2; ++ai)
#pragma unroll
            for (int m = 0; m < 4; ++m)
#pragma unroll
                for (int bj = 0; bj < 2; ++bj)
                    xr[ai][m][bj] = *(const u32x4*)(x2b + (size_t)(u.pm * 256 + ai * 128 + wr * 64 + m * 16 + fr) * DM + u.pn * 256 + 128 * bj + 32 * wc + 8 * fq);
        __builtin_amdgcn_sched_barrier(0);
#pragma unroll
        for (int ai = 0; ai < 2; ++ai)
#pragma unroll
            for (int m = 0; m < 4; ++m) {
                const int row = u.pm * 256 + ai * 128 + wr * 64 + m * 16 + fr;
#pragma unroll
                for (int bj = 0; bj < 2; ++bj) {
                    const size_t off = (size_t)row * DM + u.pn * 256 + 128 * bj + 32 * wc + 8 * fq;
                    const u32x4 w = xr[ai][m][bj];
                    f32x4 ya = acc[ai][bj][m][0], yb = acc[ai][bj][m][1];
                    ya.x += __uint_as_float(w.x << 16); ya.y += __uint_as_float(w.x & 0xffff0000u); ya.z += __uint_as_float(w.y << 16); ya.w += __uint_as_float(w.y & 0xffff0000u);
                    yb.x += __uint_as_float(w.z << 16); yb.y += __uint_as_float(w.z & 0xffff0000u); yb.z += __uint_as_float(w.w << 16); yb.w += __uint_as_float(w.w & 0xffff0000u);
                    *(f32x4*)(out + off) = ya; *(f32x4*)(out + off + 4) = yb;
                }
            }
    }
};

__device__ __forceinline__ int win_src_col(int nphys) {
    const int pn = nphys >> 8, Pp = nphys & 255, bj = Pp >> 7, wc = (Pp & 127) >> 5, r = Pp & 31;
    const int lc = (pn << 8) + 64 * wc + 32 * bj + r;
    if (lc < 1280) return lc;
    if (lc < 2304) return lc + 24;
    if (lc < 2328) return lc - 1024;
    return -1;
}
template <int MAP>
__device__ __forceinline__ void transpose_item(const float* W, int K, int N, bf16_t* WT, const float* gk, LAS float* scr, int item, int nblk, int lane) {
    const int kb = item / nblk, nb = item % nblk, k0 = 64 * kb, n0 = 32 * nb;
    const int src = MAP ? win_src_col(n0 + (lane & 31)) : n0 + (lane & 31);
    float tv[32];
#pragma unroll
    for (int i = 0; i < 32; ++i) { const int kk = 2 * i + (lane >> 5); tv[i] = (src >= 0) ? W[(size_t)(k0 + kk) * N + src] : 0.f; }
    if (gk) {
#pragma unroll
        for (int i = 0; i < 32; ++i) tv[i] *= gk[k0 + 2 * i + (lane >> 5)]; }
#pragma unroll
    for (int i = 0; i < 32; ++i) scr[(2 * i + (lane >> 5)) * 33 + (lane & 31)] = tv[i];
    asm volatile("s_waitcnt lgkmcnt(0)" ::: "memory");
    const int c = lane & 7;
#pragma unroll
    for (int j = 0; j < 4; ++j) { const int n = (lane >> 3) + 8 * j; const LAS float* s = scr + (8 * c) * 33 + n;
        u32x4 o; o.x = pk2(s[0 * 33], s[1 * 33]); o.y = pk2(s[2 * 33], s[3 * 33]); o.z = pk2(s[4 * 33], s[5 * 33]); o.w = pk2(s[6 * 33], s[7 * 33]);
        *(u32x4*)(WT + (size_t)(n0 + n) * K + k0 + 8 * c) = o; }
    asm volatile("s_waitcnt lgkmcnt(0)" ::: "memory");
}

__device__ __forceinline__ void phase0(const Args& a, LAS unsigned char* lds) {
    const int tid = threadIdx.x, lane = tid & 63, wave = tid >> 6;
    unsigned char* ws = a.ws;
    LAS float* scr = (LAS float*)(lds + wave * 16384);
    const int gw = blockIdx.x * NWAVES + wave, NGW = gridDim.x * NWAVES;
    constexpr int I_IN = 16 * 80, I_C = 32 * 8;
    constexpr int NITEMS = I_IN + 2 * I_C;
    for (int it = gw; it < NITEMS; it += NGW) {
        int r = it;
        if (r < I_IN) { transpose_item<1>(a.in[2], 1024, 2328, (bf16_t*)(ws + WS_WIN), a.in[1], scr, r, 80, lane); continue; } r -= I_IN;
        if (r < I_C) { transpose_item<0>(a.in[6], 2048, 256, (bf16_t*)(ws + WS_W1T), nullptr, scr, r, 8, lane); continue; } r -= I_C;
        transpose_item<0>(a.in[6] + (size_t)2048 * 256, 2048, 256, (bf16_t*)(ws + WS_W1T) + (size_t)256 * 2048, nullptr, scr, r, 8, lane);
    }
    {
        const float* x = a.in[0]; bf16_t* xb = (bf16_t*)(ws + WS_XB); float* rinv1 = (float*)(ws + WS_RINV1);
        for (int m = gw; m < T; m += 2 * NGW) {
            const int m2 = m + NGW;
            const bool has2 = m2 < T;
            const f32x4* xr = (const f32x4*)(x + (size_t)m * DM) + lane;
            const f32x4* xr2 = (const f32x4*)(x + (size_t)(has2 ? m2 : m) * DM) + lane;
            f32x4 v[4], u[4]; float s = 0.f, s2 = 0.f;
#pragma unroll
            for (int j = 0; j < 4; ++j) { v[j] = __builtin_nontemporal_load(xr + 64 * j); u[j] = __builtin_nontemporal_load(xr2 + 64 * j); }
#pragma unroll
            for (int j = 0; j < 4; ++j) { s += (v[j].x * v[j].x + v[j].y * v[j].y) + (v[j].z * v[j].z + v[j].w * v[j].w); s2 += (u[j].x * u[j].x + u[j].y * u[j].y) + (u[j].z * u[j].z + u[j].w * u[j].w); }
            s = wave_sum(s); s2 = wave_sum(s2);
            if (lane == 0) { rinv1[m] = rsqrtf(s * (1.f / 1024.f) + EPS); if (has2) rinv1[m2] = rsqrtf(s2 * (1.f / 1024.f) + EPS); }
            unsigned long long* o8 = (unsigned long long*)(xb + (size_t)m * DM) + lane;
#pragma unroll
            for (int j = 0; j < 4; ++j) o8[64 * j] = (unsigned long long)pk2(v[j].x, v[j].y) | ((unsigned long long)pk2(v[j].z, v[j].w) << 32);
            if (has2) { unsigned long long* o82 = (unsigned long long*)(xb + (size_t)m2 * DM) + lane;
#pragma unroll
                for (int j = 0; j < 4; ++j) o82[64 * j] = (unsigned long long)pk2(u[j].x, u[j].y) | ((unsigned long long)pk2(u[j].z, u[j].w) << 32); }
        }
    }
    {
        bf16_t* Wsp = (bf16_t*)(ws + WS_WSP); const float* spw = a.in[9];
        for (int idx = blockIdx.x * 512 + tid; idx < 8 * 128 * 128; idx += gridDim.x * 512) { const int tq = (idx >> 7) & 127, sq = idx & 127; Wsp[idx] = (bf16_t)f2bf(sq <= tq ? spw[idx] : 0.f); }
    }
    {
        if ((gw & 3) == 0 && (gw >> 2) < 512) {
            const int item = gw >> 2, kv = item >> 8, cg4 = (item >> 6) & 3, kch = item & 63;
            const float* pe = a.in[5] + kv * 2048 + kch * 32; const float* w1 = a.in[6] + ((size_t)kv * 2048 + kch * 32) * 256 + cg4 * 64 + lane;
            float wv[32];
#pragma unroll
            for (int k = 0; k < 32; ++k) wv[k] = w1[(size_t)k * 256];
            float acc = 0.f;
#pragma unroll
            for (int k = 0; k < 32; ++k) acc += pe[k] * wv[k];
            ((float*)(ws + WS_C1P))[kch * 512 + kv * 256 + cg4 * 64 + lane] = acc;
        }
    }
}

__device__ __forceinline__ void phase3(const Args& a, LAS unsigned char* lds) {
    const int tid = threadIdx.x, lane = tid & 63, wave = tid >> 6;
    unsigned char* ws = a.ws;
    const float* part = (const float*)(ws + WS_PART); const float* c1p = (const float*)(ws + WS_C1P);
    bf16_t* kcmp = (bf16_t*)(ws + WS_KCMP); bf16_t* vcmpT = (bf16_t*)(ws + WS_VCMPT);
    LAS float* w2s = (LAS float*)lds;
    LAS float* c1s = w2s + 256 * 64;
    LAS float* hids = c1s + 256;
    const int nchunk = 8192 / 32;
    for (int item = blockIdx.x; item < nchunk; item += gridDim.x) {
        const int kv = (item * 32) >> 12;
        __syncthreads();
        { const f32x4* src = (const f32x4*)(a.in[7] + (size_t)kv * 256 * 64);
#pragma unroll
          for (int i = 0; i < 8; ++i) ((LAS f32x4*)w2s)[tid + 512 * i] = src[tid + 512 * i]; }
        if (tid < 256) { float t = 0.f;
#pragma unroll
            for (int kch = 0; kch < 64; ++kch) t += c1p[kch * 512 + kv * 256 + tid];
            c1s[tid] = t; }
        __syncthreads();
#pragma unroll 1
        for (int rr = 0; rr < 4; ++rr) {
            const int R = item * 32 + wave * 4 + rr, bh = (R >> 7) & 31, n = R & 127;
            f32x4 h4 = *(const LAS f32x4*)(c1s + 4 * lane);
#pragma unroll
            for (int kc = 0; kc < 8; ++kc) h4 += *(const f32x4*)(part + ((size_t)kc * 8192 + R) * 256 + 4 * lane);
            h4.x = gelu_tanh(h4.x); h4.y = gelu_tanh(h4.y); h4.z = gelu_tanh(h4.z); h4.w = gelu_tanh(h4.w);
            *(LAS f32x4*)(hids + wave * 256 + 4 * lane) = h4;
            asm volatile("s_waitcnt lgkmcnt(0)" ::: "memory");
            float acc = 0.f;
#pragma unroll 8
            for (int c = 0; c < 256; ++c) acc += hids[wave * 256 + c] * w2s[c * 64 + lane];
            if (kv == 0) {
                const float ss = wave_sum(acc * acc);
                const float y = acc * rsqrtf(ss * (1.f / 64.f) + EPS) * a.in[4][lane];
                kcmp[((size_t)bh * 128 + n) * 64 + lane] = (bf16_t)f2bf(n < 127 ? y : 0.f);
            } else {
                vcmpT[((size_t)bh * 64 + lane) * 128 + n] = (bf16_t)f2bf(n < 127 ? acc : 0.f);
            }
        }
    }
    {
        LAS float* scr = (LAS float*)(lds + 77824 + wave * 8704);
        const int gw = blockIdx.x * NWAVES + wave, NGW = gridDim.x * NWAVES;
        constexpr int I_O = 16 * 32, I_1 = 16 * 128, I_2 = 64 * 32;
        for (int it = gw; it < I_O + I_1 + I_2; it += NGW) {
            int r = it;
            if (r < I_O) { transpose_item<0>(a.in[12], 1024, 1024, (bf16_t*)(ws + WS_WOUT), a.in[11], scr, r, 32, lane); continue; } r -= I_O;
            if (r < I_1) { transpose_item<0>(a.in[14], 1024, 4096, (bf16_t*)(ws + WS_WFF1), a.in[13], scr, r, 128, lane); continue; } r -= I_1;
            transpose_item<0>(a.in[15], 4096, 1024, (bf16_t*)(ws + WS_WFF2), nullptr, scr, r, 32, lane);
        }
    }
}

typedef short bf16x8_t __attribute__((ext_vector_type(8)));
typedef short s16x4_t __attribute__((ext_vector_type(4)));
typedef float f32x16 __attribute__((ext_vector_type(16)));
typedef __bf16 bf16x2_t __attribute__((ext_vector_type(2)));
typedef float f32x2_t __attribute__((ext_vector_type(2)));
typedef unsigned u32x2 __attribute__((ext_vector_type(2)));
#define MFMA32(a, b, c) __builtin_amdgcn_mfma_f32_32x32x16_bf16((a), (b), (c), 0, 0, 0)
__device__ __forceinline__ unsigned cvtpk(float lo, float hi) { f32x2_t v = {lo, hi}; bf16x2_t b = __builtin_convertvector(v, bf16x2_t); return __builtin_bit_cast(unsigned, b); }
__device__ __forceinline__ float ex2(float x) { return __builtin_amdgcn_exp2f(x); }
__device__ __forceinline__ f32x16 zero16() { f32x16 z;
#pragma unroll
    for (int i = 0; i < 16; ++i) z[i] = 0.f; return z; }
__device__ __forceinline__ bf16x8_t pack8(const f32x16& x, int s8) {
    u32x4 w; w.x = cvtpk(x[s8 + 0], x[s8 + 1]); w.y = cvtpk(x[s8 + 2], x[s8 + 3]); w.z = cvtpk(x[s8 + 4], x[s8 + 5]); w.w = cvtpk(x[s8 + 6], x[s8 + 7]);
    return __builtin_bit_cast(bf16x8_t, w);
}
constexpr int A_KSTR = 144, A_VSTR = 136, A_CVSTR = 264, A_IMPSTR = 33;
constexpr int A_KT = 128 * A_KSTR, A_VT = 64 * A_CVSTR;
constexpr int A_KBUF = 0, A_VBUF = 2 * A_KT, A_CMPK = A_VBUF + 2 * A_VT, A_CMPV = A_CMPK + 18432, A_IMP = A_CMPV + 16896, A_SELM = A_IMP + 4 * 64 * A_IMPSTR * 4, A_SSQ = A_SELM + 256, A_END = A_SSQ + 4096;
static_assert(A_END <= LDS_BYTES - 64, "attention LDS map");

template <int MODE>
__device__ __forceinline__ void attn_tile(const LAS unsigned char* Kb, const LAS unsigned char* Vb, const bf16x8_t (&qf)[4], f32x16 (&oacc)[2], float& l_run,
                                          int r, int h, int dlt0, int dlt1, bool hiw) {
    const unsigned ulim = (MODE == 0) ? 0x80000000u : 512u;
    float ls = 0.f;
#pragma unroll
    for (int mt = 0; mt < 4; ++mt) {
        if (mt == 0) { if (hiw) __builtin_amdgcn_s_setprio(1); else __builtin_amdgcn_s_setprio(0); }
        if (mt == 2) { if (hiw) __builtin_amdgcn_s_setprio(0); else __builtin_amdgcn_s_setprio(1); }
        const int dl = mt < 2 ? dlt0 : dlt1;
        f32x16 sacc = zero16();
#pragma unroll
        for (int ks = 0; ks < 4; ++ks) { const bf16x8_t ka = *(const LAS bf16x8_t*)(Kb + (32 * mt + r) * A_KSTR + 32 * ks + 16 * h); sacc = MFMA32(ka, qf[ks], sacc); }
#pragma unroll
        for (int i = 0; i < 16; ++i) {
            float p;
            if (MODE == 2) p = ex2(sacc[i]);
            else if (MODE == 3) p = ex2(sacc[i] + __int_as_float(dl));
            else { const int ci = 32 * mt + (i & 3) + 8 * (i >> 2); p = ((unsigned)(dl - ci) < ulim) ? ex2(sacc[i]) : 0.f; }
            sacc[i] = p; ls += p;
        }
#pragma unroll
        for (int s = 0; s < 2; ++s) {
            const bf16x8_t pf = pack8(sacc, 8 * s);
#pragma unroll
            for (int dt = 0; dt < 2; ++dt) {
                const LAS unsigned char* vp = Vb + (32 * dt + r) * A_CVSTR + (32 * mt + 16 * s + 4 * h) * 2;
                const s16x4_t lo = *(const LAS s16x4_t*)vp, hi = *(const LAS s16x4_t*)(vp + 16);
                oacc[dt] = MFMA32(__builtin_shufflevector(lo, hi, 0, 1, 2, 3, 4, 5, 6, 7), pf, oacc[dt]);
            }
        }
    }
    l_run += ls;
}

__device__ __forceinline__ void phase4_attn(const Args& a, LAS unsigned char* lds) {
    const int tid0 = threadIdx.x, w = __builtin_amdgcn_readfirstlane(tid0 >> 6), g = w >> 1, half = w & 1;
    unsigned char* ws = a.ws;
    const bf16_t* qn = (const bf16_t*)(ws + WS_QN); const bf16_t* qr = (const bf16_t*)(ws + WS_QR);
    const bf16_t* kcmp = (const bf16_t*)(ws + WS_KCMP); const bf16_t* vcmpT = (const bf16_t*)(ws + WS_VCMPT);
    const bf16_t* ksl = (const bf16_t*)(ws + WS_KSL); const bf16_t* vslT = (const bf16_t*)(ws + WS_VSLT);
    const bf16_t* kwn = (const bf16_t*)(ws + WS_KWN); const bf16_t* vwnT = (const bf16_t*)(ws + WS_VWNT);
    const float* gates = (const float*)(ws + WS_GATES);
    bf16_t* o = (bf16_t*)(ws + WS_O);
    LAS float* IMP = (LAS float*)(lds + A_IMP); LAS unsigned* SELM = (LAS unsigned*)(lds + A_SELM); LAS float* SSQ = (LAS float*)(lds + A_SSQ);
    for (int pr = blockIdx.x; pr < 256; pr += gridDim.x) {
        const int b = pr >> 4, tt0 = pr & 15;
#pragma unroll 1
        for (int it = 0; it < 2; ++it) {
            const int t = it ? 31 - tt0 : tt0;
            f32x16 comb[2][2];
#pragma unroll
            for (int hkv = 0; hkv < 2; ++hkv) {
                const int bh = b * 2 + hkv, head = hkv * 4 + g;
                int tid = tid0; asm volatile("" : "+v"(tid));
                const int lane = tid & 63, r = lane & 31, h = lane >> 5, ql = 32 * half + r, pos = 64 * t + ql, tok = b * 2048 + pos;
                comb[hkv][0] = zero16(); comb[hkv][1] = zero16();
                const float g0 = gates[(size_t)tok * 24 + head * 3 + 0], g1 = gates[(size_t)tok * 24 + head * 3 + 1], g2 = gates[(size_t)tok * 24 + head * 3 + 2];
                __syncthreads();
                {
                    const bf16_t* kc = kcmp + (size_t)bh * 128 * 64; const bf16_t* vc = vcmpT + (size_t)bh * 64 * 128;
#pragma unroll
                    for (int i = 0; i < 2; ++i) { const int c = tid + 512 * i;
                        const u32x4 kv = *(const u32x4*)(kc + (size_t)c * 8);
                        *(LAS u32x4*)(lds + A_CMPK + (c >> 3) * A_KSTR + (c & 7) * 16) = kv;
                        const u32x4 vv = *(const u32x4*)(vc + (size_t)c * 8);
                        LAS unsigned char* vp = lds + A_CMPV + (c >> 4) * A_CVSTR + (c & 15) * 16;
                        *(LAS u32x2*)vp = (u32x2){vv.x, vv.y}; *(LAS u32x2*)(vp + 8) = (u32x2){vv.z, vv.w}; }
                }
                bf16x8_t qf[4];
#pragma unroll
                for (int ks = 0; ks < 4; ++ks) qf[ks] = *(const bf16x8_t*)(qn + (size_t)tok * 512 + head * 64 + 16 * ks + 8 * h);
                __syncthreads();
                {
                    f32x16 s4[4];
#pragma unroll
                    for (int mt = 0; mt < 4; ++mt) { s4[mt] = zero16();
#pragma unroll
                        for (int ks = 0; ks < 4; ++ks) { const bf16x8_t ka = *(const LAS bf16x8_t*)(lds + A_CMPK + (32 * mt + r) * A_KSTR + 32 * ks + 16 * h); s4[mt] = MFMA32(ka, qf[ks], s4[mt]); } }
                    const int clim = (pos - 31 - 64 * h) >> 4;
                    float ls = 0.f;
#pragma unroll
                    for (int mt = 0; mt < 4; ++mt)
#pragma unroll
                        for (int i = 0; i < 16; ++i) { const int ci = 32 * mt + (i & 3) + 8 * (i >> 2);
                            const float p = (ci <= clim) ? ex2(s4[mt][i]) : 0.f; s4[mt][i] = p; ls += p; }
                    ls += __shfl_xor(ls, 32);
                    const float inv = 1.f / fmaxf(ls, 1e-20f);
#pragma unroll
                    for (int mt = 0; mt < 4; ++mt) s4[mt] *= inv;
                    if (t >= 16) {
                        float oprev = 0.f;
#pragma unroll
                        for (int idx = 0; idx < 16; ++idx) {
                            const int mt = idx >> 2, ap = idx & 3;
                            const float tail = 0.5f * s4[mt][4 * ap + 3];
                            const float ot = __shfl_xor(tail, 32);
                            const float inner = s4[mt][4 * ap] + s4[mt][4 * ap + 1] + s4[mt][4 * ap + 2] + tail;
                            const float prev = h ? ot : oprev;
                            oprev = ot;
                            IMP[(g * 64 + ql) * A_IMPSTR + 8 * mt + 2 * ap + h] = inner + prev;
                        }
                    }
                    f32x16 oc[2]; oc[0] = zero16(); oc[1] = zero16();
#pragma unroll
                    for (int mt = 0; mt < 4; ++mt)
#pragma unroll
                        for (int s = 0; s < 2; ++s) {
                            const bf16x8_t pf = pack8(s4[mt], 8 * s);
#pragma unroll
                            for (int dt = 0; dt < 2; ++dt) {
                                const LAS unsigned char* vp = lds + A_CMPV + (32 * dt + r) * A_CVSTR + (32 * mt + 16 * s + 4 * h) * 2;
                                const s16x4_t lo = *(const LAS s16x4_t*)vp, hi = *(const LAS s16x4_t*)(vp + 16);
                                oc[dt] = MFMA32(__builtin_shufflevector(lo, hi, 0, 1, 2, 3, 4, 5, 6, 7), pf, oc[dt]);
                            }
                        }
                    comb[hkv][0] += oc[0] * g0; comb[hkv][1] += oc[1] * g0;
                }
                if (t >= 16) {
                    __syncthreads();
                    const int qloc = tid >> 3, jg = tid & 7;
                    unsigned bits = 0u;
                    float xe[4]; int cnt[4];
#pragma unroll
                    for (int e = 0; e < 4; ++e) { const int j = 4 * jg + e; const LAS float* ip = IMP + qloc * A_IMPSTR + j;
                        float x = (ip[0] + ip[64 * A_IMPSTR]) + (ip[128 * A_IMPSTR] + ip[192 * A_IMPSTR]);
                        if (j == 0 || j == t || j == t - 1) x = 1e9f;
                        if (j > t) x = -INFINITY;
                        xe[e] = x; cnt[e] = 0; }
#pragma unroll 4
                    for (int i = 0; i < 32; ++i) { const LAS float* ip = IMP + qloc * A_IMPSTR + i;
                        float vi = (ip[0] + ip[64 * A_IMPSTR]) + (ip[128 * A_IMPSTR] + ip[192 * A_IMPSTR]);
                        if (i == 0 || i == t || i == t - 1) vi = 1e9f;
                        if (i > t) vi = -INFINITY;
#pragma unroll
                        for (int e = 0; e < 4; ++e) cnt[e] += (vi > xe[e] || (vi == xe[e] && i < 4 * jg + e)) ? 1 : 0; }
#pragma unroll
                    for (int e = 0; e < 4; ++e) if (cnt[e] < 16 && xe[e] > -INFINITY) bits |= 1u << (4 * jg + e);
                    bits |= __shfl_xor(bits, 1); bits |= __shfl_xor(bits, 2); bits |= __shfl_xor(bits, 4);
                    if (jg == 0) SELM[qloc] = bits;
                    __syncthreads();
                }
                const unsigned selw = (t >= 16) ? SELM[ql] : ((2u << t) - 1u);
#pragma unroll
                for (int ks = 0; ks < 4; ++ks) qf[ks] = *(const bf16x8_t*)(qr + (size_t)tok * 512 + head * 64 + 16 * ks + 8 * h);
                const int kt_lo = t >= 8 ? t - 8 : 0, wlo = kt_lo >> 1, n_sel = (t >> 1) + 1, n_all = n_sel + ((t >> 1) - wlo + 1);
                const bf16_t* Ks = ksl + (size_t)bh * 2048 * 64; const bf16_t* Vs = vslT + (size_t)bh * 64 * 2048;
                const bf16_t* Kw = kwn + (size_t)bh * 2048 * 64; const bf16_t* Vw = vwnT + (size_t)bh * 64 * 2048;
#define A_ISSUE(idx) do { const int i1_ = (idx); const bool sel1_ = i1_ < n_sel; const int st1_ = sel1_ ? i1_ : wlo + (i1_ - n_sel); \
        int tv_ = tid; asm volatile("" : "+v"(tv_)); \
        const bf16_t* Kg_ = (sel1_ ? Ks : Kw) + (size_t)st1_ * 8192; const bf16_t* Vg_ = (sel1_ ? Vs : Vw) + (size_t)st1_ * 8192; \
        kR0 = *(const u32x4*)(Kg_ + (size_t)tv_ * 8); kR1 = *(const u32x4*)(Kg_ + (size_t)(tv_ + 512) * 8); \
        vR0 = *(const u32x4*)(Vg_ + (size_t)tv_ * 8); vR1 = *(const u32x4*)(Vg_ + (size_t)(tv_ + 512) * 8); } while (0)
#define A_STAGE(bufi) do { int tv_ = tid; asm volatile("" : "+v"(tv_)); \
        LAS unsigned char* kp_ = lds + A_KBUF + (bufi) * A_KT + (tv_ >> 3) * A_KSTR + (tv_ & 7) * 16; \
        *(LAS u32x4*)kp_ = kR0; *(LAS u32x4*)(kp_ + 64 * A_KSTR) = kR1; \
        LAS unsigned char* vp_ = lds + A_VBUF + (bufi) * A_VT + (tv_ >> 3) * A_CVSTR + (tv_ & 7) * 16; \
        *(LAS u32x2*)vp_ = (u32x2){vR0.x, vR0.y}; *(LAS u32x2*)(vp_ + 8) = (u32x2){vR0.z, vR0.w}; \
        *(LAS u32x2*)(vp_ + 128) = (u32x2){vR1.x, vR1.y}; *(LAS u32x2*)(vp_ + 136) = (u32x2){vR1.z, vR1.w}; } while (0)
                u32x4 kR0, kR1, vR0, vR1;
                A_ISSUE(0);
                A_STAGE(0);
                __syncthreads();
                f32x16 oacc[2]; oacc[0] = zero16(); oacc[1] = zero16();
                float l_run = 0.f;
#pragma unroll 1
                for (int i = 0; i < n_all; ++i) {
                    const int bufo = i & 1;
                    if (i + 1 < n_all) A_ISSUE(i + 1);
                    const LAS unsigned char* Kb = lds + A_KBUF + bufo * A_KT; const LAS unsigned char* Vb = lds + A_VBUF + bufo * A_VT;
                    const bool issel = i < n_sel;
                    const int st = issel ? i : wlo + (i - n_sel);
                    const int dlt = 64 * t + ql - 128 * st - 4 * h;
                    if (issel) {
                        const bool b0 = (selw >> (2 * st)) & 1u, b1 = (selw >> (2 * st + 1)) & 1u;
                        if (__ballot(b0 || b1) != 0ull) {
                            if (2 * st + 1 < t) {
                                if (__ballot(b0 && b1) == ~0ull) attn_tile<2>(Kb, Vb, qf, oacc, l_run, r, h, dlt, dlt, (w & 4) != 0);
                                else attn_tile<3>(Kb, Vb, qf, oacc, l_run, r, h, __float_as_int(b0 ? 0.f : -1e30f), __float_as_int(b1 ? 0.f : -1e30f), (w & 4) != 0);
                            } else attn_tile<0>(Kb, Vb, qf, oacc, l_run, r, h, b0 ? dlt : -1, b1 ? dlt : -1, (w & 4) != 0);
                        }
                    } else {
                        if (2 * st > t - 8 && 2 * st + 1 < t) attn_tile<2>(Kb, Vb, qf, oacc, l_run, r, h, dlt, dlt, (w & 4) != 0);
                        else attn_tile<1>(Kb, Vb, qf, oacc, l_run, r, h, dlt, dlt, (w & 4) != 0);
                    }
                    if (i == n_sel - 1 || i == n_all - 1) { const float lt = l_run + __shfl_xor(l_run, 32); const float sc = ((i == n_sel - 1) ? g1 : g2) / fmaxf(lt, 1e-20f);
                        comb[hkv][0] += oacc[0] * sc; comb[hkv][1] += oacc[1] * sc; oacc[0] = zero16(); oacc[1] = zero16(); l_run = 0.f; }
                    if (i + 1 < n_all) A_STAGE(bufo ^ 1);
                    __syncthreads();
                }
#undef A_ISSUE
#undef A_STAGE
            }
            int tid = tid0; asm volatile("" : "+v"(tid));
            const int lane = tid & 63, r = lane & 31, h = lane >> 5, ql = 32 * half + r, pos = 64 * t + ql, tok = b * 2048 + pos;
            float ss = 0.f;
#pragma unroll
            for (int hkv = 0; hkv < 2; ++hkv)
#pragma unroll
                for (int dt = 0; dt < 2; ++dt)
#pragma unroll
                    for (int i = 0; i < 16; ++i) ss += comb[hkv][dt][i] * comb[hkv][dt][i];
            ss += __shfl_xor(ss, 32);
            if (h == 0) SSQ[w * 32 + r] = ss;
            __syncthreads();
            const float tot = (SSQ[(half + 0) * 32 + r] + SSQ[(half + 2) * 32 + r]) + (SSQ[(half + 4) * 32 + r] + SSQ[(half + 6) * 32 + r]);
            const float rn = rsqrtf(tot * (1.f / 512.f) + EPS);
#pragma unroll
            for (int hkv = 0; hkv < 2; ++hkv)
#pragma unroll
                for (int dt = 0; dt < 2; ++dt)
#pragma unroll
                    for (int ap = 0; ap < 4; ++ap) {
                        u32x2 pk; pk.x = cvtpk(comb[hkv][dt][4 * ap] * rn, comb[hkv][dt][4 * ap + 1] * rn); pk.y = cvtpk(comb[hkv][dt][4 * ap + 2] * rn, comb[hkv][dt][4 * ap + 3] * rn);
                        *(u32x2*)(o + (size_t)tok * DM + (hkv * 4 + g) * 64 + 32 * dt + 8 * ap + 4 * h) = pk;
                    }
        }
    }
}

constexpr int G_TSTR = 136, G_TILE = 128 * G_TSTR, G_SSQ = 8 * G_TILE;
static_assert(G_SSQ + 8 * 128 * 4 <= LDS_BYTES - 64, "gMLP LDS map");
__device__ __forceinline__ void phase4_gmlp(const Args& a, LAS unsigned char* lds) {
    const int tid0 = threadIdx.x, g = __builtin_amdgcn_readfirstlane(tid0 >> 6);
    unsigned char* ws = a.ws;
    const bf16_t* zu = (const bf16_t*)(ws + WS_ZU); const bf16_t* zvT = (const bf16_t*)(ws + WS_ZVT); const bf16_t* Wsp = (const bf16_t*)(ws + WS_WSP);
    const float* sp_b = a.in[10];
    bf16_t* o = (bf16_t*)(ws + WS_O);
    LAS float* SSQ2 = (LAS float*)(lds + G_SSQ);
    LAS unsigned char* tile = lds + g * G_TILE;
    for (int item = blockIdx.x; item < 256; item += gridDim.x) {
        const int b = item >> 4, ch = item & 15;
        const size_t tok0 = (size_t)b * 2048 + ch * 128;
        int tid = tid0; asm volatile("" : "+v"(tid));
        const int lane = tid & 63, r = lane & 31, h = lane >> 5;
        __syncthreads();
        bf16x8_t zf[2][8];
#pragma unroll
        for (int dt = 0; dt < 2; ++dt)
#pragma unroll
            for (int ks = 0; ks < 8; ++ks) zf[dt][ks] = *(const bf16x8_t*)(zvT + ((((size_t)b * 16 + ch) * 8 + g) * 64 + 32 * dt + r) * 128 + 16 * ks + 8 * h);
        f32x16 acc[2][4];
#pragma unroll
        for (int tt = 0; tt < 4; ++tt) { acc[0][tt] = zero16(); acc[1][tt] = zero16();
            __builtin_amdgcn_sched_barrier(0);
#pragma unroll
            for (int ks = 0; ks < 2 * tt + 2; ++ks) {
                const bf16x8_t wf = *(const bf16x8_t*)(Wsp + ((size_t)g * 128 + 32 * tt + r) * 128 + 16 * ks + 8 * h);
                acc[0][tt] = MFMA32(zf[0][ks], wf, acc[0][tt]); acc[1][tt] = MFMA32(zf[1][ks], wf, acc[1][tt]);
            } }
        __builtin_amdgcn_sched_barrier(0);
#pragma unroll
        for (int hb = 0; hb < 2; ++hb) {
            u32x4 zr[8];
#pragma unroll
            for (int it = 0; it < 8; ++it) zr[it] = *(const u32x4*)(zu + (tok0 + (lane >> 3) + 8 * (8 * hb + it)) * 512 + g * 64 + (lane & 7) * 8);
#pragma unroll
            for (int it = 0; it < 8; ++it) { LAS unsigned char* p = tile + ((lane >> 3) + 8 * (8 * hb + it)) * G_TSTR + (lane & 7) * 16;
                *(LAS u32x2*)p = (u32x2){zr[it].x, zr[it].y}; *(LAS u32x2*)(p + 8) = (u32x2){zr[it].z, zr[it].w}; }
        }
        asm volatile("s_waitcnt lgkmcnt(0)" ::: "memory");
#pragma unroll
        for (int tt = 0; tt < 4; ++tt) {
            const int tl = 32 * tt + r;
            const float bias = sp_b[g * 128 + tl];
            float ss = 0.f;
#pragma unroll
            for (int dt = 0; dt < 2; ++dt)
#pragma unroll
                for (int ap = 0; ap < 4; ++ap) {
                    const u32x2 zz = *(const LAS u32x2*)(tile + tl * G_TSTR + (32 * dt + 8 * ap + 4 * h) * 2);
                    const float z0 = __uint_as_float(zz.x << 16), z1 = __uint_as_float(zz.x & 0xffff0000u), z2 = __uint_as_float(zz.y << 16), z3 = __uint_as_float(zz.y & 0xffff0000u);
                    float v0 = z0 * (acc[dt][tt][4 * ap] + bias), v1 = z1 * (acc[dt][tt][4 * ap + 1] + bias), v2 = z2 * (acc[dt][tt][4 * ap + 2] + bias), v3 = z3 * (acc[dt][tt][4 * ap + 3] + bias);
                    acc[dt][tt][4 * ap] = v0; acc[dt][tt][4 * ap + 1] = v1; acc[dt][tt][4 * ap + 2] = v2; acc[dt][tt][4 * ap + 3] = v3;
                    ss += (v0 * v0 + v1 * v1) + (v2 * v2 + v3 * v3);
                }
            ss += __shfl_xor(ss, 32);
            if (h == 0) SSQ2[g * 128 + tl] = ss;
        }
        __syncthreads();
#pragma unroll
        for (int tt = 0; tt < 4; ++tt) {
            const int tl = 32 * tt + r;
            float tot = 0.f;
#pragma unroll
            for (int gg = 0; gg < 8; ++gg) tot += SSQ2[gg * 128 + tl];
            const float rn = rsqrtf(tot * (1.f / 512.f) + EPS);
#pragma unroll
            for (int dt = 0; dt < 2; ++dt)
#pragma unroll
                for (int ap = 0; ap < 4; ++ap) {
                    u32x2 pk; pk.x = cvtpk(acc[dt][tt][4 * ap] * rn, acc[dt][tt][4 * ap + 1] * rn); pk.y = cvtpk(acc[dt][tt][4 * ap + 2] * rn, acc[dt][tt][4 * ap + 3] * rn);
                    *(LAS u32x2*)(tile + tl * G_TSTR + (32 * dt + 8 * ap + 4 * h) * 2) = pk;
                }
        }
        asm volatile("s_waitcnt lgkmcnt(0)" ::: "memory");
#pragma unroll
        for (int it = 0; it < 16; ++it) { const LAS unsigned char* p = tile + ((lane >> 3) + 8 * it) * G_TSTR + (lane & 7) * 16;
            const u32x2 lo = *(const LAS u32x2*)p, hi = *(const LAS u32x2*)(p + 8);
            *(u32x4*)(o + (tok0 + (lane >> 3) + 8 * it) * DM + 512 + g * 64 + (lane & 7) * 8) = (u32x4){lo.x, lo.y, hi.x, hi.y}; }
    }
}

constexpr int BAR_BYTES = (1024 + 8 * 2304) * 4;
__device__ __forceinline__ unsigned xb_ld(unsigned* p) { return __hip_atomic_load(p, __ATOMIC_RELAXED, __HIP_MEMORY_SCOPE_AGENT); }
__device__ __forceinline__ unsigned xb_add(unsigned* p, unsigned v) { return __hip_atomic_fetch_add(p, v, __ATOMIC_RELAXED, __HIP_MEMORY_SCOPE_AGENT); }
__device__ __forceinline__ unsigned xb_xcc_id() { return (unsigned)__builtin_amdgcn_s_getreg((3 << 11) | 20) & 0xFu; }
__device__ __forceinline__ void grid_barrier(unsigned* barw, int k, volatile LAS unsigned* st) {
    asm volatile("s_waitcnt vmcnt(0)" ::: "memory");
    __syncthreads();
    if (threadIdx.x == 0) {
        __builtin_amdgcn_s_waitcnt(0);
        const unsigned x = xb_xcc_id();
        unsigned nloc = st[0], nx = st[1];
        if (nloc == 0u) {
            const unsigned G = gridDim.x;
            for (;;) { unsigned sum = 0u, cnt = 0u, mine = 0u;
#pragma unroll
                for (unsigned j = 0; j < 16; ++j) { const unsigned c = xb_ld(barw + 64 * j); sum += c; cnt += (c > 0u) ? 1u : 0u; mine = (j == x) ? c : mine; }
                if (sum == G) { nloc = mine; nx = cnt; break; }
                __builtin_amdgcn_s_sleep(1); }
            st[0] = nloc; st[1] = nx;
        }
        unsigned* sb = barw + 1024 + k * 2304;
        const unsigned old = xb_add(sb + 64 * x, 1u);
        if (old + 1u == nloc) {
            __builtin_amdgcn_fence(__ATOMIC_RELEASE, "agent");
            asm volatile("s_waitcnt vmcnt(0)" ::: "memory");
            const unsigned og = xb_add(sb + 2048, 1u);
            if (og + 1u == nx) xb_add(sb + 2112, 1u);
            else while (xb_ld(sb + 2112) == 0u) __builtin_amdgcn_s_sleep(1);
            __builtin_amdgcn_fence(__ATOMIC_ACQUIRE, "agent");
            xb_add(sb + 1024 + 64 * x, 1u);
            asm volatile("s_waitcnt vmcnt(0)" ::: "memory");
        } else {
            while (xb_ld(sb + 1024 + 64 * x) == 0u) __builtin_amdgcn_s_sleep(1);
            __builtin_amdgcn_fence(__ATOMIC_ACQUIRE, "agent");
            asm volatile("s_waitcnt vmcnt(0)" ::: "memory");
        }
    }
    __syncthreads();
}

#ifndef N_LAUNCHES
#define N_LAUNCHES 1
#endif
constexpr int NPHASE = 8;
__global__ void __launch_bounds__(NWAVES * 64, 2) fwd_kernel(Args args) {
    extern __shared__ __attribute__((aligned(16))) unsigned char lds_raw[];
    LAS unsigned char* lds = (LAS unsigned char*)lds_raw;
    unsigned char* ws = args.ws;
    const int lo = args.ph_lo, hi = args.ph_hi;
    const int G = gridDim.x;
#define IN(k) (lo <= (k) && (k) < hi)
    unsigned* barw = (unsigned*)ws;
    volatile LAS unsigned* bst = (volatile LAS unsigned*)(lds + LDS_BYTES - 64);
    if (threadIdx.x == 0) { bst[0] = 0u; bst[1] = 0u; (void)xb_add(barw + 64 * xb_xcc_id(), 1u); }
    __syncthreads();
    if (hi > NPHASE) cg::this_grid().sync();
#define SEAM(k) do { if (IN(k) && IN((k) + 1)) { grid_barrier(barw, (k), bst); } } while (0)
    if (IN(0)) { phase0(args, lds); }
    SEAM(0);
    if (IN(1)) {
        pg8::Gemm g{(const bf16_t*)(ws + WS_XB), (const bf16_t*)(ws + WS_WIN), T, NIN, DM, DM, DM};
        pg8::StaticOrder So; So.init(T, NIN, G, (int)blockIdx.x);
        EpiInProj E{(const float*)(ws + WS_RINV1), args.in[3], args.in[4], args.in[8], (const float*)(ws + WS_ROPEC), (const float*)(ws + WS_ROPES),
                    (bf16_t*)(ws + WS_QN), (bf16_t*)(ws + WS_QR), (bf16_t*)(ws + WS_KC), (bf16_t*)(ws + WS_VC), (bf16_t*)(ws + WS_KSL), (bf16_t*)(ws + WS_VSLT),
                    (bf16_t*)(ws + WS_KWN), (bf16_t*)(ws + WS_VWNT), (bf16_t*)(ws + WS_ZU), (bf16_t*)(ws + WS_ZVT), (float*)(ws + WS_GATES)};
        pg8::gemm_phase<EpiInProj, pg8::StaticOrder, true, true>(lds, g, So, E);
    }
    SEAM(1);
    if (IN(2)) {
        pg8::Gemm g{(const bf16_t*)(ws + WS_KC), (const bf16_t*)(ws + WS_W1T), 8192, 512, 256, 1024, 2048};
        pg8::CmpOrder So{G, (int)blockIdx.x};
        EpiPart E{(float*)(ws + WS_PART)};
        pg8::gemm_phase<EpiPart, pg8::CmpOrder, false, true>(lds, g, So, E);
    }
    SEAM(2);
    if (IN(3)) { phase3(args, lds); }
    SEAM(3);
    if (IN(4)) { phase4_attn(args, lds); phase4_gmlp(args, lds); }
    SEAM(4);
    if (IN(5)) {
        pg8::Gemm g{(const bf16_t*)(ws + WS_O), (const bf16_t*)(ws + WS_WOUT), T, DM, DM, DM, DM};
        pg8::StaticOrder So; So.init(T, DM, G, (int)blockIdx.x);
        EpiWout E{(const bf16_t*)(ws + WS_XB), (bf16_t*)(ws + WS_X2B), (float*)(ws + WS_SSQP), (LAS float*)(lds + 131072)};
        pg8::gemm_phase<EpiWout, pg8::StaticOrder, true, true>(lds, g, So, E);
    }
    SEAM(5);
    if (IN(6)) {
        pg8::Gemm g{(const bf16_t*)(ws + WS_X2B), (const bf16_t*)(ws + WS_WFF1), T, FF, DM, DM, DM};
        pg8::StaticOrder So; So.init(T, FF, G, (int)blockIdx.x);
        EpiFF1 E{(const float*)(ws + WS_SSQP), (bf16_t*)(ws + WS_H)};
        pg8::gemm_phase<EpiFF1, pg8::StaticOrder, true, true>(lds, g, So, E);
    }
    SEAM(6);
    if (IN(7)) {
        pg8::Gemm g{(const bf16_t*)(ws + WS_H), (const bf16_t*)(ws + WS_WFF2), T, DM, FF, FF, FF};
        pg8::StaticOrder So; So.init(T, DM, G, (int)blockIdx.x);
        EpiFF2 E{(const bf16_t*)(ws + WS_X2B), args.out};
        pg8::gemm_phase<EpiFF2, pg8::StaticOrder, true, true>(lds, g, So, E);
    }
#undef IN
#undef SEAM
}

extern "C" void kernel_launch(void* const* d_in, const int* in_sizes, int n_in, void* d_out, int out_size, void* d_ws, size_t ws_size, hipStream_t stream) {
    static int grid = 0;
    if (grid == 0) {
        if (n_in != 16 || out_size != T * DM || ws_size < WS_END) { fprintf(stderr, "kernel_launch: unexpected shapes (n_in %d out %d ws %zu)\n", n_in, out_size, ws_size); grid = -1; return; }
        int dev = 0, cus = 0, per_cu = 0;
        hipGetDevice(&dev); hipDeviceGetAttribute(&cus, hipDeviceAttributeMultiprocessorCount, dev);
        if (hipFuncSetAttribute((const void*)fwd_kernel, hipFuncAttributeMaxDynamicSharedMemorySize, LDS_BYTES) != hipSuccess) { fprintf(stderr, "kernel_launch: hipFuncSetAttribute failed\n"); grid = -1; return; }
        if (hipOccupancyMaxActiveBlocksPerMultiprocessor(&per_cu, (const void*)fwd_kernel, NWAVES * 64, LDS_BYTES) != hipSuccess || per_cu < 1) { fprintf(stderr, "kernel_launch: occupancy query says %d\n", per_cu); per_cu = 1; }
        (void)hipGetLastError();
        grid = cus * per_cu;
        fprintf(stderr, "kernel_launch: grid %d (cus %d x %d)\n", grid, cus, per_cu);
    }
    if (grid < 0) return;
    if (hipMemsetAsync(d_ws, 0, BAR_BYTES, stream) != hipSuccess) { fprintf(stderr, "kernel_launch: memset of the barrier words failed\n"); return; }
    Args a{};
    for (int i = 0; i < 16; ++i) a.in[i] = (const float*)d_in[i];
    a.out = (float*)d_out; a.ws = (unsigned char*)d_ws;
#if N_LAUNCHES == 1
    a.ph_lo = 0; a.ph_hi = NPHASE;
    void* kargs[] = {&a};
    hipError_t e = hipLaunchCooperativeKernel((const void*)fwd_kernel, dim3(grid), dim3(NWAVES * 64), kargs, LDS_BYTES, stream);
    if (e != hipSuccess) fprintf(stderr, "kernel_launch: cooperative launch failed: %s (grid %d)\n", hipGetErrorString(e), grid);
#else
    for (int p = 0; p < NPHASE; ++p) {
        a.ph_lo = p; a.ph_hi = p + 1;
        hipLaunchKernelGGL(fwd_kernel, dim3(grid), dim3(NWAVES * 64), LDS_BYTES, stream, a);
    }
#endif
}
```

```cpp
#include <hip/hip_runtime.h>
#include <hip/hip_cooperative_groups.h>
#include <cstdio>
#include <cstdint>
namespace cg = cooperative_groups;

#define LAS __attribute__((address_space(3)))
typedef unsigned short bf16_t;
typedef unsigned u32x4 __attribute__((ext_vector_type(4)));
typedef float f32x4 __attribute__((ext_vector_type(4)));

namespace pg8 {
#define PG8_LAS __attribute__((address_space(3)))
typedef short bf16x8 __attribute__((ext_vector_type(8)));
constexpr int BM = 256, BK = 64, HALF = 128, HTB = HALF * BK * 2, STAGE_BYTES = 8 * HTB, NXCD = 8, WGM = 4;
__host__ __device__ __forceinline__ int lds_byte(int r, int c) { const int st = (r >> 4) * 2 + (c >> 5), rr = r & 15, cc = c & 31, ob = rr * 64 + cc * 2; return st * 1024 + (ob ^ (((ob >> 9) & 1) << 5)); }
__host__ __device__ __forceinline__ void stage_rc(int b, int& R, int& C) { const int st = b / 1024, sb = b % 1024, swz = sb ^ (((sb >> 9) & 1) << 5); R = (st >> 1) * 16 + swz / 64; C = (st & 1) * 32 + (swz % 64) / 2; }
__host__ __device__ __forceinline__ int perm32(int rho) { const int n = rho >> 4, i = rho & 15; return 8 * (i >> 2) + 4 * n + (i & 3); }
struct Unit { int pm, pn, koff; };
struct Gemm { const bf16_t* A; const bf16_t* Bt; int M, N, K, lda, ldb; };
struct StaticOrder {
    int nM, nN, nwg, G, c;
    __host__ __device__ void init(int M, int N, int G_, int c_) { nM = M / BM; nN = N / BM; nwg = nM * nN; G = G_; c = c_; }
    __host__ __device__ bool next(int i, Unit& u) const {
        const long L = (long)i * G + c; if (L >= nwg) return false;
        int wgid = (int)L; { const int q = nwg / NXCD, r = nwg % NXCD, xcd = wgid % NXCD, off = wgid / NXCD; wgid = (xcd < r ? xcd * (q + 1) : r * (q + 1) + (xcd - r) * q) + off; }
        const int nig = WGM * nN, gid = wgid / nig, fm = gid * WGM, gsz = (nM - fm) < WGM ? (nM - fm) : WGM;
        u.pm = fm + ((wgid % nig) % gsz); u.pn = (wgid % nig) / gsz; u.koff = 0; return true;
    }
    __device__ __forceinline__ void a_ready(const Unit&) const {}
    __device__ __forceinline__ void done(const Unit&) const {}
};
struct CmpOrder {
    int G, c;
    __device__ bool next(int i, Unit& u) const { const long L = (long)i * G + c; if (L >= 256) return false; u.pm = (int)L & 31; u.pn = u.pm >> 4; u.koff = ((int)L >> 5) * 512; return true; }
    __device__ __forceinline__ void a_ready(const Unit&) const {}
    __device__ __forceinline__ void done(const Unit&) const {}
};
__device__ __forceinline__ unsigned cvt_pk_bf16(float lo, float hi) { unsigned r; asm volatile("v_cvt_pk_bf16_f32 %0, %1, %2" : "=v"(r) : "v"(lo), "v"(hi)); return r; }
template <class Epi, class Sched, bool ALIGN_EPI = false, bool SP2 = false>
__device__ __forceinline__ void gemm_phase(PG8_LAS unsigned char* lds, const Gemm g, const Sched& S, const Epi& E) {
    const int tid = threadIdx.x, wid = __builtin_amdgcn_readfirstlane(tid >> 6), lane = tid & 63, wr = wid >> 2, wc = wid & 3, fr = lane & 15, fq = lane >> 4;
    const int K = g.K, nt = K / BK, lda = g.lda, ldb = g.ldb;
    unsigned voffA[2], voffB[2];
#pragma unroll
    for (int i = 0; i < 2; ++i) { int R, C; stage_rc(tid * 16 + i * 8192, R, C); const int Rb = Epi::PERM ? ((R & ~31) + perm32(R & 31)) : R;
        voffA[i] = (unsigned)(R * lda + C) * 2u; voffB[i] = (unsigned)(Rb * ldb + C) * 2u; }
    const size_t kstep = (size_t)(BK * 2);
    const size_t hstepA = (size_t)HALF * lda * 2, hstepB = (size_t)HALF * ldb * 2;
    const size_t tstepA = 2 * hstepA, tstepB = 2 * hstepB;
    const unsigned ldsw = (unsigned)wid * 1024u;
    const int aoff = lds_byte(wr * 64 + fr, fq * 8), boff = lds_byte(wc * 32 + fr, fq * 8);
#define PG8_SA(b, h) (((b) * 2 + (h)) * HTB)
#define PG8_SB(b, h) ((4 + (b) * 2 + (h)) * HTB)
#define PG8_STAGE(bufoff, gbase, voff) do { _Pragma("unroll") for (int _i = 0; _i < 2; ++_i) \
        __builtin_amdgcn_global_load_lds((const unsigned*)((const char*)(gbase) + (voff)[_i]), (PG8_LAS unsigned*)(lds + (bufoff) + ldsw + _i * 8192), 16, 0, 0); } while (0)
#define PG8_LDA(dst, b, h) do { _Pragma("unroll") for (int m = 0; m < 4; ++m) _Pragma("unroll") for (int k = 0; k < 2; ++k) dst[m][k] = *(const PG8_LAS bf16x8*)(lds + PG8_SA(b, h) + aoff + m * 2048 + k * 1024); } while (0)
#define PG8_LDB(dst, b, h) do { _Pragma("unroll") for (int n = 0; n < 2; ++n) _Pragma("unroll") for (int k = 0; k < 2; ++k) dst[n][k] = *(const PG8_LAS bf16x8*)(lds + PG8_SB(b, h) + boff + n * 2048 + k * 1024); } while (0)
#define PG8_MMA(ai, bj, At, Bt) do { __builtin_amdgcn_s_setprio(1); _Pragma("unroll") for (int m = 0; m < 4; ++m) _Pragma("unroll") for (int n = 0; n < 2; ++n) _Pragma("unroll") for (int k = 0; k < 2; ++k) \
        acc[ai][bj][m][n] = __builtin_amdgcn_mfma_f32_16x16x32_bf16(Bt[n][k], At[m][k], acc[ai][bj][m][n], 0, 0, 0); __builtin_amdgcn_s_setprio(0); } while (0)
#define PG8_WAIT_V(n) asm volatile("s_waitcnt vmcnt(" #n ")" ::: "memory")
#define PG8_WAIT_L(n) asm volatile("s_waitcnt lgkmcnt(" #n ")" ::: "memory")
#define PG8_BAR __builtin_amdgcn_s_barrier()
#define PG8_SCHED __builtin_amdgcn_sched_barrier(0)
    Unit cur, nxt; int ui = 0;
    if (!S.next(0, cur)) return;
    f32x4 acc[2][2][4][2];
#pragma unroll
    for (int a = 0; a < 2; ++a)
#pragma unroll
        for (int b = 0; b < 2; ++b)
#pragma unroll
            for (int m = 0; m < 4; ++m)
#pragma unroll
                for (int n = 0; n < 2; ++n) acc[a][b][m][n] = (f32x4){0.f, 0.f, 0.f, 0.f};
    bf16x8 At[4][2], B0[2][2], B1[2][2];
    const char* cA = (const char*)g.A + (size_t)cur.pm * tstepA + cur.koff; const char* cB = (const char*)g.Bt + (size_t)cur.pn * tstepB + cur.koff;
    S.a_ready(cur);
    if constexpr (SP2) {
        PG8_STAGE(PG8_SB(0, 0), cB, voffB); PG8_STAGE(PG8_SB(0, 1), cB + hstepB, voffB); PG8_STAGE(PG8_SA(0, 0), cA, voffA); PG8_STAGE(PG8_SA(0, 1), cA + hstepA, voffA);
        if (wr == 1) PG8_BAR;
        PG8_WAIT_V(2); PG8_BAR;
        PG8_STAGE(PG8_SB(1, 0), cB + kstep, voffB); PG8_STAGE(PG8_SA(1, 0), cA + kstep, voffA); PG8_STAGE(PG8_SB(1, 1), cB + hstepB + kstep, voffB);
        PG8_WAIT_V(6); PG8_BAR;
    } else {
        PG8_STAGE(PG8_SB(0, 0), cB, voffB); PG8_STAGE(PG8_SA(0, 0), cA, voffA); PG8_STAGE(PG8_SB(0, 1), cB + hstepB, voffB); PG8_STAGE(PG8_SA(0, 1), cA + hstepA, voffA);
        if (wr == 1) PG8_BAR;
        PG8_WAIT_V(4); PG8_BAR;
        PG8_STAGE(PG8_SB(1, 0), cB + kstep, voffB); PG8_STAGE(PG8_SA(1, 0), cA + kstep, voffA); PG8_STAGE(PG8_SB(1, 1), cB + hstepB + kstep, voffB);
        PG8_WAIT_V(6); PG8_BAR;
    }
    for (;;) {
        const bool has_next = S.next(ui + 1, nxt);
        const char* nA = has_next ? (const char*)g.A + (size_t)nxt.pm * tstepA + nxt.koff : cA; const char* nB = has_next ? (const char*)g.Bt + (size_t)nxt.pn * tstepB + nxt.koff : cB;
        for (int t = 0; t < nt; t += 2) {
            const bool last = (t == nt - 2);
            const char* a1 = cA + (size_t)(t + 1) * kstep;
            const char* a2 = last ? nA : cA + (size_t)(t + 2) * kstep; const char* b2 = last ? nB : cB + (size_t)(t + 2) * kstep;
            const char* a3 = a2 + kstep; const char* b3 = b2 + kstep;
            if (last && has_next) S.a_ready(nxt);
            if constexpr (SP2) {
            PG8_LDB(B0, 0, 0); PG8_LDB(B1, 0, 1); PG8_SCHED; PG8_LDA(At, 0, 0); PG8_STAGE(PG8_SA(1, 1), a1 + hstepA, voffA);
            PG8_WAIT_V(8); PG8_WAIT_L(0); PG8_BAR; PG8_MMA(0, 0, At, B0); PG8_MMA(0, 1, At, B1); PG8_BAR; PG8_SCHED;
            PG8_LDA(At, 0, 1); PG8_STAGE(PG8_SB(0, 0), b2, voffB); PG8_STAGE(PG8_SB(0, 1), b2 + hstepB, voffB); PG8_STAGE(PG8_SA(0, 0), a2, voffA);
            PG8_WAIT_V(8); PG8_WAIT_L(0); PG8_BAR; PG8_MMA(1, 0, At, B0); PG8_MMA(1, 1, At, B1); PG8_BAR; PG8_SCHED;
            PG8_LDB(B0, 1, 0); PG8_LDB(B1, 1, 1); PG8_SCHED; PG8_LDA(At, 1, 0); PG8_STAGE(PG8_SA(0, 1), a2 + hstepA, voffA);
            PG8_WAIT_V(8); PG8_WAIT_L(0); PG8_BAR; PG8_MMA(0, 0, At, B0); PG8_MMA(0, 1, At, B1); PG8_BAR; PG8_SCHED;
            PG8_LDA(At, 1, 1); PG8_STAGE(PG8_SB(1, 0), b3, voffB); PG8_STAGE(PG8_SB(1, 1), b3 + hstepB, voffB); PG8_STAGE(PG8_SA(1, 0), a3, voffA);
            PG8_WAIT_V(8); PG8_WAIT_L(0); PG8_BAR; PG8_MMA(1, 0, At, B0); PG8_MMA(1, 1, At, B1); PG8_BAR; PG8_SCHED;
            } else {
            PG8_LDB(B0, 0, 0); PG8_SCHED; PG8_LDA(At, 0, 0); PG8_STAGE(PG8_SA(1, 1), a1 + hstepA, voffA);
            PG8_WAIT_L(8); PG8_BAR; PG8_WAIT_L(0); PG8_MMA(0, 0, At, B0); PG8_BAR; PG8_SCHED;
            PG8_LDB(B1, 0, 1); PG8_STAGE(PG8_SB(0, 0), b2, voffB);
            PG8_BAR; PG8_WAIT_L(0); PG8_MMA(0, 1, At, B1); PG8_BAR;
            PG8_LDA(At, 0, 1); PG8_STAGE(PG8_SA(0, 0), a2, voffA);
            PG8_BAR; PG8_WAIT_L(0); PG8_MMA(1, 0, At, B0); PG8_BAR; PG8_SCHED;
            PG8_STAGE(PG8_SB(0, 1), b2 + hstepB, voffB);
            PG8_WAIT_V(6); PG8_BAR; PG8_MMA(1, 1, At, B1); PG8_BAR;
            PG8_LDB(B0, 1, 0); PG8_SCHED; PG8_LDA(At, 1, 0); PG8_STAGE(PG8_SA(0, 1), a2 + hstepA, voffA);
            PG8_WAIT_L(8); PG8_BAR; PG8_WAIT_L(0); PG8_MMA(0, 0, At, B0); PG8_BAR; PG8_SCHED;
            PG8_LDB(B1, 1, 1); PG8_STAGE(PG8_SB(1, 0), b3, voffB);
            PG8_BAR; PG8_WAIT_L(0); PG8_MMA(0, 1, At, B1); PG8_BAR;
            PG8_LDA(At, 1, 1); PG8_STAGE(PG8_SA(1, 0), a3, voffA);
            PG8_BAR; PG8_WAIT_L(0); PG8_MMA(1, 0, At, B0); PG8_BAR; PG8_SCHED;
            PG8_STAGE(PG8_SB(1, 1), b3 + hstepB, voffB);
            PG8_WAIT_V(6); PG8_BAR; PG8_MMA(1, 1, At, B1); PG8_BAR;
            }
        }
        if constexpr (ALIGN_EPI) { if (wr == 0) PG8_BAR; }
        if constexpr (!Epi::AFTER_DRAIN) { E(acc, cur, wr, wc, fr, fq); S.done(cur); }
        if (!has_next) break;
#pragma unroll
        for (int a = 0; a < 2; ++a)
#pragma unroll
            for (int b = 0; b < 2; ++b)
#pragma unroll
                for (int m = 0; m < 4; ++m)
#pragma unroll
                    for (int n = 0; n < 2; ++n) acc[a][b][m][n] = (f32x4){0.f, 0.f, 0.f, 0.f};
        cur = nxt; cA = nA; cB = nB; ++ui;
        if constexpr (ALIGN_EPI) { if (wr == 1) PG8_BAR; }
    }
    PG8_WAIT_V(0);
    if constexpr (!ALIGN_EPI) { if (wr == 0) PG8_BAR; }
    PG8_BAR;
    if constexpr (Epi::AFTER_DRAIN) { E.fused(acc, cur, wr, wc, fr, fq, lds, wid, lane); S.done(cur); }
#undef PG8_SA
#undef PG8_SB
#undef PG8_STAGE
#undef PG8_LDA
#undef PG8_LDB
#undef PG8_MMA
#undef PG8_WAIT_V
#undef PG8_WAIT_L
#undef PG8_BAR
#undef PG8_SCHED
}
}

constexpr int T = 32768, S = 2048, DM = 1024, NIN = 2560, FF = 4096;
constexpr float EPS = 1e-6f;
constexpr float QSCALE = 0.125f * 1.4426950408889634f;
constexpr size_t MiB = 1u << 20;
constexpr size_t WS_WIN = 1 * MiB, WS_WOUT = 6 * MiB, WS_WFF1 = 8 * MiB, WS_WFF2 = 16 * MiB, WS_W1T = 24 * MiB;
constexpr size_t WS_WSP = 26 * MiB + 768 * 1024;
constexpr size_t WS_C1 = 26 * MiB, WS_ROPEC = 26 * MiB + 64 * 1024, WS_ROPES = 26 * MiB + 320 * 1024;
constexpr size_t WS_RINV1 = 27 * MiB, WS_SSQP = 27 * MiB + 512 * 1024, WS_GATES = 30 * MiB;
constexpr size_t WS_KCMP = 33 * MiB, WS_VCMPT = 33 * MiB + 512 * 1024, WS_HID = 34 * MiB, WS_X2B = 38 * MiB;
constexpr size_t WS_XB = 102 * MiB, WS_QN = 166 * MiB, WS_QR = 198 * MiB, WS_KC = 230 * MiB, WS_VC = 238 * MiB;
constexpr size_t WS_KSL = 246 * MiB, WS_VSLT = 254 * MiB, WS_KWN = 262 * MiB, WS_VWNT = 270 * MiB, WS_ZU = 278 * MiB, WS_ZVT = 310 * MiB, WS_O = 342 * MiB;
constexpr size_t WS_H = 102 * MiB, WS_END = 406 * MiB;
constexpr size_t WS_PART = WS_X2B;
constexpr size_t WS_C1P = 26 * MiB + 576 * 1024;
constexpr int LDS_BYTES = 147456;
constexpr int NWAVES = 8;

struct Args { const float* in[16]; float* out; unsigned char* ws; int ph_lo, ph_hi; };

__device__ __forceinline__ float bf2f(bf16_t h) { return __uint_as_float(((unsigned)h) << 16); }
__device__ __forceinline__ unsigned f2bf(float f) { unsigned u = __float_as_uint(f); return (u + 0x7fffu + ((u >> 16) & 1u)) >> 16; }
__device__ __forceinline__ unsigned pk2(float lo, float hi) { return pg8::cvt_pk_bf16(lo, hi); }
__device__ __forceinline__ float wave_sum(float v) {
#pragma unroll
    for (int o = 1; o < 64; o <<= 1) v += __shfl_xor(v, o);
    return v;
}
__device__ __forceinline__ float wave_max(float v) {
#pragma unroll
    for (int o = 1; o < 64; o <<= 1) v = fmaxf(v, __shfl_xor(v, o));
    return v;
}
__device__ __forceinline__ float gelu_tanh(float x) {
    const float u = 0.7978845608028654f * (x + 0.044715f * x * x * x);
    return x / (1.f + __expf(-2.f * u));
}
__device__ __forceinline__ void store8(bf16_t* p, const float* v) {
    u32x4 w; w.x = pk2(v[0], v[1]); w.y = pk2(v[2], v[3]); w.z = pk2(v[4], v[5]); w.w = pk2(v[6], v[7]);
    *(u32x4*)p = w;
}
__device__ __forceinline__ void load8(const bf16_t* p, float* v) {
    const u32x4 w = *(const u32x4*)p;
    v[0] = __uint_as_float(w.x << 16); v[1] = __uint_as_float(w.x & 0xffff0000u);
    v[2] = __uint_as_float(w.y << 16); v[3] = __uint_as_float(w.y & 0xffff0000u);
    v[4] = __uint_as_float(w.z << 16); v[5] = __uint_as_float(w.z & 0xffff0000u);
    v[6] = __uint_as_float(w.w << 16); v[7] = __uint_as_float(w.w & 0xffff0000u);
}
__device__ __forceinline__ float head_ssq(const float (&v)[16]) {
    float s = 0.f;
#pragma unroll
    for (int i = 0; i < 16; ++i) s += v[i] * v[i];
    s += __shfl_xor(s, 16); s += __shfl_xor(s, 32);
    return s;
}

struct EpiInProj {
    static constexpr bool PERM = true, AFTER_DRAIN = false;
    const float *rinv1, *g_q, *g_k, *g_sgu, *ropec, *ropes;
    bf16_t *qn, *qr, *kc, *vc, *ksl, *vslT, *kwn, *vwnT, *zu, *zvT; float* gates;
    __device__ __forceinline__ void operator()(const f32x4 (&acc)[2][2][4][2], const pg8::Unit& u, int wr, int wc, int fr, int fq) const {
        const int cs = u.pn * 4 + wc;
        if (cs >= 37) return;
        const int d0 = 8 * fq;
        float rsv[2][4];
#pragma unroll
        for (int ai = 0; ai < 2; ++ai)
#pragma unroll
            for (int m = 0; m < 4; ++m) rsv[ai][m] = rinv1[u.pm * 256 + ai * 128 + wr * 64 + m * 16 + fr];
#pragma unroll
        for (int ai = 0; ai < 2; ++ai)
#pragma unroll
            for (int m = 0; m < 4; ++m) {
                const int row = u.pm * 256 + ai * 128 + wr * 64 + m * 16 + fr;
                const float rs = rsv[ai][m];
                float v[16];
#pragma unroll
                for (int bj = 0; bj < 2; ++bj)
#pragma unroll
                    for (int n = 0; n < 2; ++n)
#pragma unroll
                        for (int e = 0; e < 4; ++e) v[bj * 8 + n * 4 + e] = acc[ai][bj][m][n][e] * rs;
                const int b = row >> 11, s = row & 2047;
                if (cs < 8 || cs == 12 || cs == 13 || cs == 16 || cs == 17) {
                    const float* gg = cs < 8 ? g_q : (cs < 14 ? g_k + 64 : g_k + 128);
                    const float rn = rsqrtf(head_ssq(v) * (1.f / 64.f) + EPS) * (cs < 8 ? QSCALE : 1.f);
                    float y[16];
#pragma unroll
                    for (int i = 0; i < 16; ++i) y[i] = v[i] * rn * gg[32 * (i >> 3) + d0 + (i & 7)];
                    float r1[8], r2[8];
#pragma unroll
                    for (int i = 0; i < 8; ++i) { int di = d0 + i; asm volatile("" : "+v"(di));
                        const float frev = __builtin_amdgcn_exp2f(-(float)di * (13.287712379549449f / 32.f)) * 0.15915494309189535f;
                        float xr = (float)s * frev; xr -= __builtin_rintf(xr);
                        const float c = __builtin_amdgcn_cosf(xr), sn = __builtin_amdgcn_sinf(xr); r1[i] = y[i] * c - y[8 + i] * sn; r2[i] = y[8 + i] * c + y[i] * sn; }
                    if (cs < 8) {
                        bf16_t* p = qn + (size_t)row * 512 + cs * 64 + d0; store8(p, y); store8(p + 32, y + 8);
                        bf16_t* p2 = qr + (size_t)row * 512 + cs * 64 + d0; store8(p2, r1); store8(p2 + 32, r2);
                    } else {
                        bf16_t* p = (cs < 14 ? ksl : kwn) + ((size_t)(b * 2 + (cs & 1)) * 2048 + s) * 64 + d0; store8(p, r1); store8(p + 32, r2);
                    }
                } else if (cs < 12) {
                    bf16_t* p = (cs < 10 ? kc : vc) + ((size_t)(b * 2 + (cs & 1)) * 2048 + s) * 64 + d0; store8(p, v); store8(p + 32, v + 8);
                } else if (cs < 20) {
                    bf16_t* p = (cs < 16 ? vslT : vwnT) + ((size_t)(b * 2 + (cs & 1)) * 32 + (s >> 6)) * 4096 + (s & 63);
#pragma unroll
                    for (int i = 0; i < 16; ++i) p[(32 * (i >> 3) + d0 + (i & 7)) * 64] = (bf16_t)f2bf(v[i]);
                } else if (cs < 28) {
                    float y[16];
#pragma unroll
                    for (int i = 0; i < 16; ++i) y[i] = gelu_tanh(v[i]);
                    bf16_t* p = zu + (size_t)row * 512 + (cs - 20) * 64 + d0; store8(p, y); store8(p + 32, y + 8);
                } else if (cs < 36) {
                    const int g = cs - 28;
                    float y[16];
#pragma unroll
                    for (int i = 0; i < 16; ++i) y[i] = gelu_tanh(v[i]);
                    const float rn = rsqrtf(head_ssq(y) * (1.f / 64.f) + EPS);
                    bf16_t* p = zvT + (((size_t)b * 16 + (s >> 7)) * 8 + g) * 8192 + (s & 127);
#pragma unroll
                    for (int i = 0; i < 16; ++i) { const int d = 32 * (i >> 3) + d0 + (i & 7); p[d * 128] = (bf16_t)f2bf(y[i] * rn * g_sgu[g * 64 + d]); }
                } else {
                    if (fq < 3) {
#pragma unroll
                        for (int i = 0; i < 8; ++i) gates[(size_t)row * 24 + d0 + i] = 1.f / (1.f + __expf(-v[i]));
                    }
                }
            }
    }
};

struct EpiPart {
    static constexpr bool PERM = true, AFTER_DRAIN = false;
    float* part;
    __device__ __forceinline__ void operator()(const f32x4 (&acc)[2][2][4][2], const pg8::Unit& u, int wr, int wc, int fr, int fq) const {
        float* base = part + (size_t)(u.koff >> 9) * 8192 * 256;
#pragma unroll
        for (int ai = 0; ai < 2; ++ai)
#pragma unroll
            for (int m = 0; m < 4; ++m) {
                const int row = u.pm * 256 + ai * 128 + wr * 64 + m * 16 + fr;
#pragma unroll
                for (int bj = 0; bj < 2; ++bj) {
                    float* p = base + (size_t)row * 256 + 128 * bj + 32 * wc + 8 * fq;
                    *(f32x4*)p = acc[ai][bj][m][0]; *(f32x4*)(p + 4) = acc[ai][bj][m][1];
                }
            }
    }
};

struct EpiWout {
    static constexpr bool PERM = true, AFTER_DRAIN = false;
    const bf16_t* xb; bf16_t* x2b; float* ssqp; LAS float* red;
    __device__ __forceinline__ void operator()(const f32x4 (&acc)[2][2][4][2], const pg8::Unit& u, int wr, int wc, int fr, int fq) const {
        u32x4 xr[2][4][2];
#pragma unroll
        for (int ai = 0; ai < 2; ++ai)
#pragma unroll
            for (int m = 0; m < 4; ++m)
#pragma unroll
                for (int bj = 0; bj < 2; ++bj)
                    xr[ai][m][bj] = *(const u32x4*)(xb + (size_t)(u.pm * 256 + ai * 128 + wr * 64 + m * 16 + fr) * DM + u.pn * 256 + 128 * bj + 32 * wc + 8 * fq);
        __builtin_amdgcn_sched_barrier(0);
#pragma unroll
        for (int ai = 0; ai < 2; ++ai)
#pragma unroll
            for (int m = 0; m < 4; ++m) {
                const int row = u.pm * 256 + ai * 128 + wr * 64 + m * 16 + fr;
                float ss = 0.f;
#pragma unroll
                for (int bj = 0; bj < 2; ++bj) {
                    const size_t off = (size_t)row * DM + u.pn * 256 + 128 * bj + 32 * wc + 8 * fq;
                    const u32x4 w = xr[ai][m][bj];
                    float y[8];
                    y[0] = __uint_as_float(w.x << 16) + acc[ai][bj][m][0].x; y[1] = __uint_as_float(w.x & 0xffff0000u) + acc[ai][bj][m][0].y;
                    y[2] = __uint_as_float(w.y << 16) + acc[ai][bj][m][0].z; y[3] = __uint_as_float(w.y & 0xffff0000u) + acc[ai][bj][m][0].w;
                    y[4] = __uint_as_float(w.z << 16) + acc[ai][bj][m][1].x; y[5] = __uint_as_float(w.z & 0xffff0000u) + acc[ai][bj][m][1].y;
                    y[6] = __uint_as_float(w.w << 16) + acc[ai][bj][m][1].z; y[7] = __uint_as_float(w.w & 0xffff0000u) + acc[ai][bj][m][1].w;
                    store8(x2b + off, y);
#pragma unroll
                    for (int i = 0; i < 8; ++i) ss += y[i] * y[i];
                }
                ss += __shfl_xor(ss, 16); ss += __shfl_xor(ss, 32);
                if (fq == 0) red[wc * 256 + (row & 255)] = ss;
            }
        __syncthreads();
        { const int tid = threadIdx.x;
          if (tid < 256) ssqp[(size_t)(u.pm * 256 + tid) * 4 + u.pn] = (red[tid] + red[256 + tid]) + (red[512 + tid] + red[768 + tid]); }
    }
};

struct EpiFF1 {
    static constexpr bool PERM = true, AFTER_DRAIN = false;
    const float* ssqp; bf16_t* H;
    __device__ __forceinline__ void operator()(const f32x4 (&acc)[2][2][4][2], const pg8::Unit& u, int wr, int wc, int fr, int fq) const {
        f32x4 sq[2][4];
#pragma unroll
        for (int ai = 0; ai < 2; ++ai)
#pragma unroll
            for (int m = 0; m < 4; ++m) sq[ai][m] = *(const f32x4*)(ssqp + (size_t)(u.pm * 256 + ai * 128 + wr * 64 + m * 16 + fr) * 4);
        __builtin_amdgcn_sched_barrier(0);
#pragma unroll
        for (int ai = 0; ai < 2; ++ai)
#pragma unroll
            for (int m = 0; m < 4; ++m) {
                const int row = u.pm * 256 + ai * 128 + wr * 64 + m * 16 + fr;
                const float tot = (sq[ai][m].x + sq[ai][m].y) + (sq[ai][m].z + sq[ai][m].w);
                const float rn = rsqrtf(tot * (1.f / 1024.f) + EPS);
#pragma unroll
                for (int bj = 0; bj < 2; ++bj) {
                    float y[8];
#pragma unroll
                    for (int n = 0; n < 2; ++n)
#pragma unroll
                        for (int e = 0; e < 4; ++e) { const float h = fmaxf(acc[ai][bj][m][n][e] * rn, 0.f); y[n * 4 + e] = h * h; }
                    store8(H + (size_t)row * FF + u.pn * 256 + 128 * bj + 32 * wc + 8 * fq, y);
                }
            }
    }
};

struct EpiFF2 {
    static constexpr bool PERM = true, AFTER_DRAIN = false;
    const bf16_t* x2b; float* out;
    __device__ __forceinline__ void operator()(const f32x4 (&acc)[2][2][4][2], const pg8::Unit& u, int wr, int wc, int fr, int fq) const {
        u32x4 xr[2][4][2];
#pragma unroll
        for (int ai = 0; ai < 2; ++ai)
#pragma unroll
            for (int m = 0; m < 4; ++m)
#pragma unroll
                for (int bj = 0; bj < 2; ++bj)
                    xr[ai][m][bj] = *(const u32x4*)(x2b + (size_t)(u.pm * 256 + ai * 128 + wr * 64 + m * 16 + fr) * DM + u.pn * 256 + 128 * bj + 32 * wc + 8 * fq);
        __builtin_amdgcn_sched_barrier(0);
#pragma unroll
        for (int ai = 0; ai < 2; ++ai)
#pragma unroll
            for (int m = 0; m < 4; ++m) {
                const int row = u.pm * 256 + ai * 128 + wr * 64 + m * 16 + fr;
#pragma unroll
                for (int bj = 0; bj < 2; ++bj) {
                    const size_t off = (size_t)row * DM + u.pn * 256 + 128 * bj + 32 * wc + 8 * fq;
                    const u32x4 w = xr[ai][m][bj];
                    f32x4 ya = acc[ai][bj][m][0], yb = acc[ai][bj][m][1];
                    ya.x += __uint_as_float(w.x << 16); ya.y += __uint_as_float(w.x & 0xffff0000u); ya.z += __uint_as_float(w.y << 16); ya.w += __uint_as_float(w.y & 0xffff0000u);
                    yb.x += __uint_as_float(w.z << 16); yb.y += __uint_as_float(w.z & 0xffff0000u); yb.z += __uint_as_float(w.w << 16); yb.w += __uint_as_float(w.w & 0xffff0000u);
                    *(f32x4*)(out + off) = ya; *(f32x4*)(out + off + 4) = yb;
                }
            }
    }
};

__device__ __forceinline__ int win_src_col(int nphys) {
    const int pn = nphys >> 8, Pp = nphys & 255, bj = Pp >> 7, wc = (Pp & 127) >> 5, r = Pp & 31;
    const int lc = (pn << 8) + 64 * wc + 32 * bj + r;
    if (lc < 1280) return lc;
    if (lc < 2304) return lc + 24;
    if (lc < 2328) return lc - 1024;
    return -1;
}
template <int MAP>
__device__ __forceinline__ void transpose_item(const float* W, int K, int N, bf16_t* WT, const float* gk, LAS float* scr, int item, int nblk, int lane) {
    const int kb = item / nblk, nb = item % nblk, k0 = 64 * kb, n0 = 32 * nb;
    const int src = MAP ? win_src_col(n0 + (lane & 31)) : n0 + (lane & 31);
    float tv[32];
#pragma unroll
    for (int i = 0; i < 32; ++i) { const int kk = 2 * i + (lane >> 5); tv[i] = (src >= 0) ? __builtin_nontemporal_load(W + (size_t)(k0 + kk) * N + src) : 0.f; }
    if (gk) {
#pragma unroll
        for (int i = 0; i < 32; ++i) tv[i] *= gk[k0 + 2 * i + (lane >> 5)]; }
#pragma unroll
    for (int i = 0; i < 32; ++i) scr[(2 * i + (lane >> 5)) * 33 + (lane & 31)] = tv[i];
    asm volatile("s_waitcnt lgkmcnt(0)" ::: "memory");
    const int c = lane & 7;
#pragma unroll
    for (int j = 0; j < 4; ++j) { const int n = (lane >> 3) + 8 * j; const LAS float* s = scr + (8 * c) * 33 + n;
        u32x4 o; o.x = pk2(s[0 * 33], s[1 * 33]); o.y = pk2(s[2 * 33], s[3 * 33]); o.z = pk2(s[4 * 33], s[5 * 33]); o.w = pk2(s[6 * 33], s[7 * 33]);
        *(u32x4*)(WT + (size_t)(n0 + n) * K + k0 + 8 * c) = o; }
    asm volatile("s_waitcnt lgkmcnt(0)" ::: "memory");
}

__device__ __forceinline__ void phase0(const Args& a, LAS unsigned char* lds) {
    const int tid = threadIdx.x, lane = tid & 63, wave = tid >> 6;
    unsigned char* ws = a.ws;
    LAS float* scr = (LAS float*)(lds + wave * 16384);
    const int gw = blockIdx.x * NWAVES + wave, NGW = gridDim.x * NWAVES;
    constexpr int I_IN = 16 * 80, I_C = 32 * 8;
    constexpr int NITEMS = I_IN + 2 * I_C;
    for (int it = gw; it < NITEMS; it += NGW) {
        int r = it;
        if (r < I_IN) { transpose_item<1>(a.in[2], 1024, 2328, (bf16_t*)(ws + WS_WIN), a.in[1], scr, r, 80, lane); continue; } r -= I_IN;
        if (r < I_C) { transpose_item<0>(a.in[6], 2048, 256, (bf16_t*)(ws + WS_W1T), nullptr, scr, r, 8, lane); continue; } r -= I_C;
        transpose_item<0>(a.in[6] + (size_t)2048 * 256, 2048, 256, (bf16_t*)(ws + WS_W1T) + (size_t)256 * 2048, nullptr, scr, r, 8, lane);
    }
    {
        const float* x = a.in[0]; bf16_t* xb = (bf16_t*)(ws + WS_XB); float* rinv1 = (float*)(ws + WS_RINV1);
        for (int m = gw; m < T; m += 2 * NGW) {
            const int m2 = m + NGW;
            const bool has2 = m2 < T;
            const f32x4* xr = (const f32x4*)(x + (size_t)m * DM) + lane;
            const f32x4* xr2 = (const f32x4*)(x + (size_t)(has2 ? m2 : m) * DM) + lane;
            f32x4 v[4], u[4]; float s = 0.f, s2 = 0.f;
#pragma unroll
            for (int j = 0; j < 4; ++j) { v[j] = __builtin_nontemporal_load(xr + 64 * j); u[j] = __builtin_nontemporal_load(xr2 + 64 * j); }
#pragma unroll
            for (int j = 0; j < 4; ++j) { s += (v[j].x * v[j].x + v[j].y * v[j].y) + (v[j].z * v[j].z + v[j].w * v[j].w); s2 += (u[j].x * u[j].x + u[j].y * u[j].y) + (u[j].z * u[j].z + u[j].w * u[j].w); }
            s = wave_sum(s); s2 = wave_sum(s2);
            if (lane == 0) { rinv1[m] = rsqrtf(s * (1.f / 1024.f) + EPS); if (has2) rinv1[m2] = rsqrtf(s2 * (1.f / 1024.f) + EPS); }
            unsigned long long* o8 = (unsigned long long*)(xb + (size_t)m * DM) + lane;
#pragma unroll
            for (int j = 0; j < 4; ++j) o8[64 * j] = (unsigned long long)pk2(v[j].x, v[j].y) | ((unsigned long long)pk2(v[j].z, v[j].w) << 32);
            if (has2) { unsigned long long* o82 = (unsigned long long*)(xb + (size_t)m2 * DM) + lane;
#pragma unroll
                for (int j = 0; j < 4; ++j) o82[64 * j] = (unsigned long long)pk2(u[j].x, u[j].y) | ((unsigned long long)pk2(u[j].z, u[j].w) << 32); }
        }
    }
    {
        bf16_t* Wsp = (bf16_t*)(ws + WS_WSP); const float* spw = a.in[9];
        for (int idx = blockIdx.x * 512 + tid; idx < 8 * 128 * 128; idx += gridDim.x * 512) { const int tq = (idx >> 7) & 127, sq = idx & 127; Wsp[idx] = (bf16_t)f2bf(sq <= tq ? spw[idx] : 0.f); }
    }
    {
        if ((gw & 3) == 0 && (gw >> 2) < 512) {
            const int item = gw >> 2, kv = item >> 8, cg4 = (item >> 6) & 3, kch = item & 63;
            const float* pe = a.in[5] + kv * 2048 + kch * 32; const float* w1 = a.in[6] + ((size_t)kv * 2048 + kch * 32) * 256 + cg4 * 64 + lane;
            float wv[32];
#pragma unroll
            for (int k = 0; k < 32; ++k) wv[k] = w1[(size_t)k * 256];
            float acc = 0.f;
#pragma unroll
            for (int k = 0; k < 32; ++k) acc += pe[k] * wv[k];
            ((float*)(ws + WS_C1P))[kch * 512 + kv * 256 + cg4 * 64 + lane] = acc;
        }
    }
}

__device__ __forceinline__ void phase3(const Args& a, LAS unsigned char* lds) {
    const int tid = threadIdx.x, lane = tid & 63, wave = tid >> 6;
    unsigned char* ws = a.ws;
    const float* part = (const float*)(ws + WS_PART); const float* c1p = (const float*)(ws + WS_C1P);
    bf16_t* kcmp = (bf16_t*)(ws + WS_KCMP); bf16_t* vcmpT = (bf16_t*)(ws + WS_VCMPT);
    LAS float* w2s = (LAS float*)lds;
    LAS float* c1s = w2s + 256 * 64;
    LAS float* hids = c1s + 256;
    const int nchunk = 8192 / 32;
    for (int item = blockIdx.x; item < nchunk; item += gridDim.x) {
        const int kv = (item * 32) >> 12;
        __syncthreads();
        { const f32x4* src = (const f32x4*)(a.in[7] + (size_t)kv * 256 * 64);
#pragma unroll
          for (int i = 0; i < 8; ++i) ((LAS f32x4*)w2s)[tid + 512 * i] = src[tid + 512 * i]; }
        if (tid < 256) { float t = 0.f;
#pragma unroll
            for (int kch = 0; kch < 64; ++kch) t += c1p[kch * 512 + kv * 256 + tid];
            c1s[tid] = t; }
        __syncthreads();
#pragma unroll 1
        for (int rr = 0; rr < 4; ++rr) {
            const int R = item * 32 + wave * 4 + rr, bh = (R >> 7) & 31, n = R & 127;
            f32x4 h4 = *(const LAS f32x4*)(c1s + 4 * lane);
#pragma unroll
            for (int kc = 0; kc < 8; ++kc) h4 += *(const f32x4*)(part + ((size_t)kc * 8192 + R) * 256 + 4 * lane);
            h4.x = gelu_tanh(h4.x); h4.y = gelu_tanh(h4.y); h4.z = gelu_tanh(h4.z); h4.w = gelu_tanh(h4.w);
            *(LAS f32x4*)(hids + wave * 256 + 4 * lane) = h4;
            asm volatile("s_waitcnt lgkmcnt(0)" ::: "memory");
            float acc = 0.f;
#pragma unroll 8
            for (int c = 0; c < 256; ++c) acc += hids[wave * 256 + c] * w2s[c * 64 + lane];
            if (kv == 0) {
                const float ss = wave_sum(acc * acc);
                const float y = acc * rsqrtf(ss * (1.f / 64.f) + EPS) * a.in[4][lane];
                kcmp[((size_t)bh * 128 + n) * 64 + lane] = (bf16_t)f2bf(n < 127 ? y : 0.f);
            } else {
                vcmpT[((size_t)bh * 64 + lane) * 128 + n] = (bf16_t)f2bf(n < 127 ? acc : 0.f);
            }
        }
    }
    {
        LAS float* scr = (LAS float*)(lds + 77824 + wave * 8704);
        const int gw = blockIdx.x * NWAVES + wave, NGW = gridDim.x * NWAVES;
        constexpr int I_O = 16 * 32, I_1 = 16 * 128, I_2 = 64 * 32;
        for (int it = gw; it < I_O + I_1 + I_2; it += NGW) {
            int r = it;
            if (r < I_O) { transpose_item<0>(a.in[12], 1024, 1024, (bf16_t*)(ws + WS_WOUT), a.in[11], scr, r, 32, lane); continue; } r -= I_O;
            if (r < I_1) { transpose_item<0>(a.in[14], 1024, 4096, (bf16_t*)(ws + WS_WFF1), a.in[13], scr, r, 128, lane); continue; } r -= I_1;
            transpose_item<0>(a.in[15], 4096, 1024, (bf16_t*)(ws + WS_WFF2), nullptr, scr, r, 32, lane);
        }
    }
}

typedef short bf16x8_t __attribute__((ext_vector_type(8)));
typedef short s16x4_t __attribute__((ext_vector_type(4)));
typedef float f32x16 __attribute__((ext_vector_type(16)));
typedef __bf16 bf16x2_t __attribute__((ext_vector_type(2)));
typedef float f32x2_t __attribute__((ext_vector_type(2)));
typedef unsigned u32x2 __attribute__((ext_vector_type(2)));
#define MFMA32(a, b, c) __builtin_amdgcn_mfma_f32_32x32x16_bf16((a), (b), (c), 0, 0, 0)
__device__ __forceinline__ unsigned cvtpk(float lo, float hi) { f32x2_t v = {lo, hi}; bf16x2_t b = __builtin_convertvector(v, bf16x2_t); return __builtin_bit_cast(unsigned, b); }
__device__ __forceinline__ float ex2(float x) { return __builtin_amdgcn_exp2f(x); }
__device__ __forceinline__ f32x16 zero16() { f32x16 z;
#pragma unroll
    for (int i = 0; i < 16; ++i) z[i] = 0.f; return z; }
__device__ __forceinline__ bf16x8_t pack8(const f32x16& x, int s8) {
    u32x4 w; w.x = cvtpk(x[s8 + 0], x[s8 + 1]); w.y = cvtpk(x[s8 + 2], x[s8 + 3]); w.z = cvtpk(x[s8 + 4], x[s8 + 5]); w.w = cvtpk(x[s8 + 6], x[s8 + 7]);
    return __builtin_bit_cast(bf16x8_t, w);
}
constexpr int A_KSTR = 144, A_VSTR = 136, A_CVSTR = 264, A_IMPSTR = 33;
constexpr int A_KT = 128 * A_KSTR, A_VT = 64 * A_CVSTR;
constexpr int A_KBUF = 0, A_VBUF = 2 * A_KT, A_CMPK = A_VBUF + 2 * A_VT, A_CMPV = A_CMPK + 18432, A_IMP = A_CMPV + 16896, A_SELM = A_IMP + 4 * 64 * A_IMPSTR * 4, A_SSQ = A_SELM + 256, A_END = A_SSQ + 4096;
static_assert(A_END <= LDS_BYTES - 64, "attention LDS map");

template <int MODE>
__device__ __forceinline__ void attn_tile(const LAS unsigned char* Kb, const LAS unsigned char* Vb, const bf16x8_t (&qf)[4], f32x16 (&oacc)[2], float& l_run,
                                          int r, int h, int dlt0, int dlt1, bool hiw) {
    const unsigned ulim = (MODE == 0) ? 0x80000000u : 512u;
    float ls = 0.f;
#pragma unroll
    for (int mt = 0; mt < 4; ++mt) {
        if (mt == 0) { if (hiw) __builtin_amdgcn_s_setprio(1); else __builtin_amdgcn_s_setprio(0); }
        if (mt == 2) { if (hiw) __builtin_amdgcn_s_setprio(0); else __builtin_amdgcn_s_setprio(1); }
        const int dl = mt < 2 ? dlt0 : dlt1;
        f32x16 sacc = zero16();
#pragma unroll
        for (int ks = 0; ks < 4; ++ks) { const bf16x8_t ka = *(const LAS bf16x8_t*)(Kb + (32 * mt + r) * A_KSTR + 32 * ks + 16 * h); sacc = MFMA32(ka, qf[ks], sacc); }
#pragma unroll
        for (int i = 0; i < 16; ++i) {
            float p;
            if (MODE == 2) p = ex2(sacc[i]);
            else if (MODE == 3) p = ex2(sacc[i] + __int_as_float(dl));
            else { const int ci = 32 * mt + (i & 3) + 8 * (i >> 2); p = ((unsigned)(dl - ci) < ulim) ? ex2(sacc[i]) : 0.f; }
            sacc[i] = p; ls += p;
        }
#pragma unroll
        for (int s = 0; s < 2; ++s) {
            const bf16x8_t pf = pack8(sacc, 8 * s);
#pragma unroll
            for (int dt = 0; dt < 2; ++dt) {
                const LAS unsigned char* vp = Vb + (32 * dt + r) * A_CVSTR + (32 * mt + 16 * s + 4 * h) * 2;
                const s16x4_t lo = *(const LAS s16x4_t*)vp, hi = *(const LAS s16x4_t*)(vp + 16);
                oacc[dt] = MFMA32(__builtin_shufflevector(lo, hi, 0, 1, 2, 3, 4, 5, 6, 7), pf, oacc[dt]);
            }
        }
    }
    l_run += ls;
}

__device__ __forceinline__ void phase4_attn(const Args& a, LAS unsigned char* lds) {
    const int tid0 = threadIdx.x, w = __builtin_amdgcn_readfirstlane(tid0 >> 6), g = w >> 1, half = w & 1;
    unsigned char* ws = a.ws;
    const bf16_t* qn = (const bf16_t*)(ws + WS_QN); const bf16_t* qr = (const bf16_t*)(ws + WS_QR);
    const bf16_t* kcmp = (const bf16_t*)(ws + WS_KCMP); const bf16_t* vcmpT = (const bf16_t*)(ws + WS_VCMPT);
    const bf16_t* ksl = (const bf16_t*)(ws + WS_KSL); const bf16_t* vslT = (const bf16_t*)(ws + WS_VSLT);
    const bf16_t* kwn = (const bf16_t*)(ws + WS_KWN); const bf16_t* vwnT = (const bf16_t*)(ws + WS_VWNT);
    const float* gates = (const float*)(ws + WS_GATES);
    bf16_t* o = (bf16_t*)(ws + WS_O);
    LAS float* IMP = (LAS float*)(lds + A_IMP); LAS unsigned* SELM = (LAS unsigned*)(lds + A_SELM); LAS float* SSQ = (LAS float*)(lds + A_SSQ);
    for (int pr = blockIdx.x; pr < 256; pr += gridDim.x) {
        const int b = pr >> 4, tt0 = pr & 15;
#pragma unroll 1
        for (int it = 0; it < 2; ++it) {
            const int t = it ? 31 - tt0 : tt0;
            f32x16 comb[2][2];
#pragma unroll
            for (int hkv = 0; hkv < 2; ++hkv) {
                const int bh = b * 2 + hkv, head = hkv * 4 + g;
                int tid = tid0; asm volatile("" : "+v"(tid));
                const int lane = tid & 63, r = lane & 31, h = lane >> 5, ql = 32 * half + r, pos = 64 * t + ql, tok = b * 2048 + pos;
                comb[hkv][0] = zero16(); comb[hkv][1] = zero16();
                const float g0 = gates[(size_t)tok * 24 + head * 3 + 0], g1 = gates[(size_t)tok * 24 + head * 3 + 1], g2 = gates[(size_t)tok * 24 + head * 3 + 2];
                __syncthreads();
                {
                    const bf16_t* kc = kcmp + (size_t)bh * 128 * 64; const bf16_t* vc = vcmpT + (size_t)bh * 64 * 128;
#pragma unroll
                    for (int i = 0; i < 2; ++i) { const int c = tid + 512 * i;
                        const u32x4 kv = *(const u32x4*)(kc + (size_t)c * 8);
                        *(LAS u32x4*)(lds + A_CMPK + (c >> 3) * A_KSTR + (c & 7) * 16) = kv;
                        const u32x4 vv = *(const u32x4*)(vc + (size_t)c * 8);
                        LAS unsigned char* vp = lds + A_CMPV + (c >> 4) * A_CVSTR + (c & 15) * 16;
                        *(LAS u32x2*)vp = (u32x2){vv.x, vv.y}; *(LAS u32x2*)(vp + 8) = (u32x2){vv.z, vv.w}; }
                }
                bf16x8_t qf[4];
#pragma unroll
                for (int ks = 0; ks < 4; ++ks) qf[ks] = __builtin_nontemporal_load((const bf16x8_t*)(qn + (size_t)tok * 512 + head * 64 + 16 * ks + 8 * h));
                __syncthreads();
                {
                    f32x16 s4[4];
#pragma unroll
                    for (int mt = 0; mt < 4; ++mt) { s4[mt] = zero16();
#pragma unroll
                        for (int ks = 0; ks < 4; ++ks) { const bf16x8_t ka = *(const LAS bf16x8_t*)(lds + A_CMPK + (32 * mt + r) * A_KSTR + 32 * ks + 16 * h); s4[mt] = MFMA32(ka, qf[ks], s4[mt]); } }
                    const int clim = (pos - 31 - 64 * h) >> 4;
                    float ls = 0.f;
#pragma unroll
                    for (int mt = 0; mt < 4; ++mt)
#pragma unroll
                        for (int i = 0; i < 16; ++i) { const int ci = 32 * mt + (i & 3) + 8 * (i >> 2);
                            const float p = (ci <= clim) ? ex2(s4[mt][i]) : 0.f; s4[mt][i] = p; ls += p; }
                    ls += __shfl_xor(ls, 32);
                    const float inv = 1.f / fmaxf(ls, 1e-20f);
#pragma unroll
                    for (int mt = 0; mt < 4; ++mt) s4[mt] *= inv;
                    if (t >= 16) {
                        float oprev = 0.f;
#pragma unroll
                        for (int idx = 0; idx < 16; ++idx) {
                            const int mt = idx >> 2, ap = idx & 3;
                            const float tail = 0.5f * s4[mt][4 * ap + 3];
                            const float ot = __shfl_xor(tail, 32);
                            const float inner = s4[mt][4 * ap] + s4[mt][4 * ap + 1] + s4[mt][4 * ap + 2] + tail;
                            const float prev = h ? ot : oprev;
                            oprev = ot;
                            IMP[(g * 64 + ql) * A_IMPSTR + 8 * mt + 2 * ap + h] = inner + prev;
                        }
                    }
                    f32x16 oc[2]; oc[0] = zero16(); oc[1] = zero16();
#pragma unroll
                    for (int mt = 0; mt < 4; ++mt)
#pragma unroll
                        for (int s = 0; s < 2; ++s) {
                            const bf16x8_t pf = pack8(s4[mt], 8 * s);
#pragma unroll
                            for (int dt = 0; dt < 2; ++dt) {
                                const LAS unsigned char* vp = lds + A_CMPV + (32 * dt + r) * A_CVSTR + (32 * mt + 16 * s + 4 * h) * 2;
                                const s16x4_t lo = *(const LAS s16x4_t*)vp, hi = *(const LAS s16x4_t*)(vp + 16);
                                oc[dt] = MFMA32(__builtin_shufflevector(lo, hi, 0, 1, 2, 3, 4, 5, 6, 7), pf, oc[dt]);
                            }
                        }
                    comb[hkv][0] += oc[0] * g0; comb[hkv][1] += oc[1] * g0;
                }
                if (t >= 16) {
                    __syncthreads();
                    const int qloc = tid >> 3, jg = tid & 7;
                    unsigned bits = 0u;
                    float xe[4]; int cnt[4];
#pragma unroll
                    for (int e = 0; e < 4; ++e) { const int j = 4 * jg + e; const LAS float* ip = IMP + qloc * A_IMPSTR + j;
                        float x = (ip[0] + ip[64 * A_IMPSTR]) + (ip[128 * A_IMPSTR] + ip[192 * A_IMPSTR]);
                        if (j == 0 || j == t || j == t - 1) x = 1e9f;
                        if (j > t) x = -INFINITY;
                        xe[e] = x; cnt[e] = 0; }
#pragma unroll 4
                    for (int i = 0; i < 32; ++i) { const LAS float* ip = IMP + qloc * A_IMPSTR + i;
                        float vi = (ip[0] + ip[64 * A_IMPSTR]) + (ip[128 * A_IMPSTR] + ip[192 * A_IMPSTR]);
                        if (i == 0 || i == t || i == t - 1) vi = 1e9f;
                        if (i > t) vi = -INFINITY;
#pragma unroll
                        for (int e = 0; e < 4; ++e) cnt[e] += (vi > xe[e] || (vi == xe[e] && i < 4 * jg + e)) ? 1 : 0; }
#pragma unroll
                    for (int e = 0; e < 4; ++e) if (cnt[e] < 16 && xe[e] > -INFINITY) bits |= 1u << (4 * jg + e);
                    bits |= __shfl_xor(bits, 1); bits |= __shfl_xor(bits, 2); bits |= __shfl_xor(bits, 4);
                    if (jg == 0) SELM[qloc] = bits;
                    __syncthreads();
                }
                const unsigned selw = (t >= 16) ? SELM[ql] : ((2u << t) - 1u);
#pragma unroll
                for (int ks = 0; ks < 4; ++ks) qf[ks] = __builtin_nontemporal_load((const bf16x8_t*)(qr + (size_t)tok * 512 + head * 64 + 16 * ks + 8 * h));
                const int kt_lo = t >= 8 ? t - 8 : 0, wlo = kt_lo >> 1, n_sel = (t >> 1) + 1, n_all = n_sel + ((t >> 1) - wlo + 1);
                const bf16_t* Ks = ksl + (size_t)bh * 2048 * 64; const bf16_t* Vs = vslT + (size_t)bh * 64 * 2048;
                const bf16_t* Kw = kwn + (size_t)bh * 2048 * 64; const bf16_t* Vw = vwnT + (size_t)bh * 64 * 2048;
#define A_ISSUE(idx) do { const int i1_ = (idx); const bool sel1_ = i1_ < n_sel; const int st1_ = sel1_ ? i1_ : wlo + (i1_ - n_sel); \
        int tv_ = tid; asm volatile("" : "+v"(tv_)); \
        const bf16_t* Kg_ = (sel1_ ? Ks : Kw) + (size_t)st1_ * 8192; const bf16_t* Vg_ = (sel1_ ? Vs : Vw) + (size_t)st1_ * 8192; \
        kR0 = *(const u32x4*)(Kg_ + (size_t)tv_ * 8); kR1 = *(const u32x4*)(Kg_ + (size_t)(tv_ + 512) * 8); \
        vR0 = *(const u32x4*)(Vg_ + (size_t)tv_ * 8); vR1 = *(const u32x4*)(Vg_ + (size_t)(tv_ + 512) * 8); } while (0)
#define A_STAGE(bufi) do { int tv_ = tid; asm volatile("" : "+v"(tv_)); \
        LAS unsigned char* kp_ = lds + A_KBUF + (bufi) * A_KT + (tv_ >> 3) * A_KSTR + (tv_ & 7) * 16; \
        *(LAS u32x4*)kp_ = kR0; *(LAS u32x4*)(kp_ + 64 * A_KSTR) = kR1; \
        LAS unsigned char* vp_ = lds + A_VBUF + (bufi) * A_VT + (tv_ >> 3) * A_CVSTR + (tv_ & 7) * 16; \
        *(LAS u32x2*)vp_ = (u32x2){vR0.x, vR0.y}; *(LAS u32x2*)(vp_ + 8) = (u32x2){vR0.z, vR0.w}; \
        *(LAS u32x2*)(vp_ + 128) = (u32x2){vR1.x, vR1.y}; *(LAS u32x2*)(vp_ + 136) = (u32x2){vR1.z, vR1.w}; } while (0)
                u32x4 kR0, kR1, vR0, vR1;
                A_ISSUE(0);
                A_STAGE(0);
                __syncthreads();
                f32x16 oacc[2]; oacc[0] = zero16(); oacc[1] = zero16();
                float l_run = 0.f;
#pragma unroll 1
                for (int i = 0; i < n_all; ++i) {
                    const int bufo = i & 1;
                    if (i + 1 < n_all) A_ISSUE(i + 1);
                    const LAS unsigned char* Kb = lds + A_KBUF + bufo * A_KT; const LAS unsigned char* Vb = lds + A_VBUF + bufo * A_VT;
                    const bool issel = i < n_sel;
                    const int st = issel ? i : wlo + (i - n_sel);
                    const int dlt = 64 * t + ql - 128 * st - 4 * h;
                    if (issel) {
                        const bool b0 = (selw >> (2 * st)) & 1u, b1 = (selw >> (2 * st + 1)) & 1u;
                        if (__ballot(b0 || b1) != 0ull) {
                            if (2 * st + 1 < t) {
                                if (__ballot(b0 && b1) == ~0ull) attn_tile<2>(Kb, Vb, qf, oacc, l_run, r, h, dlt, dlt, (w & 4) != 0);
                                else attn_tile<3>(Kb, Vb, qf, oacc, l_run, r, h, __float_as_int(b0 ? 0.f : -1e30f), __float_as_int(b1 ? 0.f : -1e30f), (w & 4) != 0);
                            } else attn_tile<0>(Kb, Vb, qf, oacc, l_run, r, h, b0 ? dlt : -1, b1 ? dlt : -1, (w & 4) != 0);
                        }
                    } else {
                        if (2 * st > t - 8 && 2 * st + 1 < t) attn_tile<2>(Kb, Vb, qf, oacc, l_run, r, h, dlt, dlt, (w & 4) != 0);
                        else attn_tile<1>(Kb, Vb, qf, oacc, l_run, r, h, dlt, dlt, (w & 4) != 0);
                    }
                    if (i == n_sel - 1 || i == n_all - 1) { const float lt = l_run + __shfl_xor(l_run, 32); const float sc = ((i == n_sel - 1) ? g1 : g2) / fmaxf(lt, 1e-20f);
                        comb[hkv][0] += oacc[0] * sc; comb[hkv][1] += oacc[1] * sc; oacc[0] = zero16(); oacc[1] = zero16(); l_run = 0.f; }
                    if (i + 1 < n_all) A_STAGE(bufo ^ 1);
                    __syncthreads();
                }
#undef A_ISSUE
#undef A_STAGE
            }
            int tid = tid0; asm volatile("" : "+v"(tid));
            const int lane = tid & 63, r = lane & 31, h = lane >> 5, ql = 32 * half + r, pos = 64 * t + ql, tok = b * 2048 + pos;
            float ss = 0.f;
#pragma unroll
            for (int hkv = 0; hkv < 2; ++hkv)
#pragma unroll
                for (int dt = 0; dt < 2; ++dt)
#pragma unroll
                    for (int i = 0; i < 16; ++i) ss += comb[hkv][dt][i] * comb[hkv][dt][i];
            ss += __shfl_xor(ss, 32);
            if (h == 0) SSQ[w * 32 + r] = ss;
            __syncthreads();
            const float tot = (SSQ[(half + 0) * 32 + r] + SSQ[(half + 2) * 32 + r]) + (SSQ[(half + 4) * 32 + r] + SSQ[(half + 6) * 32 + r]);
            const float rn = rsqrtf(tot * (1.f / 512.f) + EPS);
#pragma unroll
            for (int hkv = 0; hkv < 2; ++hkv)
#pragma unroll
                for (int dt = 0; dt < 2; ++dt)
#pragma unroll
                    for (int ap = 0; ap < 4; ++ap) {
                        u32x2 pk; pk.x = cvtpk(comb[hkv][dt][4 * ap] * rn, comb[hkv][dt][4 * ap + 1] * rn); pk.y = cvtpk(comb[hkv][dt][4 * ap + 2] * rn, comb[hkv][dt][4 * ap + 3] * rn);
                        *(u32x2*)(o + (size_t)tok * DM + (hkv * 4 + g) * 64 + 32 * dt + 8 * ap + 4 * h) = pk;
                    }
        }
    }
}

constexpr int G_TSTR = 136, G_TILE = 128 * G_TSTR, G_SSQ = 8 * G_TILE;
static_assert(G_SSQ + 8 * 128 * 4 <= LDS_BYTES - 64, "gMLP LDS map");
__device__ __forceinline__ void phase4_gmlp(const Args& a, LAS unsigned char* lds) {
    const int tid0 = threadIdx.x, g = __builtin_amdgcn_readfirstlane(tid0 >> 6);
    unsigned char* ws = a.ws;
    const bf16_t* zu = (const bf16_t*)(ws + WS_ZU); const bf16_t* zvT = (const bf16_t*)(ws + WS_ZVT); const bf16_t* Wsp = (const bf16_t*)(ws + WS_WSP);
    const float* sp_b = a.in[10];
    bf16_t* o = (bf16_t*)(ws + WS_O);
    LAS float* SSQ2 = (LAS float*)(lds + G_SSQ);
    LAS unsigned char* tile = lds + g * G_TILE;
    for (int item = blockIdx.x; item < 256; item += gridDim.x) {
        const int b = item >> 4, ch = item & 15;
        const size_t tok0 = (size_t)b * 2048 + ch * 128;
        int tid = tid0; asm volatile("" : "+v"(tid));
        const int lane = tid & 63, r = lane & 31, h = lane >> 5;
        __syncthreads();
        bf16x8_t zf[2][8];
#pragma unroll
        for (int dt = 0; dt < 2; ++dt)
#pragma unroll
            for (int ks = 0; ks < 8; ++ks) zf[dt][ks] = *(const bf16x8_t*)(zvT + ((((size_t)b * 16 + ch) * 8 + g) * 64 + 32 * dt + r) * 128 + 16 * ks + 8 * h);
        f32x16 acc[2][4];
#pragma unroll
        for (int tt = 0; tt < 4; ++tt) { acc[0][tt] = zero16(); acc[1][tt] = zero16();
            __builtin_amdgcn_sched_barrier(0);
#pragma unroll
            for (int ks = 0; ks < 2 * tt + 2; ++ks) {
                const bf16x8_t wf = *(const bf16x8_t*)(Wsp + ((size_t)g * 128 + 32 * tt + r) * 128 + 16 * ks + 8 * h);
                acc[0][tt] = MFMA32(zf[0][ks], wf, acc[0][tt]); acc[1][tt] = MFMA32(zf[1][ks], wf, acc[1][tt]);
            } }
        __builtin_amdgcn_sched_barrier(0);
#pragma unroll
        for (int hb = 0; hb < 2; ++hb) {
            u32x4 zr[8];
#pragma unroll
            for (int it = 0; it < 8; ++it) zr[it] = __builtin_nontemporal_load((const u32x4*)(zu + (tok0 + (lane >> 3) + 8 * (8 * hb + it)) * 512 + g * 64 + (lane & 7) * 8));
#pragma unroll
            for (int it = 0; it < 8; ++it) { LAS unsigned char* p = tile + ((lane >> 3) + 8 * (8 * hb + it)) * G_TSTR + (lane & 7) * 16;
                *(LAS u32x2*)p = (u32x2){zr[it].x, zr[it].y}; *(LAS u32x2*)(p + 8) = (u32x2){zr[it].z, zr[it].w}; }
        }
        asm volatile("s_waitcnt lgkmcnt(0)" ::: "memory");
#pragma unroll
        for (int tt = 0; tt < 4; ++tt) {
            const int tl = 32 * tt + r;
            const float bias = sp_b[g * 128 + tl];
            float ss = 0.f;
#pragma unroll
            for (int dt = 0; dt < 2; ++dt)
#pragma unroll
                for (int ap = 0; ap < 4; ++ap) {
                    const u32x2 zz = *(const LAS u32x2*)(tile + tl * G_TSTR + (32 * dt + 8 * ap + 4 * h) * 2);
                    const float z0 = __uint_as_float(zz.x << 16), z1 = __uint_as_float(zz.x & 0xffff0000u), z2 = __uint_as_float(zz.y << 16), z3 = __uint_as_float(zz.y & 0xffff0000u);
                    float v0 = z0 * (acc[dt][tt][4 * ap] + bias), v1 = z1 * (acc[dt][tt][4 * ap + 1] + bias), v2 = z2 * (acc[dt][tt][4 * ap + 2] + bias), v3 = z3 * (acc[dt][tt][4 * ap + 3] + bias);
                    acc[dt][tt][4 * ap] = v0; acc[dt][tt][4 * ap + 1] = v1; acc[dt][tt][4 * ap + 2] = v2; acc[dt][tt][4 * ap + 3] = v3;
                    ss += (v0 * v0 + v1 * v1) + (v2 * v2 + v3 * v3);
                }
            ss += __shfl_xor(ss, 32);
            if (h == 0) SSQ2[g * 128 + tl] = ss;
        }
        __syncthreads();
#pragma unroll
        for (int tt = 0; tt < 4; ++tt) {
            const int tl = 32 * tt + r;
            float tot = 0.f;
#pragma unroll
            for (int gg = 0; gg < 8; ++gg) tot += SSQ2[gg * 128 + tl];
            const float rn = rsqrtf(tot * (1.f / 512.f) + EPS);
#pragma unroll
            for (int dt = 0; dt < 2; ++dt)
#pragma unroll
                for (int ap = 0; ap < 4; ++ap) {
                    u32x2 pk; pk.x = cvtpk(acc[dt][tt][4 * ap] * rn, acc[dt][tt][4 * ap + 1] * rn); pk.y = cvtpk(acc[dt][tt][4 * ap + 2] * rn, acc[dt][tt][4 * ap + 3] * rn);
                    *(LAS u32x2*)(tile + tl * G_TSTR + (32 * dt + 8 * ap + 4 * h) * 2) = pk;
                }
        }
        asm volatile("s_waitcnt lgkmcnt(0)" ::: "memory");
#pragma unroll
        for (int it = 0; it < 16; ++it) { const LAS unsigned char* p = tile + ((lane >> 3) + 8 * it) * G_TSTR + (lane & 7) * 16;
            const u32x2 lo = *(const LAS u32x2*)p, hi = *(const LAS u32x2*)(p + 8);
            *(u32x4*)(o + (tok0 + (lane >> 3) + 8 * it) * DM + 512 + g * 64 + (lane & 7) * 8) = (u32x4){lo.x, lo.y, hi.x, hi.y}; }
    }
}

constexpr int BAR_BYTES = (1024 + 8 * 2304) * 4;
__device__ __forceinline__ unsigned xb_ld(unsigned* p) { return __hip_atomic_load(p, __ATOMIC_RELAXED, __HIP_MEMORY_SCOPE_AGENT); }
__device__ __forceinline__ unsigned xb_add(unsigned* p, unsigned v) { return __hip_atomic_fetch_add(p, v, __ATOMIC_RELAXED, __HIP_MEMORY_SCOPE_AGENT); }
__device__ __forceinline__ unsigned xb_xcc_id() { return (unsigned)__builtin_amdgcn_s_getreg((3 << 11) | 20) & 0xFu; }
__device__ __forceinline__ void grid_barrier(unsigned* barw, int k, volatile LAS unsigned* st) {
    asm volatile("s_waitcnt vmcnt(0)" ::: "memory");
    __syncthreads();
    if (threadIdx.x == 0) {
        __builtin_amdgcn_s_waitcnt(0);
        const unsigned x = xb_xcc_id();
        unsigned nloc = st[0], nx = st[1];
        if (nloc == 0u) {
            const unsigned G = gridDim.x;
            for (;;) { unsigned sum = 0u, cnt = 0u, mine = 0u;
#pragma unroll
                for (unsigned j = 0; j < 16; ++j) { const unsigned c = xb_ld(barw + 64 * j); sum += c; cnt += (c > 0u) ? 1u : 0u; mine = (j == x) ? c : mine; }
                if (sum == G) { nloc = mine; nx = cnt; break; }
                __builtin_amdgcn_s_sleep(1); }
            st[0] = nloc; st[1] = nx;
        }
        unsigned* sb = barw + 1024 + k * 2304;
        const unsigned old = xb_add(sb + 64 * x, 1u);
        if (old + 1u == nloc) {
            __builtin_amdgcn_fence(__ATOMIC_RELEASE, "agent");
            asm volatile("s_waitcnt vmcnt(0)" ::: "memory");
            const unsigned og = xb_add(sb + 2048, 1u);
            if (og + 1u == nx) xb_add(sb + 2112, 1u);
            else while (xb_ld(sb + 2112) == 0u) __builtin_amdgcn_s_sleep(1);
            __builtin_amdgcn_fence(__ATOMIC_ACQUIRE, "agent");
            xb_add(sb + 1024 + 64 * x, 1u);
            asm volatile("s_waitcnt vmcnt(0)" ::: "memory");
        } else {
            while (xb_ld(sb + 1024 + 64 * x) == 0u) __builtin_amdgcn_s_sleep(1);
            __builtin_amdgcn_fence(__ATOMIC_ACQUIRE, "agent");
            asm volatile("s_waitcnt vmcnt(0)" ::: "memory");
        }
    }
    __syncthreads();
}

#ifndef N_LAUNCHES
#define N_LAUNCHES 1
#endif
constexpr int NPHASE = 8;
__global__ void __launch_bounds__(NWAVES * 64, 2) fwd_kernel(Args args) {
    extern __shared__ __attribute__((aligned(16))) unsigned char lds_raw[];
    LAS unsigned char* lds = (LAS unsigned char*)lds_raw;
    unsigned char* ws = args.ws;
    const int lo = args.ph_lo, hi = args.ph_hi;
    const int G = gridDim.x;
#define IN(k) (lo <= (k) && (k) < hi)
    unsigned* barw = (unsigned*)ws;
    volatile LAS unsigned* bst = (volatile LAS unsigned*)(lds + LDS_BYTES - 64);
    if (threadIdx.x == 0) { bst[0] = 0u; bst[1] = 0u; (void)xb_add(barw + 64 * xb_xcc_id(), 1u); }
    __syncthreads();
    if (hi > NPHASE) cg::this_grid().sync();
#define SEAM(k) do { if (IN(k) && IN((k) + 1)) { grid_barrier(barw, (k), bst); } } while (0)
    if (IN(0)) { phase0(args, lds); }
    SEAM(0);
    if (IN(1)) {
        pg8::Gemm g{(const bf16_t*)(ws + WS_XB), (const bf16_t*)(ws + WS_WIN), T, NIN, DM, DM, DM};
        pg8::StaticOrder So; So.init(T, NIN, G, (int)blockIdx.x);
        EpiInProj E{(const float*)(ws + WS_RINV1), args.in[3], args.in[4], args.in[8], (const float*)(ws + WS_ROPEC), (const float*)(ws + WS_ROPES),
                    (bf16_t*)(ws + WS_QN), (bf16_t*)(ws + WS_QR), (bf16_t*)(ws + WS_KC), (bf16_t*)(ws + WS_VC), (bf16_t*)(ws + WS_KSL), (bf16_t*)(ws + WS_VSLT),
                    (bf16_t*)(ws + WS_KWN), (bf16_t*)(ws + WS_VWNT), (bf16_t*)(ws + WS_ZU), (bf16_t*)(ws + WS_ZVT), (float*)(ws + WS_GATES)};
        pg8::gemm_phase<EpiInProj, pg8::StaticOrder, true, true>(lds, g, So, E);
    }
    SEAM(1);
    if (IN(2)) {
        pg8::Gemm g{(const bf16_t*)(ws + WS_KC), (const bf16_t*)(ws + WS_W1T), 8192, 512, 256, 1024, 2048};
        pg8::CmpOrder So{G, (int)blockIdx.x};
        EpiPart E{(float*)(ws + WS_PART)};
        pg8::gemm_phase<EpiPart, pg8::CmpOrder, false, true>(lds, g, So, E);
    }
    SEAM(2);
    if (IN(3)) { phase3(args, lds); }
    SEAM(3);
    if (IN(4)) { phase4_attn(args, lds); phase4_gmlp(args, lds); }
    SEAM(4);
    if (IN(5)) {
        pg8::Gemm g{(const bf16_t*)(ws + WS_O), (const bf16_t*)(ws + WS_WOUT), T, DM, DM, DM, DM};
        pg8::StaticOrder So; So.init(T, DM, G, (int)blockIdx.x);
        EpiWout E{(const bf16_t*)(ws + WS_XB), (bf16_t*)(ws + WS_X2B), (float*)(ws + WS_SSQP), (LAS float*)(lds + 131072)};
        pg8::gemm_phase<EpiWout, pg8::StaticOrder, true, true>(lds, g, So, E);
    }
    SEAM(5);
    if (IN(6)) {
        pg8::Gemm g{(const bf16_t*)(ws + WS_X2B), (const bf16_t*)(ws + WS_WFF1), T, FF, DM, DM, DM};
        pg8::StaticOrder So; So.init(T, FF, G, (int)blockIdx.x);
        EpiFF1 E{(const float*)(ws + WS_SSQP), (bf16_t*)(ws + WS_H)};
        pg8::gemm_phase<EpiFF1, pg8::StaticOrder, true, true>(lds, g, So, E);
    }
    SEAM(6);
    if (IN(7)) {
        pg8::Gemm g{(const bf16_t*)(ws + WS_H), (const bf16_t*)(ws + WS_WFF2), T, DM, FF, FF, FF};
        pg8::StaticOrder So; So.init(T, DM, G, (int)blockIdx.x);
        EpiFF2 E{(const bf16_t*)(ws + WS_X2B), args.out};
        pg8::gemm_phase<EpiFF2, pg8::StaticOrder, true, true>(lds, g, So, E);
    }
#undef IN
#undef SEAM
}

extern "C" void kernel_launch(void* const* d_in, const int* in_sizes, int n_in, void* d_out, int out_size, void* d_ws, size_t ws_size, hipStream_t stream) {
    static int grid = 0;
    if (grid == 0) {
        if (n_in != 16 || out_size != T * DM || ws_size < WS_END) { fprintf(stderr, "kernel_launch: unexpected shapes (n_in %d out %d ws %zu)\n", n_in, out_size, ws_size); grid = -1; return; }
        int dev = 0, cus = 0, per_cu = 0;
        hipGetDevice(&dev); hipDeviceGetAttribute(&cus, hipDeviceAttributeMultiprocessorCount, dev);
        if (hipFuncSetAttribute((const void*)fwd_kernel, hipFuncAttributeMaxDynamicSharedMemorySize, LDS_BYTES) != hipSuccess) { fprintf(stderr, "kernel_launch: hipFuncSetAttribute failed\n"); grid = -1; return; }
        if (hipOccupancyMaxActiveBlocksPerMultiprocessor(&per_cu, (const void*)fwd_kernel, NWAVES * 64, LDS_BYTES) != hipSuccess || per_cu < 1) { fprintf(stderr, "kernel_launch: occupancy query says %d\n", per_cu); per_cu = 1; }
        (void)hipGetLastError();
        grid = cus * per_cu;
        fprintf(stderr, "kernel_launch: grid %d (cus %d x %d)\n", grid, cus, per_cu);
    }
    if (grid < 0) return;
    if (hipMemsetAsync(d_ws, 0, BAR_BYTES, stream) != hipSuccess) { fprintf(stderr, "kernel_launch: memset of the barrier words failed\n"); return; }
    Args a{};
    for (int i = 0; i < 16; ++i) a.in[i] = (const float*)d_in[i];
    a.out = (float*)d_out; a.ws = (unsigned char*)d_ws;
#if N_LAUNCHES == 1
    a.ph_lo = 0; a.ph_hi = NPHASE;
    void* kargs[] = {&a};
    hipError_t e = hipLaunchCooperativeKernel((const void*)fwd_kernel, dim3(grid), dim3(NWAVES * 64), kargs, LDS_BYTES, stream);
    if (e != hipSuccess) fprintf(stderr, "kernel_launch: cooperative launch failed: %s (grid %d)\n", hipGetErrorString(e), grid);
#else
    for (int p = 0; p < NPHASE; ++p) {
        a.ph_lo = p; a.ph_hi = p + 1;
        hipLaunchKernelGGL(fwd_kernel, dim3(grid), dim3(NWAVES * 64), LDS_BYTES, stream, a);
    }
#endif
}
```

```cpp
#include <hip/hip_runtime.h>
#include <hip/hip_cooperative_groups.h>
#include <cstdio>
#include <cstdint>
namespace cg = cooperative_groups;

#define LAS __attribute__((address_space(3)))
typedef unsigned short bf16_t;
typedef unsigned u32x4 __attribute__((ext_vector_type(4)));
typedef float f32x4 __attribute__((ext_vector_type(4)));

namespace pg8 {
#define PG8_LAS __attribute__((address_space(3)))
typedef short bf16x8 __attribute__((ext_vector_type(8)));
constexpr int BM = 256, BK = 64, HALF = 128, HTB = HALF * BK * 2, STAGE_BYTES = 8 * HTB, NXCD = 8, WGM = 4;
__host__ __device__ __forceinline__ int lds_byte(int r, int c) { const int st = (r >> 4) * 2 + (c >> 5), rr = r & 15, cc = c & 31, ob = rr * 64 + cc * 2; return st * 1024 + (ob ^ (((ob >> 9) & 1) << 5)); }
__host__ __device__ __forceinline__ void stage_rc(int b, int& R, int& C) { const int st = b / 1024, sb = b % 1024, swz = sb ^ (((sb >> 9) & 1) << 5); R = (st >> 1) * 16 + swz / 64; C = (st & 1) * 32 + (swz % 64) / 2; }
__host__ __device__ __forceinline__ int perm32(int rho) { const int n = rho >> 4, i = rho & 15; return 8 * (i >> 2) + 4 * n + (i & 3); }
struct Unit { int pm, pn, koff; };
struct Gemm { const bf16_t* A; const bf16_t* Bt; int M, N, K, lda, ldb; };
struct StaticOrder {
    int nM, nN, nwg, G, c;
    __host__ __device__ void init(int M, int N, int G_, int c_) { nM = M / BM; nN = N / BM; nwg = nM * nN; G = G_; c = c_; }
    __host__ __device__ bool next(int i, Unit& u) const {
        const long L = (long)i * G + c; if (L >= nwg) return false;
        int wgid = (int)L; { const int q = nwg / NXCD, r = nwg % NXCD, xcd = wgid % NXCD, off = wgid / NXCD; wgid = (xcd < r ? xcd * (q + 1) : r * (q + 1) + (xcd - r) * q) + off; }
        const int nig = WGM * nN, gid = wgid / nig, fm = gid * WGM, gsz = (nM - fm) < WGM ? (nM - fm) : WGM;
        u.pm = fm + ((wgid % nig) % gsz); u.pn = (wgid % nig) / gsz; u.koff = 0; return true;
    }
    __device__ __forceinline__ void a_ready(const Unit&) const {}
    __device__ __forceinline__ void done(const Unit&) const {}
};
struct CmpOrder {
    int G, c;
    __device__ bool next(int i, Unit& u) const { const long L = (long)i * G + c; if (L >= 128) return false; u.pm = (int)L & 31; u.pn = u.pm >> 4; u.koff = ((int)L >> 5) * 1024; return true; }
    __device__ __forceinline__ void a_ready(const Unit&) const {}
    __device__ __forceinline__ void done(const Unit&) const {}
};
__device__ __forceinline__ unsigned cvt_pk_bf16(float lo, float hi) { unsigned r; asm volatile("v_cvt_pk_bf16_f32 %0, %1, %2" : "=v"(r) : "v"(lo), "v"(hi)); return r; }
template <class Epi, class Sched, bool ALIGN_EPI = false, bool SP2 = false>
__device__ __forceinline__ void gemm_phase(PG8_LAS unsigned char* lds, const Gemm g, const Sched& S, const Epi& E) {
    const int tid = threadIdx.x, wid = __builtin_amdgcn_readfirstlane(tid >> 6), lane = tid & 63, wr = wid >> 2, wc = wid & 3, fr = lane & 15, fq = lane >> 4;
    const int K = g.K, nt = K / BK, lda = g.lda, ldb = g.ldb;
    unsigned voffA[2], voffB[2];
#pragma unroll
    for (int i = 0; i < 2; ++i) { int R, C; stage_rc(tid * 16 + i * 8192, R, C); const int Rb = Epi::PERM ? ((R & ~31) + perm32(R & 31)) : R;
        voffA[i] = (unsigned)(R * lda + C) * 2u; voffB[i] = (unsigned)(Rb * ldb + C) * 2u; }
    const size_t kstep = (size_t)(BK * 2);
    const size_t hstepA = (size_t)HALF * lda * 2, hstepB = (size_t)HALF * ldb * 2;
    const size_t tstepA = 2 * hstepA, tstepB = 2 * hstepB;
    const unsigned ldsw = (unsigned)wid * 1024u;
    const int aoff = lds_byte(wr * 64 + fr, fq * 8), boff = lds_byte(wc * 32 + fr, fq * 8);
#define PG8_SA(b, h) (((b) * 2 + (h)) * HTB)
#define PG8_SB(b, h) ((4 + (b) * 2 + (h)) * HTB)
#define PG8_STAGE(bufoff, gbase, voff) do { _Pragma("unroll") for (int _i = 0; _i < 2; ++_i) \
        __builtin_amdgcn_global_load_lds((const unsigned*)((const char*)(gbase) + (voff)[_i]), (PG8_LAS unsigned*)(lds + (bufoff) + ldsw + _i * 8192), 16, 0, 0); } while (0)
#define PG8_LDA(dst, b, h) do { _Pragma("unroll") for (int m = 0; m < 4; ++m) _Pragma("unroll") for (int k = 0; k < 2; ++k) dst[m][k] = *(const PG8_LAS bf16x8*)(lds + PG8_SA(b, h) + aoff + m * 2048 + k * 1024); } while (0)
#define PG8_LDB(dst, b, h) do { _Pragma("unroll") for (int n = 0; n < 2; ++n) _Pragma("unroll") for (int k = 0; k < 2; ++k) dst[n][k] = *(const PG8_LAS bf16x8*)(lds + PG8_SB(b, h) + boff + n * 2048 + k * 1024); } while (0)
#define PG8_MMA(ai, bj, At, Bt) do { __builtin_amdgcn_s_setprio(1); _Pragma("unroll") for (int m = 0; m < 4; ++m) _Pragma("unroll") for (int n = 0; n < 2; ++n) _Pragma("unroll") for (int k = 0; k < 2; ++k) \
        acc[ai][bj][m][n] = __builtin_amdgcn_mfma_f32_16x16x32_bf16(Bt[n][k], At[m][k], acc[ai][bj][m][n], 0, 0, 0); __builtin_amdgcn_s_setprio(0); } while (0)
#define PG8_WAIT_V(n) asm volatile("s_waitcnt vmcnt(" #n ")" ::: "memory")
#define PG8_WAIT_L(n) asm volatile("s_waitcnt lgkmcnt(" #n ")" ::: "memory")
#define PG8_BAR __builtin_amdgcn_s_barrier()
#define PG8_SCHED __builtin_amdgcn_sched_barrier(0)
    Unit cur, nxt; int ui = 0;
    if (!S.next(0, cur)) return;
    f32x4 acc[2][2][4][2];
#pragma unroll
    for (int a = 0; a < 2; ++a)
#pragma unroll
        for (int b = 0; b < 2; ++b)
#pragma unroll
            for (int m = 0; m < 4; ++m)
#pragma unroll
                for (int n = 0; n < 2; ++n) acc[a][b][m][n] = (f32x4){0.f, 0.f, 0.f, 0.f};
    bf16x8 At[4][2], B0[2][2], B1[2][2];
    const char* cA = (const char*)g.A + (size_t)cur.pm * tstepA + cur.koff; const char* cB = (const char*)g.Bt + (size_t)cur.pn * tstepB + cur.koff;
    S.a_ready(cur);
    if constexpr (SP2) {
        PG8_STAGE(PG8_SB(0, 0), cB, voffB); PG8_STAGE(PG8_SB(0, 1), cB + hstepB, voffB); PG8_STAGE(PG8_SA(0, 0), cA, voffA); PG8_STAGE(PG8_SA(0, 1), cA + hstepA, voffA);
        if (wr == 1) PG8_BAR;
        PG8_WAIT_V(2); PG8_BAR;
        PG8_STAGE(PG8_SB(1, 0), cB + kstep, voffB); PG8_STAGE(PG8_SA(1, 0), cA + kstep, voffA); PG8_STAGE(PG8_SB(1, 1), cB + hstepB + kstep, voffB);
        PG8_WAIT_V(6); PG8_BAR;
    } else {
        PG8_STAGE(PG8_SB(0, 0), cB, voffB); PG8_STAGE(PG8_SA(0, 0), cA, voffA); PG8_STAGE(PG8_SB(0, 1), cB + hstepB, voffB); PG8_STAGE(PG8_SA(0, 1), cA + hstepA, voffA);
        if (wr == 1) PG8_BAR;
        PG8_WAIT_V(4); PG8_BAR;
        PG8_STAGE(PG8_SB(1, 0), cB + kstep, voffB); PG8_STAGE(PG8_SA(1, 0), cA + kstep, voffA); PG8_STAGE(PG8_SB(1, 1), cB + hstepB + kstep, voffB);
        PG8_WAIT_V(6); PG8_BAR;
    }
    for (;;) {
        const bool has_next = S.next(ui + 1, nxt);
        const char* nA = has_next ? (const char*)g.A + (size_t)nxt.pm * tstepA + nxt.koff : cA; const char* nB = has_next ? (const char*)g.Bt + (size_t)nxt.pn * tstepB + nxt.koff : cB;
        for (int t = 0; t < nt; t += 2) {
            const bool last = (t == nt - 2);
            const char* a1 = cA + (size_t)(t + 1) * kstep;
            const char* a2 = last ? nA : cA + (size_t)(t + 2) * kstep; const char* b2 = last ? nB : cB + (size_t)(t + 2) * kstep;
            const char* a3 = a2 + kstep; const char* b3 = b2 + kstep;
            if (last && has_next) S.a_ready(nxt);
            if constexpr (SP2) {
            PG8_LDB(B0, 0, 0); PG8_LDB(B1, 0, 1); PG8_SCHED; PG8_LDA(At, 0, 0); PG8_STAGE(PG8_SA(1, 1), a1 + hstepA, voffA);
            PG8_WAIT_V(8); PG8_WAIT_L(0); PG8_BAR; PG8_MMA(0, 0, At, B0); PG8_MMA(0, 1, At, B1); PG8_BAR; PG8_SCHED;
            PG8_LDA(At, 0, 1); PG8_STAGE(PG8_SB(0, 0), b2, voffB); PG8_STAGE(PG8_SB(0, 1), b2 + hstepB, voffB); PG8_STAGE(PG8_SA(0, 0), a2, voffA);
            PG8_WAIT_V(8); PG8_WAIT_L(0); PG8_BAR; PG8_MMA(1, 0, At, B0); PG8_MMA(1, 1, At, B1); PG8_BAR; PG8_SCHED;
            PG8_LDB(B0, 1, 0); PG8_LDB(B1, 1, 1); PG8_SCHED; PG8_LDA(At, 1, 0); PG8_STAGE(PG8_SA(0, 1), a2 + hstepA, voffA);
            PG8_WAIT_V(8); PG8_WAIT_L(0); PG8_BAR; PG8_MMA(0, 0, At, B0); PG8_MMA(0, 1, At, B1); PG8_BAR; PG8_SCHED;
            PG8_LDA(At, 1, 1); PG8_STAGE(PG8_SB(1, 0), b3, voffB); PG8_STAGE(PG8_SB(1, 1), b3 + hstepB, voffB); PG8_STAGE(PG8_SA(1, 0), a3, voffA);
            PG8_WAIT_V(8); PG8_WAIT_L(0); PG8_BAR; PG8_MMA(1, 0, At, B0); PG8_MMA(1, 1, At, B1); PG8_BAR; PG8_SCHED;
            } else {
            PG8_LDB(B0, 0, 0); PG8_SCHED; PG8_LDA(At, 0, 0); PG8_STAGE(PG8_SA(1, 1), a1 + hstepA, voffA);
            PG8_WAIT_L(8); PG8_BAR; PG8_WAIT_L(0); PG8_MMA(0, 0, At, B0); PG8_BAR; PG8_SCHED;
            PG8_LDB(B1, 0, 1); PG8_STAGE(PG8_SB(0, 0), b2, voffB);
            PG8_BAR; PG8_WAIT_L(0); PG8_MMA(0, 1, At, B1); PG8_BAR;
            PG8_LDA(At, 0, 1); PG8_STAGE(PG8_SA(0, 0), a2, voffA);
            PG8_BAR; PG8_WAIT_L(0); PG8_MMA(1, 0, At, B0); PG8_BAR; PG8_SCHED;
            PG8_STAGE(PG8_SB(0, 1), b2 + hstepB, voffB);
            PG8_WAIT_V(6); PG8_BAR; PG8_MMA(1, 1, At, B1); PG8_BAR;
            PG8_LDB(B0, 1, 0); PG8_SCHED; PG8_LDA(At, 1, 0); PG8_STAGE(PG8_SA(0, 1), a2 + hstepA, voffA);
            PG8_WAIT_L(8); PG8_BAR; PG8_WAIT_L(0); PG8_MMA(0, 0, At, B0); PG8_BAR; PG8_SCHED;
            PG8_LDB(B1, 1, 1); PG8_STAGE(PG8_SB(1, 0), b3, voffB);
            PG8_BAR; PG8_WAIT_L(0); PG8_MMA(0, 1, At, B1); PG8_BAR;
            PG8_LDA(At, 1, 1); PG8_STAGE(PG8_SA(1, 0), a3, voffA);
            PG8_BAR; PG8_WAIT_L(0); PG8_MMA(1, 0, At, B0); PG8_BAR; PG8_SCHED;
            PG8_STAGE(PG8_SB(1, 1), b3 + hstepB, voffB);
            PG8_WAIT_V(6); PG8_BAR; PG8_MMA(1, 1, At, B1); PG8_BAR;
            }
        }
        if constexpr (ALIGN_EPI) { if (wr == 0) PG8_BAR; }
        if constexpr (!Epi::AFTER_DRAIN) { E(acc, cur, wr, wc, fr, fq); S.done(cur); }
        if (!has_next) break;
#pragma unroll
        for (int a = 0; a < 2; ++a)
#pragma unroll
            for (int b = 0; b < 2; ++b)
#pragma unroll
                for (int m = 0; m < 4; ++m)
#pragma unroll
                    for (int n = 0; n < 2; ++n) acc[a][b][m][n] = (f32x4){0.f, 0.f, 0.f, 0.f};
        cur = nxt; cA = nA; cB = nB; ++ui;
        if constexpr (ALIGN_EPI) { if (wr == 1) PG8_BAR; }
    }
    PG8_WAIT_V(0);
    if constexpr (!ALIGN_EPI) { if (wr == 0) PG8_BAR; }
    PG8_BAR;
    if constexpr (Epi::AFTER_DRAIN) { E.fused(acc, cur, wr, wc, fr, fq, lds, wid, lane); S.done(cur); }
#undef PG8_SA
#undef PG8_SB
#undef PG8_STAGE
#undef PG8_LDA
#undef PG8_LDB
#undef PG8_MMA
#undef PG8_WAIT_V
#undef PG8_WAIT_L
#undef PG8_BAR
#undef PG8_SCHED
}
}

constexpr int T = 32768, S = 2048, DM = 1024, NIN = 2560, FF = 4096;
constexpr float EPS = 1e-6f;
constexpr float QSCALE = 0.125f * 1.4426950408889634f;
constexpr size_t MiB = 1u << 20;
constexpr size_t WS_WIN = 1 * MiB, WS_WOUT = 6 * MiB, WS_WFF1 = 8 * MiB, WS_WFF2 = 16 * MiB, WS_W1T = 24 * MiB;
constexpr size_t WS_WSP = 26 * MiB + 768 * 1024;
constexpr size_t WS_C1 = 26 * MiB, WS_ROPEC = 26 * MiB + 64 * 1024, WS_ROPES = 26 * MiB + 320 * 1024;
constexpr size_t WS_RINV1 = 27 * MiB, WS_SSQP = 27 * MiB + 512 * 1024, WS_GATES = 30 * MiB;
constexpr size_t WS_KCMP = 33 * MiB, WS_VCMPT = 33 * MiB + 512 * 1024, WS_HID = 34 * MiB, WS_X2B = 38 * MiB;
constexpr size_t WS_XB = 102 * MiB, WS_QN = 166 * MiB, WS_QR = 198 * MiB, WS_KC = 230 * MiB, WS_VC = 238 * MiB;
constexpr size_t WS_KSL = 246 * MiB, WS_VSLT = 254 * MiB, WS_KWN = 262 * MiB, WS_VWNT = 270 * MiB, WS_ZU = 278 * MiB, WS_ZVT = 310 * MiB, WS_O = 342 * MiB;
constexpr size_t WS_H = 102 * MiB, WS_END = 406 * MiB;
constexpr size_t WS_PART = WS_X2B;
constexpr size_t WS_C1P = 26 * MiB + 576 * 1024;
constexpr int LDS_BYTES = 147456;
constexpr int NWAVES = 8;

struct Args { const float* in[16]; float* out; unsigned char* ws; int ph_lo, ph_hi; };

__device__ __forceinline__ float bf2f(bf16_t h) { return __uint_as_float(((unsigned)h) << 16); }
__device__ __forceinline__ unsigned f2bf(float f) { unsigned u = __float_as_uint(f); return (u + 0x7fffu + ((u >> 16) & 1u)) >> 16; }
__device__ __forceinline__ unsigned pk2(float lo, float hi) { return pg8::cvt_pk_bf16(lo, hi); }
__device__ __forceinline__ float wave_sum(float v) {
#pragma unroll
    for (int o = 1; o < 64; o <<= 1) v += __shfl_xor(v, o);
    return v;
}
__device__ __forceinline__ float wave_max(float v) {
#pragma unroll
    for (int o = 1; o < 64; o <<= 1) v = fmaxf(v, __shfl_xor(v, o));
    return v;
}
__device__ __forceinline__ float gelu_tanh(float x) {
    const float u = 0.7978845608028654f * (x + 0.044715f * x * x * x);
    return x / (1.f + __expf(-2.f * u));
}
__device__ __forceinline__ void store8(bf16_t* p, const float* v) {
    u32x4 w; w.x = pk2(v[0], v[1]); w.y = pk2(v[2], v[3]); w.z = pk2(v[4], v[5]); w.w = pk2(v[6], v[7]);
    *(u32x4*)p = w;
}
__device__ __forceinline__ void load8(const bf16_t* p, float* v) {
    const u32x4 w = *(const u32x4*)p;
    v[0] = __uint_as_float(w.x << 16); v[1] = __uint_as_float(w.x & 0xffff0000u);
    v[2] = __uint_as_float(w.y << 16); v[3] = __uint_as_float(w.y & 0xffff0000u);
    v[4] = __uint_as_float(w.z << 16); v[5] = __uint_as_float(w.z & 0xffff0000u);
    v[6] = __uint_as_float(w.w << 16); v[7] = __uint_as_float(w.w & 0xffff0000u);
}
__device__ __forceinline__ float head_ssq(const float (&v)[16]) {
    float s = 0.f;
#pragma unroll
    for (int i = 0; i < 16; ++i) s += v[i] * v[i];
    s += __shfl_xor(s, 16); s += __shfl_xor(s, 32);
    return s;
}

struct EpiInProj {
    static constexpr bool PERM = true, AFTER_DRAIN = false;
    const float *rinv1, *g_q, *g_k, *g_sgu, *ropec, *ropes;
    bf16_t *qn, *qr, *kc, *vc, *ksl, *vslT, *kwn, *vwnT, *zu, *zvT; float* gates;
    __device__ __forceinline__ void operator()(const f32x4 (&acc)[2][2][4][2], const pg8::Unit& u, int wr, int wc, int fr, int fq) const {
        const int cs = u.pn * 4 + wc;
        if (cs >= 37) return;
        const int d0 = 8 * fq;
        float rsv[2][4];
#pragma unroll
        for (int ai = 0; ai < 2; ++ai)
#pragma unroll
            for (int m = 0; m < 4; ++m) rsv[ai][m] = rinv1[u.pm * 256 + ai * 128 + wr * 64 + m * 16 + fr];
#pragma unroll
        for (int ai = 0; ai < 2; ++ai)
#pragma unroll
            for (int m = 0; m < 4; ++m) {
                const int row = u.pm * 256 + ai * 128 + wr * 64 + m * 16 + fr;
                const float rs = rsv[ai][m];
                float v[16];
#pragma unroll
                for (int bj = 0; bj < 2; ++bj)
#pragma unroll
                    for (int n = 0; n < 2; ++n)
#pragma unroll
                        for (int e = 0; e < 4; ++e) v[bj * 8 + n * 4 + e] = acc[ai][bj][m][n][e] * rs;
                const int b = row >> 11, s = row & 2047;
                if (cs < 8 || cs == 12 || cs == 13 || cs == 16 || cs == 17) {
                    const float* gg = cs < 8 ? g_q : (cs < 14 ? g_k + 64 : g_k + 128);
                    const float rn = rsqrtf(head_ssq(v) * (1.f / 64.f) + EPS) * (cs < 8 ? QSCALE : 1.f);
                    float y[16];
#pragma unroll
                    for (int i = 0; i < 16; ++i) y[i] = v[i] * rn * gg[32 * (i >> 3) + d0 + (i & 7)];
                    float r1[8], r2[8];
#pragma unroll
                    for (int i = 0; i < 8; ++i) { int di = d0 + i; asm volatile("" : "+v"(di));
                        const float frev = __builtin_amdgcn_exp2f(-(float)di * (13.287712379549449f / 32.f)) * 0.15915494309189535f;
                        float xr = (float)s * frev; xr -= __builtin_rintf(xr);
                        const float c = __builtin_amdgcn_cosf(xr), sn = __builtin_amdgcn_sinf(xr); r1[i] = y[i] * c - y[8 + i] * sn; r2[i] = y[8 + i] * c + y[i] * sn; }
                    if (cs < 8) {
                        bf16_t* p = qn + (size_t)row * 512 + cs * 64 + d0; store8(p, y); store8(p + 32, y + 8);
                        bf16_t* p2 = qr + (size_t)row * 512 + cs * 64 + d0; store8(p2, r1); store8(p2 + 32, r2);
                    } else {
                        bf16_t* p = (cs < 14 ? ksl : kwn) + ((size_t)(b * 2 + (cs & 1)) * 2048 + s) * 64 + d0; store8(p, r1); store8(p + 32, r2);
                    }
                } else if (cs < 12) {
                    bf16_t* p = (cs < 10 ? kc : vc) + ((size_t)(b * 2 + (cs & 1)) * 2048 + s) * 64 + d0; store8(p, v); store8(p + 32, v + 8);
                } else if (cs < 20) {
                    bf16_t* p = (cs < 16 ? vslT : vwnT) + ((size_t)(b * 2 + (cs & 1)) * 32 + (s >> 6)) * 4096 + (s & 63);
#pragma unroll
                    for (int i = 0; i < 16; ++i) p[(32 * (i >> 3) + d0 + (i & 7)) * 64] = (bf16_t)f2bf(v[i]);
                } else if (cs < 28) {
                    float y[16];
#pragma unroll
                    for (int i = 0; i < 16; ++i) y[i] = gelu_tanh(v[i]);
                    bf16_t* p = zu + (size_t)row * 512 + (cs - 20) * 64 + d0; store8(p, y); store8(p + 32, y + 8);
                } else if (cs < 36) {
                    const int g = cs - 28;
                    float y[16];
#pragma unroll
                    for (int i = 0; i < 16; ++i) y[i] = gelu_tanh(v[i]);
                    const float rn = rsqrtf(head_ssq(y) * (1.f / 64.f) + EPS);
                    bf16_t* p = zvT + (((size_t)b * 16 + (s >> 7)) * 8 + g) * 8192 + (s & 127);
#pragma unroll
                    for (int i = 0; i < 16; ++i) { const int d = 32 * (i >> 3) + d0 + (i & 7); p[d * 128] = (bf16_t)f2bf(y[i] * rn * g_sgu[g * 64 + d]); }
                } else {
                    if (fq < 3) {
#pragma unroll
                        for (int i = 0; i < 8; ++i) gates[(size_t)row * 24 + d0 + i] = 1.f / (1.f + __expf(-v[i]));
                    }
                }
            }
    }
};

struct EpiPart {
    static constexpr bool PERM = true, AFTER_DRAIN = false;
    float* part;
    __device__ __forceinline__ void operator()(const f32x4 (&acc)[2][2][4][2], const pg8::Unit& u, int wr, int wc, int fr, int fq) const {
        float* base = part + (size_t)(u.koff >> 10) * 8192 * 256;
#pragma unroll
        for (int ai = 0; ai < 2; ++ai)
#pragma unroll
            for (int m = 0; m < 4; ++m) {
                const int row = u.pm * 256 + ai * 128 + wr * 64 + m * 16 + fr;
#pragma unroll
                for (int bj = 0; bj < 2; ++bj) {
                    float* p = base + (size_t)row * 256 + 128 * bj + 32 * wc + 8 * fq;
                    *(f32x4*)p = acc[ai][bj][m][0]; *(f32x4*)(p + 4) = acc[ai][bj][m][1];
                }
            }
    }
};

struct EpiWout {
    static constexpr bool PERM = true, AFTER_DRAIN = false;
    const bf16_t* xb; bf16_t* x2b; float* ssqp; LAS float* red;
    __device__ __forceinline__ void operator()(const f32x4 (&acc)[2][2][4][2], const pg8::Unit& u, int wr, int wc, int fr, int fq) const {
        u32x4 xr[2][4][2];
#pragma unroll
        for (int ai = 0; ai < 2; ++ai)
#pragma unroll
            for (int m = 0; m < 4; ++m)
#pragma unroll
                for (int bj = 0; bj < 2; ++bj)
                    xr[ai][m][bj] = *(const u32x4*)(xb + (size_t)(u.pm * 256 + ai * 128 + wr * 64 + m * 16 + fr) * DM + u.pn * 256 + 128 * bj + 32 * wc + 8 * fq);
        __builtin_amdgcn_sched_barrier(0);
#pragma unroll
        for (int ai = 0; ai < 2; ++ai)
#pragma unroll
            for (int m = 0; m < 4; ++m) {
                const int row = u.pm * 256 + ai * 128 + wr * 64 + m * 16 + fr;
                float ss = 0.f;
#pragma unroll
                for (int bj = 0; bj < 2; ++bj) {
                    const size_t off = (size_t)row * DM + u.pn * 256 + 128 * bj + 32 * wc + 8 * fq;
                    const u32x4 w = xr[ai][m][bj];
                    float y[8];
                    y[0] = __uint_as_float(w.x << 16) + acc[ai][bj][m][0].x; y[1] = __uint_as_float(w.x & 0xffff0000u) + acc[ai][bj][m][0].y;
                    y[2] = __uint_as_float(w.y << 16) + acc[ai][bj][m][0].z; y[3] = __uint_as_float(w.y & 0xffff0000u) + acc[ai][bj][m][0].w;
                    y[4] = __uint_as_float(w.z << 16) + acc[ai][bj][m][1].x; y[5] = __uint_as_float(w.z & 0xffff0000u) + acc[ai][bj][m][1].y;
                    y[6] = __uint_as_float(w.w << 16) + acc[ai][bj][m][1].z; y[7] = __uint_as_float(w.w & 0xffff0000u) + acc[ai][bj][m][1].w;
                    store8(x2b + off, y);
#pragma unroll
                    for (int i = 0; i < 8; ++i) ss += y[i] * y[i];
                }
                ss += __shfl_xor(ss, 16); ss += __shfl_xor(ss, 32);
                if (fq == 0) red[wc * 256 + (row & 255)] = ss;
            }
        __syncthreads();
        { const int tid = threadIdx.x;
          if (tid < 256) ssqp[(size_t)(u.pm * 256 + tid) * 4 + u.pn] = (red[tid] + red[256 + tid]) + (red[512 + tid] + red[768 + tid]); }
    }
};

struct EpiFF1 {
    static constexpr bool PERM = true, AFTER_DRAIN = false;
    const float* ssqp; bf16_t* H;
    __device__ __forceinline__ void operator()(const f32x4 (&acc)[2][2][4][2], const pg8::Unit& u, int wr, int wc, int fr, int fq) const {
        f32x4 sq[2][4];
#pragma unroll
        for (int ai = 0; ai < 2; ++ai)
#pragma unroll
            for (int m = 0; m < 4; ++m) sq[ai][m] = *(const f32x4*)(ssqp + (size_t)(u.pm * 256 + ai * 128 + wr * 64 + m * 16 + fr) * 4);
        __builtin_amdgcn_sched_barrier(0);
#pragma unroll
        for (int ai = 0; ai < 2; ++ai)
#pragma unroll
            for (int m = 0; m < 4; ++m) {
                const int row = u.pm * 256 + ai * 128 + wr * 64 + m * 16 + fr;
                const float tot = (sq[ai][m].x + sq[ai][m].y) + (sq[ai][m].z + sq[ai][m].w);
                const float rn = rsqrtf(tot * (1.f / 1024.f) + EPS);
#pragma unroll
                for (int bj = 0; bj < 2; ++bj) {
                    float y[8];
#pragma unroll
                    for (int n = 0; n < 2; ++n)
#pragma unroll
                        for (int e = 0; e < 4; ++e) { const float h = fmaxf(acc[ai][bj][m][n][e] * rn, 0.f); y[n * 4 + e] = h * h; }
                    store8(H + (size_t)row * FF + u.pn * 256 + 128 * bj + 32 * wc + 8 * fq, y);
                }
            }
    }
};

struct EpiFF2 {
    static constexpr bool PERM = true, AFTER_DRAIN = false;
    const bf16_t* x2b; float* out;
    __device__ __forceinline__ void operator()(const f32x4 (&acc)[2][2][4][2], const pg8::Unit& u, int wr, int wc, int fr, int fq) const {
        u32x4 xr[2][4][2];
#pragma unroll
        for (int ai = 0; ai < 2; ++ai)
#pragma unroll
            for (int m = 0; m < 4; ++m)
#pragma unroll
                for (int bj = 0; bj < 2; ++bj)
                    xr[ai][m][bj] = *(const u32x4*)(x2b + (size_t)(u.pm * 256 + ai * 128 + wr * 64 + m * 16 + fr) * DM + u.pn * 256 + 128 * bj + 32 * wc + 8 * fq);
        __builtin_amdgcn_sched_barrier(0);
#pragma unroll
        for (int ai = 0; ai < 2; ++ai)
#pragma unroll
            for (int m = 0; m < 4; ++m) {
                const int row = u.pm * 256 + ai * 128 + wr * 64 + m * 16 + fr;
#pragma unroll
                for (int bj = 0; bj < 2; ++bj) {
                    const size_t off = (size_t)row * DM + u.pn * 256 + 128 * bj + 32 * wc + 8 * fq;
                    const u32x4 w = xr[ai][m][bj];
                    f32x4 ya = acc[ai][bj][m][0], yb = acc[ai][bj][m][1];
                    ya.x += __uint_as_float(w.x << 16); ya.y += __uint_as_float(w.x & 0xffff0000u); ya.z += __uint_as_float(w.y << 16); ya.w += __uint_as_float(w.y & 0xffff0000u);
                    yb.x += __uint_as_float(w.z << 16); yb.y += __uint_as_float(w.z & 0xffff0000u); yb.z += __uint_as_float(w.w << 16); yb.w += __uint_as_float(w.w & 0xffff0000u);
                    *(f32x4*)(out + off) = ya; *(f32x4*)(out + off + 4) = yb;
                }
            }
    }
};

__device__ __forceinline__ int win_src_col(int nphys) {
    const int pn = nphys >> 8, Pp = nphys & 255, bj = Pp >> 7, wc = (Pp & 127) >> 5, r = Pp & 31;
    const int lc = (pn << 8) + 64 * wc + 32 * bj + r;
    if (lc < 1280) return lc;
    if (lc < 2304) return lc + 24;
    if (lc < 2328) return lc - 1024;
    return -1;
}
template <int MAP>
__device__ __forceinline__ void transpose_item(const float* W, int K, int N, bf16_t* WT, const float* gk, LAS float* scr, int item, int nblk, int lane) {
    const int kb = item / nblk, nb = item % nblk, k0 = 64 * kb, n0 = 32 * nb;
    const int src = MAP ? win_src_col(n0 + (lane & 31)) : n0 + (lane & 31);
    float tv[32];
#pragma unroll
    for (int i = 0; i < 32; ++i) { const int kk = 2 * i + (lane >> 5); tv[i] = (src >= 0) ? __builtin_nontemporal_load(W + (size_t)(k0 + kk) * N + src) : 0.f; }
    if (gk) {
#pragma unroll
        for (int i = 0; i < 32; ++i) tv[i] *= gk[k0 + 2 * i + (lane >> 5)]; }
#pragma unroll
    for (int i = 0; i < 32; ++i) scr[(2 * i + (lane >> 5)) * 33 + (lane & 31)] = tv[i];
    asm volatile("s_waitcnt lgkmcnt(0)" ::: "memory");
    const int c = lane & 7;
#pragma unroll
    for (int j = 0; j < 4; ++j) { const int n = (lane >> 3) + 8 * j; const LAS float* s = scr + (8 * c) * 33 + n;
        u32x4 o; o.x = pk2(s[0 * 33], s[1 * 33]); o.y = pk2(s[2 * 33], s[3 * 33]); o.z = pk2(s[4 * 33], s[5 * 33]); o.w = pk2(s[6 * 33], s[7 * 33]);
        *(u32x4*)(WT + (size_t)(n0 + n) * K + k0 + 8 * c) = o; }
    asm volatile("s_waitcnt lgkmcnt(0)" ::: "memory");
}

__device__ __forceinline__ void phase0(const Args& a, LAS unsigned char* lds) {
    const int tid = threadIdx.x, lane = tid & 63, wave = tid >> 6;
    unsigned char* ws = a.ws;
    LAS float* scr = (LAS float*)(lds + wave * 16384);
    const int gw = blockIdx.x * NWAVES + wave, NGW = gridDim.x * NWAVES;
    constexpr int I_IN = 16 * 80, I_C = 32 * 8;
    constexpr int NITEMS = I_IN + 2 * I_C;
    for (int it = gw; it < NITEMS; it += NGW) {
        int r = it;
        if (r < I_IN) { transpose_item<1>(a.in[2], 1024, 2328, (bf16_t*)(ws + WS_WIN), a.in[1], scr, r, 80, lane); continue; } r -= I_IN;
        if (r < I_C) { transpose_item<0>(a.in[6], 2048, 256, (bf16_t*)(ws + WS_W1T), nullptr, scr, r, 8, lane); continue; } r -= I_C;
        transpose_item<0>(a.in[6] + (size_t)2048 * 256, 2048, 256, (bf16_t*)(ws + WS_W1T) + (size_t)256 * 2048, nullptr, scr, r, 8, lane);
    }
    {
        const float* x = a.in[0]; bf16_t* xb = (bf16_t*)(ws + WS_XB); float* rinv1 = (float*)(ws + WS_RINV1);
        for (int m = gw; m < T; m += 2 * NGW) {
            const int m2 = m + NGW;
            const bool has2 = m2 < T;
            const f32x4* xr = (const f32x4*)(x + (size_t)m * DM) + lane;
            const f32x4* xr2 = (const f32x4*)(x + (size_t)(has2 ? m2 : m) * DM) + lane;
            f32x4 v[4], u[4]; float s = 0.f, s2 = 0.f;
#pragma unroll
            for (int j = 0; j < 4; ++j) { v[j] = __builtin_nontemporal_load(xr + 64 * j); u[j] = __builtin_nontemporal_load(xr2 + 64 * j); }
#pragma unroll
            for (int j = 0; j < 4; ++j) { s += (v[j].x * v[j].x + v[j].y * v[j].y) + (v[j].z * v[j].z + v[j].w * v[j].w); s2 += (u[j].x * u[j].x + u[j].y * u[j].y) + (u[j].z * u[j].z + u[j].w * u[j].w); }
            s = wave_sum(s); s2 = wave_sum(s2);
            if (lane == 0) { rinv1[m] = rsqrtf(s * (1.f / 1024.f) + EPS); if (has2) rinv1[m2] = rsqrtf(s2 * (1.f / 1024.f) + EPS); }
            unsigned long long* o8 = (unsigned long long*)(xb + (size_t)m * DM) + lane;
#pragma unroll
            for (int j = 0; j < 4; ++j) o8[64 * j] = (unsigned long long)pk2(v[j].x, v[j].y) | ((unsigned long long)pk2(v[j].z, v[j].w) << 32);
            if (has2) { unsigned long long* o82 = (unsigned long long*)(xb + (size_t)m2 * DM) + lane;
#pragma unroll
                for (int j = 0; j < 4; ++j) o82[64 * j] = (unsigned long long)pk2(u[j].x, u[j].y) | ((unsigned long long)pk2(u[j].z, u[j].w) << 32); }
        }
    }
    {
        bf16_t* Wsp = (bf16_t*)(ws + WS_WSP); const float* spw = a.in[9];
        for (int idx = blockIdx.x * 512 + tid; idx < 8 * 128 * 128; idx += gridDim.x * 512) { const int tq = (idx >> 7) & 127, sq = idx & 127; Wsp[idx] = (bf16_t)f2bf(sq <= tq ? spw[idx] : 0.f); }
    }
    {
        if ((gw & 3) == 0 && (gw >> 2) < 512) {
            const int item = gw >> 2, kv = item >> 8, cg4 = (item >> 6) & 3, kch = item & 63;
            const float* pe = a.in[5] + kv * 2048 + kch * 32; const float* w1 = a.in[6] + ((size_t)kv * 2048 + kch * 32) * 256 + cg4 * 64 + lane;
            float wv[32];
#pragma unroll
            for (int k = 0; k < 32; ++k) wv[k] = w1[(size_t)k * 256];
            float acc = 0.f;
#pragma unroll
            for (int k = 0; k < 32; ++k) acc += pe[k] * wv[k];
            ((float*)(ws + WS_C1P))[kch * 512 + kv * 256 + cg4 * 64 + lane] = acc;
        }
    }
}

__device__ __forceinline__ void phase3(const Args& a, LAS unsigned char* lds) {
    const int tid = threadIdx.x, lane = tid & 63, wave = tid >> 6;
    unsigned char* ws = a.ws;
    const float* part = (const float*)(ws + WS_PART); const float* c1p = (const float*)(ws + WS_C1P);
    bf16_t* kcmp = (bf16_t*)(ws + WS_KCMP); bf16_t* vcmpT = (bf16_t*)(ws + WS_VCMPT);
    LAS float* w2s = (LAS float*)lds;
    LAS float* c1s = w2s + 256 * 64;
    LAS float* hids = c1s + 256;
    const int nchunk = 8192 / 32;
    for (int item = blockIdx.x; item < nchunk; item += gridDim.x) {
        const int kv = (item * 32) >> 12;
        __syncthreads();
        { const f32x4* src = (const f32x4*)(a.in[7] + (size_t)kv * 256 * 64);
#pragma unroll
          for (int i = 0; i < 8; ++i) ((LAS f32x4*)w2s)[tid + 512 * i] = src[tid + 512 * i]; }
        if (tid < 256) { float t = 0.f;
#pragma unroll
            for (int kch = 0; kch < 64; ++kch) t += c1p[kch * 512 + kv * 256 + tid];
            c1s[tid] = t; }
        __syncthreads();
#pragma unroll 1
        for (int rr = 0; rr < 4; ++rr) {
            const int R = item * 32 + wave * 4 + rr, bh = (R >> 7) & 31, n = R & 127;
            f32x4 h4 = *(const LAS f32x4*)(c1s + 4 * lane);
#pragma unroll
            for (int kc = 0; kc < 4; ++kc) h4 += *(const f32x4*)(part + ((size_t)kc * 8192 + R) * 256 + 4 * lane);
            h4.x = gelu_tanh(h4.x); h4.y = gelu_tanh(h4.y); h4.z = gelu_tanh(h4.z); h4.w = gelu_tanh(h4.w);
            *(LAS f32x4*)(hids + wave * 256 + 4 * lane) = h4;
            asm volatile("s_waitcnt lgkmcnt(0)" ::: "memory");
            float acc = 0.f;
#pragma unroll 8
            for (int c = 0; c < 256; ++c) acc += hids[wave * 256 + c] * w2s[c * 64 + lane];
            if (kv == 0) {
                const float ss = wave_sum(acc * acc);
                const float y = acc * rsqrtf(ss * (1.f / 64.f) + EPS) * a.in[4][lane];
                kcmp[((size_t)bh * 128 + n) * 64 + lane] = (bf16_t)f2bf(n < 127 ? y : 0.f);
            } else {
                vcmpT[((size_t)bh * 64 + lane) * 128 + n] = (bf16_t)f2bf(n < 127 ? acc : 0.f);
            }
        }
    }
    {
        LAS float* scr = (LAS float*)(lds + 77824 + wave * 8704);
        const int gw = blockIdx.x * NWAVES + wave, NGW = gridDim.x * NWAVES;
        constexpr int I_O = 16 * 32, I_1 = 16 * 128, I_2 = 64 * 32;
        for (int it = gw; it < I_O + I_1 + I_2; it += NGW) {
            int r = it;
            if (r < I_O) { transpose_item<0>(a.in[12], 1024, 1024, (bf16_t*)(ws + WS_WOUT), a.in[11], scr, r, 32, lane); continue; } r -= I_O;
            if (r < I_1) { transpose_item<0>(a.in[14], 1024, 4096, (bf16_t*)(ws + WS_WFF1), a.in[13], scr, r, 128, lane); continue; } r -= I_1;
            transpose_item<0>(a.in[15], 4096, 1024, (bf16_t*)(ws + WS_WFF2), nullptr, scr, r, 32, lane);
        }
    }
}

typedef short bf16x8_t __attribute__((ext_vector_type(8)));
typedef short s16x4_t __attribute__((ext_vector_type(4)));
typedef float f32x16 __attribute__((ext_vector_type(16)));
typedef __bf16 bf16x2_t __attribute__((ext_vector_type(2)));
typedef float f32x2_t __attribute__((ext_vector_type(2)));
typedef unsigned u32x2 __attribute__((ext_vector_type(2)));
#define MFMA32(a, b, c) __builtin_amdgcn_mfma_f32_32x32x16_bf16((a), (b), (c), 0, 0, 0)
__device__ __forceinline__ unsigned cvtpk(float lo, float hi) { f32x2_t v = {lo, hi}; bf16x2_t b = __builtin_convertvector(v, bf16x2_t); return __builtin_bit_cast(unsigned, b); }
__device__ __forceinline__ float ex2(float x) { return __builtin_amdgcn_exp2f(x); }
__device__ __forceinline__ f32x16 zero16() { f32x16 z;
#pragma unroll
    for (int i = 0; i < 16; ++i) z[i] = 0.f; return z; }
__device__ __forceinline__ bf16x8_t pack8(const f32x16& x, int s8) {
    u32x4 w; w.x = cvtpk(x[s8 + 0], x[s8 + 1]); w.y = cvtpk(x[s8 + 2], x[s8 + 3]); w.z = cvtpk(x[s8 + 4], x[s8 + 5]); w.w = cvtpk(x[s8 + 6], x[s8 + 7]);
    return __builtin_bit_cast(bf16x8_t, w);
}
constexpr int A_KSTR = 144, A_VSTR = 136, A_CVSTR = 264, A_IMPSTR = 33;
constexpr int A_KT = 128 * A_KSTR, A_VT = 64 * A_CVSTR;
constexpr int A_KBUF = 0, A_VBUF = 2 * A_KT, A_CMPK = A_VBUF + 2 * A_VT, A_CMPV = A_CMPK + 18432, A_IMP = A_CMPV + 16896, A_SELM = A_IMP + 4 * 64 * A_IMPSTR * 4, A_SSQ = A_SELM + 256, A_END = A_SSQ + 4096;
static_assert(A_END <= LDS_BYTES - 64, "attention LDS map");

template <int MODE>
__device__ __forceinline__ void attn_tile(const LAS unsigned char* Kb, const LAS unsigned char* Vb, const bf16x8_t (&qf)[4], f32x16 (&oacc)[2], float& l_run,
                                          int r, int h, int dlt0, int dlt1, bool hiw) {
    const unsigned ulim = (MODE == 0) ? 0x80000000u : 512u;
    float ls = 0.f;
#pragma unroll
    for (int mt = 0; mt < 4; ++mt) {
        if (mt == 0) { if (hiw) __builtin_amdgcn_s_setprio(1); else __builtin_amdgcn_s_setprio(0); }
        if (mt == 2) { if (hiw) __builtin_amdgcn_s_setprio(0); else __builtin_amdgcn_s_setprio(1); }
        const int dl = mt < 2 ? dlt0 : dlt1;
        f32x16 sacc = zero16();
#pragma unroll
        for (int ks = 0; ks < 4; ++ks) { const bf16x8_t ka = *(const LAS bf16x8_t*)(Kb + (32 * mt + r) * A_KSTR + 32 * ks + 16 * h); sacc = MFMA32(ka, qf[ks], sacc); }
#pragma unroll
        for (int i = 0; i < 16; ++i) {
            float p;
            if (MODE == 2) p = ex2(sacc[i]);
            else if (MODE == 3) p = ex2(sacc[i] + __int_as_float(dl));
            else { const int ci = 32 * mt + (i & 3) + 8 * (i >> 2); p = ((unsigned)(dl - ci) < ulim) ? ex2(sacc[i]) : 0.f; }
            sacc[i] = p; ls += p;
        }
#pragma unroll
        for (int s = 0; s < 2; ++s) {
            const bf16x8_t pf = pack8(sacc, 8 * s);
#pragma unroll
            for (int dt = 0; dt < 2; ++dt) {
                const LAS unsigned char* vp = Vb + (32 * dt + r) * A_CVSTR + (32 * mt + 16 * s + 4 * h) * 2;
                const s16x4_t lo = *(const LAS s16x4_t*)vp, hi = *(const LAS s16x4_t*)(vp + 16);
                oacc[dt] = MFMA32(__builtin_shufflevector(lo, hi, 0, 1, 2, 3, 4, 5, 6, 7), pf, oacc[dt]);
            }
        }
    }
    l_run += ls;
}

__device__ __forceinline__ void phase4_attn(const Args& a, LAS unsigned char* lds) {
    const int tid0 = threadIdx.x, w = __builtin_amdgcn_readfirstlane(tid0 >> 6), g = w >> 1, half = w & 1;
    unsigned char* ws = a.ws;
    const bf16_t* qn = (const bf16_t*)(ws + WS_QN); const bf16_t* qr = (const bf16_t*)(ws + WS_QR);
    const bf16_t* kcmp = (const bf16_t*)(ws + WS_KCMP); const bf16_t* vcmpT = (const bf16_t*)(ws + WS_VCMPT);
    const bf16_t* ksl = (const bf16_t*)(ws + WS_KSL); const bf16_t* vslT = (const bf16_t*)(ws + WS_VSLT);
    const bf16_t* kwn = (const bf16_t*)(ws + WS_KWN); const bf16_t* vwnT = (const bf16_t*)(ws + WS_VWNT);
    const float* gates = (const float*)(ws + WS_GATES);
    bf16_t* o = (bf16_t*)(ws + WS_O);
    LAS float* IMP = (LAS float*)(lds + A_IMP); LAS unsigned* SELM = (LAS unsigned*)(lds + A_SELM); LAS float* SSQ = (LAS float*)(lds + A_SSQ);
    for (int pr = blockIdx.x; pr < 256; pr += gridDim.x) {
        const int b = pr >> 4, tt0 = pr & 15;
#pragma unroll 1
        for (int it = 0; it < 2; ++it) {
            const int t = it ? 31 - tt0 : tt0;
            f32x16 comb[2][2];
#pragma unroll
            for (int hkv = 0; hkv < 2; ++hkv) {
                const int bh = b * 2 + hkv, head = hkv * 4 + g;
                int tid = tid0; asm volatile("" : "+v"(tid));
                const int lane = tid & 63, r = lane & 31, h = lane >> 5, ql = 32 * half + r, pos = 64 * t + ql, tok = b * 2048 + pos;
                comb[hkv][0] = zero16(); comb[hkv][1] = zero16();
                const float g0 = gates[(size_t)tok * 24 + head * 3 + 0], g1 = gates[(size_t)tok * 24 + head * 3 + 1], g2 = gates[(size_t)tok * 24 + head * 3 + 2];
                __syncthreads();
                {
                    const bf16_t* kc = kcmp + (size_t)bh * 128 * 64; const bf16_t* vc = vcmpT + (size_t)bh * 64 * 128;
#pragma unroll
                    for (int i = 0; i < 2; ++i) { const int c = tid + 512 * i;
                        const u32x4 kv = *(const u32x4*)(kc + (size_t)c * 8);
                        *(LAS u32x4*)(lds + A_CMPK + (c >> 3) * A_KSTR + (c & 7) * 16) = kv;
                        const u32x4 vv = *(const u32x4*)(vc + (size_t)c * 8);
                        LAS unsigned char* vp = lds + A_CMPV + (c >> 4) * A_CVSTR + (c & 15) * 16;
                        *(LAS u32x2*)vp = (u32x2){vv.x, vv.y}; *(LAS u32x2*)(vp + 8) = (u32x2){vv.z, vv.w}; }
                }
                bf16x8_t qf[4];
#pragma unroll
                for (int ks = 0; ks < 4; ++ks) qf[ks] = __builtin_nontemporal_load((const bf16x8_t*)(qn + (size_t)tok * 512 + head * 64 + 16 * ks + 8 * h));
                __syncthreads();
                {
                    f32x16 s4[4];
#pragma unroll
                    for (int mt = 0; mt < 4; ++mt) { s4[mt] = zero16();
#pragma unroll
                        for (int ks = 0; ks < 4; ++ks) { const bf16x8_t ka = *(const LAS bf16x8_t*)(lds + A_CMPK + (32 * mt + r) * A_KSTR + 32 * ks + 16 * h); s4[mt] = MFMA32(ka, qf[ks], s4[mt]); } }
                    const int clim = (pos - 31 - 64 * h) >> 4;
                    float ls = 0.f;
#pragma unroll
                    for (int mt = 0; mt < 4; ++mt)
#pragma unroll
                        for (int i = 0; i < 16; ++i) { const int ci = 32 * mt + (i & 3) + 8 * (i >> 2);
                            const float p = (ci <= clim) ? ex2(s4[mt][i]) : 0.f; s4[mt][i] = p; ls += p; }
                    ls += __shfl_xor(ls, 32);
                    const float inv = 1.f / fmaxf(ls, 1e-20f);
#pragma unroll
                    for (int mt = 0; mt < 4; ++mt) s4[mt] *= inv;
                    if (t >= 16) {
                        float oprev = 0.f;
#pragma unroll
                        for (int idx = 0; idx < 16; ++idx) {
                            const int mt = idx >> 2, ap = idx & 3;
                            const float tail = 0.5f * s4[mt][4 * ap + 3];
                            const float ot = __shfl_xor(tail, 32);
                            const float inner = s4[mt][4 * ap] + s4[mt][4 * ap + 1] + s4[mt][4 * ap + 2] + tail;
                            const float prev = h ? ot : oprev;
                            oprev = ot;
                            IMP[(g * 64 + ql) * A_IMPSTR + 8 * mt + 2 * ap + h] = inner + prev;
                        }
                    }
                    f32x16 oc[2]; oc[0] = zero16(); oc[1] = zero16();
#pragma unroll
                    for (int mt = 0; mt < 4; ++mt)
#pragma unroll
                        for (int s = 0; s < 2; ++s) {
                            const bf16x8_t pf = pack8(s4[mt], 8 * s);
#pragma unroll
                            for (int dt = 0; dt < 2; ++dt) {
                                const LAS unsigned char* vp = lds + A_CMPV + (32 * dt + r) * A_CVSTR + (32 * mt + 16 * s + 4 * h) * 2;
                                const s16x4_t lo = *(const LAS s16x4_t*)vp, hi = *(const LAS s16x4_t*)(vp + 16);
                                oc[dt] = MFMA32(__builtin_shufflevector(lo, hi, 0, 1, 2, 3, 4, 5, 6, 7), pf, oc[dt]);
                            }
                        }
                    comb[hkv][0] += oc[0] * g0; comb[hkv][1] += oc[1] * g0;
                }
                if (t >= 16) {
                    __syncthreads();
                    const int qloc = tid >> 3, jg = tid & 7;
                    unsigned bits = 0u;
                    float xe[4]; int cnt[4];
#pragma unroll
                    for (int e = 0; e < 4; ++e) { const int j = 4 * jg + e; const LAS float* ip = IMP + qloc * A_IMPSTR + j;
                        float x = (ip[0] + ip[64 * A_IMPSTR]) + (ip[128 * A_IMPSTR] + ip[192 * A_IMPSTR]);
                        if (j == 0 || j == t || j == t - 1) x = 1e9f;
                        if (j > t) x = -INFINITY;
                        xe[e] = x; cnt[e] = 0; }
#pragma unroll 4
                    for (int i = 0; i < 32; ++i) { const LAS float* ip = IMP + qloc * A_IMPSTR + i;
                        float vi = (ip[0] + ip[64 * A_IMPSTR]) + (ip[128 * A_IMPSTR] + ip[192 * A_IMPSTR]);
                        if (i == 0 || i == t || i == t - 1) vi = 1e9f;
                        if (i > t) vi = -INFINITY;
#pragma unroll
                        for (int e = 0; e < 4; ++e) cnt[e] += (vi > xe[e] || (vi == xe[e] && i < 4 * jg + e)) ? 1 : 0; }
#pragma unroll
                    for (int e = 0; e < 4; ++e) if (cnt[e] < 16 && xe[e] > -INFINITY) bits |= 1u << (4 * jg + e);
                    bits |= __shfl_xor(bits, 1); bits |= __shfl_xor(bits, 2); bits |= __shfl_xor(bits, 4);
                    if (jg == 0) SELM[qloc] = bits;
                    __syncthreads();
                }
                const unsigned selw = (t >= 16) ? SELM[ql] : ((2u << t) - 1u);
#pragma unroll
                for (int ks = 0; ks < 4; ++ks) qf[ks] = __builtin_nontemporal_load((const bf16x8_t*)(qr + (size_t)tok * 512 + head * 64 + 16 * ks + 8 * h));
                const int kt_lo = t >= 8 ? t - 8 : 0, wlo = kt_lo >> 1, n_sel = (t >> 1) + 1, n_all = n_sel + ((t >> 1) - wlo + 1);
                const bf16_t* Ks = ksl + (size_t)bh * 2048 * 64; const bf16_t* Vs = vslT + (size_t)bh * 64 * 2048;
                const bf16_t* Kw = kwn + (size_t)bh * 2048 * 64; const bf16_t* Vw = vwnT + (size_t)bh * 64 * 2048;
#define A_ISSUE(idx) do { const int i1_ = (idx); const bool sel1_ = i1_ < n_sel; const int st1_ = sel1_ ? i1_ : wlo + (i1_ - n_sel); \
        int tv_ = tid; asm volatile("" : "+v"(tv_)); \
        const bf16_t* Kg_ = (sel1_ ? Ks : Kw) + (size_t)st1_ * 8192; const bf16_t* Vg_ = (sel1_ ? Vs : Vw) + (size_t)st1_ * 8192; \
        kR0 = *(const u32x4*)(Kg_ + (size_t)tv_ * 8); kR1 = *(const u32x4*)(Kg_ + (size_t)(tv_ + 512) * 8); \
        vR0 = *(const u32x4*)(Vg_ + (size_t)tv_ * 8); vR1 = *(const u32x4*)(Vg_ + (size_t)(tv_ + 512) * 8); } while (0)
#define A_STAGE(bufi) do { int tv_ = tid; asm volatile("" : "+v"(tv_)); \
        LAS unsigned char* kp_ = lds + A_KBUF + (bufi) * A_KT + (tv_ >> 3) * A_KSTR + (tv_ & 7) * 16; \
        *(LAS u32x4*)kp_ = kR0; *(LAS u32x4*)(kp_ + 64 * A_KSTR) = kR1; \
        LAS unsigned char* vp_ = lds + A_VBUF + (bufi) * A_VT + (tv_ >> 3) * A_CVSTR + (tv_ & 7) * 16; \
        *(LAS u32x2*)vp_ = (u32x2){vR0.x, vR0.y}; *(LAS u32x2*)(vp_ + 8) = (u32x2){vR0.z, vR0.w}; \
        *(LAS u32x2*)(vp_ + 128) = (u32x2){vR1.x, vR1.y}; *(LAS u32x2*)(vp_ + 136) = (u32x2){vR1.z, vR1.w}; } while (0)
                u32x4 kR0, kR1, vR0, vR1;
                A_ISSUE(0);
                A_STAGE(0);
                __syncthreads();
                f32x16 oacc[2]; oacc[0] = zero16(); oacc[1] = zero16();
                float l_run = 0.f;
#pragma unroll 1
                for (int i = 0; i < n_all; ++i) {
                    const int bufo = i & 1;
                    if (i + 1 < n_all) A_ISSUE(i + 1);
                    const LAS unsigned char* Kb = lds + A_KBUF + bufo * A_KT; const LAS unsigned char* Vb = lds + A_VBUF + bufo * A_VT;
                    const bool issel = i < n_sel;
                    const int st = issel ? i : wlo + (i - n_sel);
                    const int dlt = 64 * t + ql - 128 * st - 4 * h;
                    if (issel) {
                        const bool b0 = (selw >> (2 * st)) & 1u, b1 = (selw >> (2 * st + 1)) & 1u;
                        if (__ballot(b0 || b1) != 0ull) {
                            if (2 * st + 1 < t) {
                                if (__ballot(b0 && b1) == ~0ull) attn_tile<2>(Kb, Vb, qf, oacc, l_run, r, h, dlt, dlt, (w & 4) != 0);
                                else attn_tile<3>(Kb, Vb, qf, oacc, l_run, r, h, __float_as_int(b0 ? 0.f : -1e30f), __float_as_int(b1 ? 0.f : -1e30f), (w & 4) != 0);
                            } else attn_tile<0>(Kb, Vb, qf, oacc, l_run, r, h, b0 ? dlt : -1, b1 ? dlt : -1, (w & 4) != 0);
                        }
                    } else {
                        if (2 * st > t - 8 && 2 * st + 1 < t) attn_tile<2>(Kb, Vb, qf, oacc, l_run, r, h, dlt, dlt, (w & 4) != 0);
                        else attn_tile<1>(Kb, Vb, qf, oacc, l_run, r, h, dlt, dlt, (w & 4) != 0);
                    }
                    if (i == n_sel - 1 || i == n_all - 1) { const float lt = l_run + __shfl_xor(l_run, 32); const float sc = ((i == n_sel - 1) ? g1 : g2) / fmaxf(lt, 1e-20f);
                        comb[hkv][0] += oacc[0] * sc; comb[hkv][1] += oacc[1] * sc; oacc[0] = zero16(); oacc[1] = zero16(); l_run = 0.f; }
                    if (i + 1 < n_all) A_STAGE(bufo ^ 1);
                    __syncthreads();
                }
#undef A_ISSUE
#undef A_STAGE
            }
            int tid = tid0; asm volatile("" : "+v"(tid));
            const int lane = tid & 63, r = lane & 31, h = lane >> 5, ql = 32 * half + r, pos = 64 * t + ql, tok = b * 2048 + pos;
            float ss = 0.f;
#pragma unroll
            for (int hkv = 0; hkv < 2; ++hkv)
#pragma unroll
                for (int dt = 0; dt < 2; ++dt)
#pragma unroll
                    for (int i = 0; i < 16; ++i) ss += comb[hkv][dt][i] * comb[hkv][dt][i];
            ss += __shfl_xor(ss, 32);
            if (h == 0) SSQ[w * 32 + r] = ss;
            __syncthreads();
            const float tot = (SSQ[(half + 0) * 32 + r] + SSQ[(half + 2) * 32 + r]) + (SSQ[(half + 4) * 32 + r] + SSQ[(half + 6) * 32 + r]);
            const float rn = rsqrtf(tot * (1.f / 512.f) + EPS);
#pragma unroll
            for (int hkv = 0; hkv < 2; ++hkv)
#pragma unroll
                for (int dt = 0; dt < 2; ++dt)
#pragma unroll
                    for (int ap = 0; ap < 4; ++ap) {
                        u32x2 pk; pk.x = cvtpk(comb[hkv][dt][4 * ap] * rn, comb[hkv][dt][4 * ap + 1] * rn); pk.y = cvtpk(comb[hkv][dt][4 * ap + 2] * rn, comb[hkv][dt][4 * ap + 3] * rn);
                        *(u32x2*)(o + (size_t)tok * DM + (hkv * 4 + g) * 64 + 32 * dt + 8 * ap + 4 * h) = pk;
                    }
        }
    }
}

constexpr int G_TSTR = 136, G_TILE = 128 * G_TSTR, G_SSQ = 8 * G_TILE;
static_assert(G_SSQ + 8 * 128 * 4 <= LDS_BYTES - 64, "gMLP LDS map");
__device__ __forceinline__ void phase4_gmlp(const Args& a, LAS unsigned char* lds) {
    const int tid0 = threadIdx.x, g = __builtin_amdgcn_readfirstlane(tid0 >> 6);
    unsigned char* ws = a.ws;
    const bf16_t* zu = (const bf16_t*)(ws + WS_ZU); const bf16_t* zvT = (const bf16_t*)(ws + WS_ZVT); const bf16_t* Wsp = (const bf16_t*)(ws + WS_WSP);
    const float* sp_b = a.in[10];
    bf16_t* o = (bf16_t*)(ws + WS_O);
    LAS float* SSQ2 = (LAS float*)(lds + G_SSQ);
    LAS unsigned char* tile = lds + g * G_TILE;
    for (int item = blockIdx.x; item < 256; item += gridDim.x) {
        const int b = item >> 4, ch = item & 15;
        const size_t tok0 = (size_t)b * 2048 + ch * 128;
        int tid = tid0; asm volatile("" : "+v"(tid));
        const int lane = tid & 63, r = lane & 31, h = lane >> 5;
        __syncthreads();
        bf16x8_t zf[2][8];
#pragma unroll
        for (int dt = 0; dt < 2; ++dt)
#pragma unroll
            for (int ks = 0; ks < 8; ++ks) zf[dt][ks] = *(const bf16x8_t*)(zvT + ((((size_t)b * 16 + ch) * 8 + g) * 64 + 32 * dt + r) * 128 + 16 * ks + 8 * h);
        f32x16 acc[2][4];
#pragma unroll
        for (int tt = 0; tt < 4; ++tt) { acc[0][tt] = zero16(); acc[1][tt] = zero16();
            __builtin_amdgcn_sched_barrier(0);
#pragma unroll
            for (int ks = 0; ks < 2 * tt + 2; ++ks) {
                const bf16x8_t wf = *(const bf16x8_t*)(Wsp + ((size_t)g * 128 + 32 * tt + r) * 128 + 16 * ks + 8 * h);
                acc[0][tt] = MFMA32(zf[0][ks], wf, acc[0][tt]); acc[1][tt] = MFMA32(zf[1][ks], wf, acc[1][tt]);
            } }
        __builtin_amdgcn_sched_barrier(0);
#pragma unroll
        for (int hb = 0; hb < 2; ++hb) {
            u32x4 zr[8];
#pragma unroll
            for (int it = 0; it < 8; ++it) zr[it] = __builtin_nontemporal_load((const u32x4*)(zu + (tok0 + (lane >> 3) + 8 * (8 * hb + it)) * 512 + g * 64 + (lane & 7) * 8));
#pragma unroll
            for (int it = 0; it < 8; ++it) { LAS unsigned char* p = tile + ((lane >> 3) + 8 * (8 * hb + it)) * G_TSTR + (lane & 7) * 16;
                *(LAS u32x2*)p = (u32x2){zr[it].x, zr[it].y}; *(LAS u32x2*)(p + 8) = (u32x2){zr[it].z, zr[it].w}; }
        }
        asm volatile("s_waitcnt lgkmcnt(0)" ::: "memory");
#pragma unroll
        for (int tt = 0; tt < 4; ++tt) {
            const int tl = 32 * tt + r;
            const float bias = sp_b[g * 128 + tl];
            float ss = 0.f;
#pragma unroll
            for (int dt = 0; dt < 2; ++dt)
#pragma unroll
                for (int ap = 0; ap < 4; ++ap) {
                    const u32x2 zz = *(const LAS u32x2*)(tile + tl * G_TSTR + (32 * dt + 8 * ap + 4 * h) * 2);
                    const float z0 = __uint_as_float(zz.x << 16), z1 = __uint_as_float(zz.x & 0xffff0000u), z2 = __uint_as_float(zz.y << 16), z3 = __uint_as_float(zz.y & 0xffff0000u);
                    float v0 = z0 * (acc[dt][tt][4 * ap] + bias), v1 = z1 * (acc[dt][tt][4 * ap + 1] + bias), v2 = z2 * (acc[dt][tt][4 * ap + 2] + bias), v3 = z3 * (acc[dt][tt][4 * ap + 3] + bias);
                    acc[dt][tt][4 * ap] = v0; acc[dt][tt][4 * ap + 1] = v1; acc[dt][tt][4 * ap + 2] = v2; acc[dt][tt][4 * ap + 3] = v3;
                    ss += (v0 * v0 + v1 * v1) + (v2 * v2 + v3 * v3);
                }
            ss += __shfl_xor(ss, 32);
            if (h == 0) SSQ2[g * 128 + tl] = ss;
        }
        __syncthreads();
#pragma unroll
        for (int tt = 0; tt < 4; ++tt) {
            const int tl = 32 * tt + r;
            float tot = 0.f;
#pragma unroll
            for (int gg = 0; gg < 8; ++gg) tot += SSQ2[gg * 128 + tl];
            const float rn = rsqrtf(tot * (1.f / 512.f) + EPS);
#pragma unroll
            for (int dt = 0; dt < 2; ++dt)
#pragma unroll
                for (int ap = 0; ap < 4; ++ap) {
                    u32x2 pk; pk.x = cvtpk(acc[dt][tt][4 * ap] * rn, acc[dt][tt][4 * ap + 1] * rn); pk.y = cvtpk(acc[dt][tt][4 * ap + 2] * rn, acc[dt][tt][4 * ap + 3] * rn);
                    *(LAS u32x2*)(tile + tl * G_TSTR + (32 * dt + 8 * ap + 4 * h) * 2) = pk;
                }
        }
        asm volatile("s_waitcnt lgkmcnt(0)" ::: "memory");
#pragma unroll
        for (int it = 0; it < 16; ++it) { const LAS unsigned char* p = tile + ((lane >> 3) + 8 * it) * G_TSTR + (lane & 7) * 16;
            const u32x2 lo = *(const LAS u32x2*)p, hi = *(const LAS u32x2*)(p + 8);
            *(u32x4*)(o + (tok0 + (lane >> 3) + 8 * it) * DM + 512 + g * 64 + (lane & 7) * 8) = (u32x4){lo.x, lo.y, hi.x, hi.y}; }
    }
}

constexpr int BAR_BYTES = (1024 + 8 * 2304) * 4;
__device__ __forceinline__ unsigned xb_ld(unsigned* p) { return __hip_atomic_load(p, __ATOMIC_RELAXED, __HIP_MEMORY_SCOPE_AGENT); }
__device__ __forceinline__ unsigned xb_add(unsigned* p, unsigned v) { return __hip_atomic_fetch_add(p, v, __ATOMIC_RELAXED, __HIP_MEMORY_SCOPE_AGENT); }
__device__ __forceinline__ unsigned xb_xcc_id() { return (unsigned)__builtin_amdgcn_s_getreg((3 << 11) | 20) & 0xFu; }
__device__ __forceinline__ void grid_barrier(unsigned* barw, int k, volatile LAS unsigned* st) {
    asm volatile("s_waitcnt vmcnt(0)" ::: "memory");
    __syncthreads();
    if (threadIdx.x == 0) {
        __builtin_amdgcn_s_waitcnt(0);
        const unsigned x = xb_xcc_id();
        unsigned nloc = st[0], nx = st[1];
        if (nloc == 0u) {
            const unsigned G = gridDim.x;
            for (;;) { unsigned sum = 0u, cnt = 0u, mine = 0u;
#pragma unroll
                for (unsigned j = 0; j < 16; ++j) { const unsigned c = xb_ld(barw + 64 * j); sum += c; cnt += (c > 0u) ? 1u : 0u; mine = (j == x) ? c : mine; }
                if (sum == G) { nloc = mine; nx = cnt; break; }
                __builtin_amdgcn_s_sleep(1); }
            st[0] = nloc; st[1] = nx;
        }
        unsigned* sb = barw + 1024 + k * 2304;
        const unsigned old = xb_add(sb + 64 * x, 1u);
        if (old + 1u == nloc) {
            __builtin_amdgcn_fence(__ATOMIC_RELEASE, "agent");
            asm volatile("s_waitcnt vmcnt(0)" ::: "memory");
            const unsigned og = xb_add(sb + 2048, 1u);
            if (og + 1u == nx) xb_add(sb + 2112, 1u);
            else while (xb_ld(sb + 2112) == 0u) __builtin_amdgcn_s_sleep(1);
            __builtin_amdgcn_fence(__ATOMIC_ACQUIRE, "agent");
            xb_add(sb + 1024 + 64 * x, 1u);
            asm volatile("s_waitcnt vmcnt(0)" ::: "memory");
        } else {
            while (xb_ld(sb + 1024 + 64 * x) == 0u) __builtin_amdgcn_s_sleep(1);
            __builtin_amdgcn_fence(__ATOMIC_ACQUIRE, "agent");
            asm volatile("s_waitcnt vmcnt(0)" ::: "memory");
        }
    }
    __syncthreads();
}

#ifndef N_LAUNCHES
#define N_LAUNCHES 1
#endif
constexpr int NPHASE = 8;
__global__ void __launch_bounds__(NWAVES * 64, 2) fwd_kernel(Args args) {
    extern __shared__ __attribute__((aligned(16))) unsigned char lds_raw[];
    LAS unsigned char* lds = (LAS unsigned char*)lds_raw;
    unsigned char* ws = args.ws;
    const int lo = args.ph_lo, hi = args.ph_hi;
    const int G = gridDim.x;
#define IN(k) (lo <= (k) && (k) < hi)
    unsigned* barw = (unsigned*)ws;
    volatile LAS unsigned* bst = (volatile LAS unsigned*)(lds + LDS_BYTES - 64);
    if (threadIdx.x == 0) { bst[0] = 0u; bst[1] = 0u; (void)xb_add(barw + 64 * xb_xcc_id(), 1u); }
    __syncthreads();
    if (hi > NPHASE) cg::this_grid().sync();
#define SEAM(k) do { if (IN(k) && IN((k) + 1)) { grid_barrier(barw, (k), bst); } } while (0)
    if (IN(0)) { phase0(args, lds); }
    SEAM(0);
    if (IN(1)) {
        pg8::Gemm g{(const bf16_t*)(ws + WS_XB), (const bf16_t*)(ws + WS_WIN), T, NIN, DM, DM, DM};
        pg8::StaticOrder So; So.init(T, NIN, G, (int)blockIdx.x);
        EpiInProj E{(const float*)(ws + WS_RINV1), args.in[3], args.in[4], args.in[8], (const float*)(ws + WS_ROPEC), (const float*)(ws + WS_ROPES),
                    (bf16_t*)(ws + WS_QN), (bf16_t*)(ws + WS_QR), (bf16_t*)(ws + WS_KC), (bf16_t*)(ws + WS_VC), (bf16_t*)(ws + WS_KSL), (bf16_t*)(ws + WS_VSLT),
                    (bf16_t*)(ws + WS_KWN), (bf16_t*)(ws + WS_VWNT), (bf16_t*)(ws + WS_ZU), (bf16_t*)(ws + WS_ZVT), (float*)(ws + WS_GATES)};
        pg8::gemm_phase<EpiInProj, pg8::StaticOrder, true, true>(lds, g, So, E);
    }
    SEAM(1);
    if (IN(2)) {
        pg8::Gemm g{(const bf16_t*)(ws + WS_KC), (const bf16_t*)(ws + WS_W1T), 8192, 512, 512, 1024, 2048};
        pg8::CmpOrder So{G, (int)blockIdx.x};
        EpiPart E{(float*)(ws + WS_PART)};
        pg8::gemm_phase<EpiPart, pg8::CmpOrder, false, true>(lds, g, So, E);
    }
    SEAM(2);
    if (IN(3)) { phase3(args, lds); }
    SEAM(3);
    if (IN(4)) { phase4_attn(args, lds); phase4_gmlp(args, lds); }
    SEAM(4);
    if (IN(5)) {
        pg8::Gemm g{(const bf16_t*)(ws + WS_O), (const bf16_t*)(ws + WS_WOUT), T, DM, DM, DM, DM};
        pg8::StaticOrder So; So.init(T, DM, G, (int)blockIdx.x);
        EpiWout E{(const bf16_t*)(ws + WS_XB), (bf16_t*)(ws + WS_X2B), (float*)(ws + WS_SSQP), (LAS float*)(lds + 131072)};
        pg8::gemm_phase<EpiWout, pg8::StaticOrder, true, true>(lds, g, So, E);
    }
    SEAM(5);
    if (IN(6)) {
        pg8::Gemm g{(const bf16_t*)(ws + WS_X2B), (const bf16_t*)(ws + WS_WFF1), T, FF, DM, DM, DM};
        pg8::StaticOrder So; So.init(T, FF, G, (int)blockIdx.x);
        EpiFF1 E{(const float*)(ws + WS_SSQP), (bf16_t*)(ws + WS_H)};
        pg8::gemm_phase<EpiFF1, pg8::StaticOrder, true, true>(lds, g, So, E);
    }
    SEAM(6);
    if (IN(7)) {
        pg8::Gemm g{(const bf16_t*)(ws + WS_H), (const bf16_t*)(ws + WS_WFF2), T, DM, FF, FF, FF};
        pg8::StaticOrder So; So.init(T, DM, G, (int)blockIdx.x);
        EpiFF2 E{(const bf16_t*)(ws + WS_X2B), args.out};
        pg8::gemm_phase<EpiFF2, pg8::StaticOrder, true, true>(lds, g, So, E);
    }
#undef IN
#undef SEAM
}

extern "C" void kernel_launch(void* const* d_in, const int* in_sizes, int n_in, void* d_out, int out_size, void* d_ws, size_t ws_size, hipStream_t stream) {
    static int grid = 0;
    if (grid == 0) {
        if (n_in != 16 || out_size != T * DM || ws_size < WS_END) { fprintf(stderr, "kernel_launch: unexpected shapes (n_in %d out %d ws %zu)\n", n_in, out_size, ws_size); grid = -1; return; }
        int dev = 0, cus = 0, per_cu = 0;
        hipGetDevice(&dev); hipDeviceGetAttribute(&cus, hipDeviceAttributeMultiprocessorCount, dev);
        if (hipFuncSetAttribute((const void*)fwd_kernel, hipFuncAttributeMaxDynamicSharedMemorySize, LDS_BYTES) != hipSuccess) { fprintf(stderr, "kernel_launch: hipFuncSetAttribute failed\n"); grid = -1; return; }
        if (hipOccupancyMaxActiveBlocksPerMultiprocessor(&per_cu, (const void*)fwd_kernel, NWAVES * 64, LDS_BYTES) != hipSuccess || per_cu < 1) { fprintf(stderr, "kernel_launch: occupancy query says %d\n", per_cu); per_cu = 1; }
        (void)hipGetLastError();
        grid = cus * per_cu;
        fprintf(stderr, "kernel_launch: grid %d (cus %d x %d)\n", grid, cus, per_cu);
    }
    if (grid < 0) return;
    if (hipMemsetAsync(d_ws, 0, BAR_BYTES, stream) != hipSuccess) { fprintf(stderr, "kernel_launch: memset of the barrier words failed\n"); return; }
    Args a{};
    for (int i = 0; i < 16; ++i) a.in[i] = (const float*)d_in[i];
    a.out = (float*)d_out; a.ws = (unsigned char*)d_ws;
#if N_LAUNCHES == 1
    a.ph_lo = 0; a.ph_hi = NPHASE;
    void* kargs[] = {&a};
    hipError_t e = hipLaunchCooperativeKernel((const void*)fwd_kernel, dim3(grid), dim3(NWAVES * 64), kargs, LDS_BYTES, stream);
    if (e != hipSuccess) fprintf(stderr, "kernel_launch: cooperative launch failed: %s (grid %d)\n", hipGetErrorString(e), grid);
#else
    for (int p = 0; p < NPHASE; ++p) {
        a.ph_lo = p; a.ph_hi = p + 1;
        hipLaunchKernelGGL(fwd_kernel, dim3(grid), dim3(NWAVES * 64), LDS_BYTES, stream, a);
    }
#endif
}
```

```cpp
#include <hip/hip_runtime.h>
#include <hip/hip_cooperative_groups.h>
#include <cstdio>
#include <cstdint>
namespace cg = cooperative_groups;

#define LAS __attribute__((address_space(3)))
typedef unsigned short bf16_t;
typedef unsigned u32x4 __attribute__((ext_vector_type(4)));
typedef float f32x4 __attribute__((ext_vector_type(4)));

namespace pg8 {
#define PG8_LAS __attribute__((address_space(3)))
typedef short bf16x8 __attribute__((ext_vector_type(8)));
constexpr int BM = 256, BK = 64, HALF = 128, HTB = HALF * BK * 2, STAGE_BYTES = 8 * HTB, NXCD = 8, WGM = 4;
__host__ __device__ __forceinline__ int lds_byte(int r, int c) { const int st = (r >> 4) * 2 + (c >> 5), rr = r & 15, cc = c & 31, ob = rr * 64 + cc * 2; return st * 1024 + (ob ^ (((ob >> 9) & 1) << 5)); }
__host__ __device__ __forceinline__ void stage_rc(int b, int& R, int& C) { const int st = b / 1024, sb = b % 1024, swz = sb ^ (((sb >> 9) & 1) << 5); R = (st >> 1) * 16 + swz / 64; C = (st & 1) * 32 + (swz % 64) / 2; }
__host__ __device__ __forceinline__ int perm32(int rho) { const int n = rho >> 4, i = rho & 15; return 8 * (i >> 2) + 4 * n + (i & 3); }
struct Unit { int pm, pn, koff; };
struct Gemm { const bf16_t* A; const bf16_t* Bt; int M, N, K, lda, ldb; };
struct StaticOrder {
    int nM, nN, nwg, G, c;
    __host__ __device__ void init(int M, int N, int G_, int c_) { nM = M / BM; nN = N / BM; nwg = nM * nN; G = G_; c = c_; }
    __host__ __device__ bool next(int i, Unit& u) const {
        const long L = (long)i * G + c; if (L >= nwg) return false;
        int wgid = (int)L; { const int q = nwg / NXCD, r = nwg % NXCD, xcd = wgid % NXCD, off = wgid / NXCD; wgid = (xcd < r ? xcd * (q + 1) : r * (q + 1) + (xcd - r) * q) + off; }
        const int nig = WGM * nN, gid = wgid / nig, fm = gid * WGM, gsz = (nM - fm) < WGM ? (nM - fm) : WGM;
        u.pm = fm + ((wgid % nig) % gsz); u.pn = (wgid % nig) / gsz; u.koff = 0; return true;
    }
    __device__ __forceinline__ void a_ready(const Unit&) const {}
    __device__ __forceinline__ void done(const Unit&) const {}
};
struct CmpOrder {
    int G, c;
    __device__ bool next(int i, Unit& u) const { const long L = (long)i * G + c; if (L >= 128) return false; u.pm = (int)L & 31; u.pn = u.pm >> 4; u.koff = ((int)L >> 5) * 1024; return true; }
    __device__ __forceinline__ void a_ready(const Unit&) const {}
    __device__ __forceinline__ void done(const Unit&) const {}
};
__device__ __forceinline__ unsigned cvt_pk_bf16(float lo, float hi) { unsigned r; asm volatile("v_cvt_pk_bf16_f32 %0, %1, %2" : "=v"(r) : "v"(lo), "v"(hi)); return r; }
template <class Epi, class Sched, bool ALIGN_EPI = false, bool SP2 = false>
__device__ __forceinline__ void gemm_phase(PG8_LAS unsigned char* lds, const Gemm g, const Sched& S, const Epi& E) {
    const int tid = threadIdx.x, wid = __builtin_amdgcn_readfirstlane(tid >> 6), lane = tid & 63, wr = wid >> 2, wc = wid & 3, fr = lane & 15, fq = lane >> 4;
    const int K = g.K, nt = K / BK, lda = g.lda, ldb = g.ldb;
    unsigned voffA[2], voffB[2];
#pragma unroll
    for (int i = 0; i < 2; ++i) { int R, C; stage_rc(tid * 16 + i * 8192, R, C); const int Rb = Epi::PERM ? ((R & ~31) + perm32(R & 31)) : R;
        voffA[i] = (unsigned)(R * lda + C) * 2u; voffB[i] = (unsigned)(Rb * ldb + C) * 2u; }
    const size_t kstep = (size_t)(BK * 2);
    const size_t hstepA = (size_t)HALF * lda * 2, hstepB = (size_t)HALF * ldb * 2;
    const size_t tstepA = 2 * hstepA, tstepB = 2 * hstepB;
    const unsigned ldsw = (unsigned)wid * 1024u;
    const int aoff = lds_byte(wr * 64 + fr, fq * 8), boff = lds_byte(wc * 32 + fr, fq * 8);
#define PG8_SA(b, h) (((b) * 2 + (h)) * HTB)
#define PG8_SB(b, h) ((4 + (b) * 2 + (h)) * HTB)
#define PG8_STAGE(bufoff, gbase, voff) do { _Pragma("unroll") for (int _i = 0; _i < 2; ++_i) \
        __builtin_amdgcn_global_load_lds((const unsigned*)((const char*)(gbase) + (voff)[_i]), (PG8_LAS unsigned*)(lds + (bufoff) + ldsw + _i * 8192), 16, 0, 0); } while (0)
#define PG8_LDA(dst, b, h) do { _Pragma("unroll") for (int m = 0; m < 4; ++m) _Pragma("unroll") for (int k = 0; k < 2; ++k) dst[m][k] = *(const PG8_LAS bf16x8*)(lds + PG8_SA(b, h) + aoff + m * 2048 + k * 1024); } while (0)
#define PG8_LDB(dst, b, h) do { _Pragma("unroll") for (int n = 0; n < 2; ++n) _Pragma("unroll") for (int k = 0; k < 2; ++k) dst[n][k] = *(const PG8_LAS bf16x8*)(lds + PG8_SB(b, h) + boff + n * 2048 + k * 1024); } while (0)
#define PG8_MMA(ai, bj, At, Bt) do { __builtin_amdgcn_s_setprio(1); _Pragma("unroll") for (int m = 0; m < 4; ++m) _Pragma("unroll") for (int n = 0; n < 2; ++n) _Pragma("unroll") for (int k = 0; k < 2; ++k) \
        acc[ai][bj][m][n] = __builtin_amdgcn_mfma_f32_16x16x32_bf16(Bt[n][k], At[m][k], acc[ai][bj][m][n], 0, 0, 0); __builtin_amdgcn_s_setprio(0); } while (0)
#define PG8_WAIT_V(n) asm volatile("s_waitcnt vmcnt(" #n ")" ::: "memory")
#define PG8_WAIT_L(n) asm volatile("s_waitcnt lgkmcnt(" #n ")" ::: "memory")
#define PG8_BAR __builtin_amdgcn_s_barrier()
#define PG8_SCHED __builtin_amdgcn_sched_barrier(0)
    Unit cur, nxt; int ui = 0;
    if (!S.next(0, cur)) return;
    f32x4 acc[2][2][4][2];
#pragma unroll
    for (int a = 0; a < 2; ++a)
#pragma unroll
        for (int b = 0; b < 2; ++b)
#pragma unroll
            for (int m = 0; m < 4; ++m)
#pragma unroll
                for (int n = 0; n < 2; ++n) acc[a][b][m][n] = (f32x4){0.f, 0.f, 0.f, 0.f};
    bf16x8 At[4][2], B0[2][2], B1[2][2];
    const char* cA = (const char*)g.A + (size_t)cur.pm * tstepA + cur.koff; const char* cB = (const char*)g.Bt + (size_t)cur.pn * tstepB + cur.koff;
    S.a_ready(cur);
    if constexpr (SP2) {
        PG8_STAGE(PG8_SB(0, 0), cB, voffB); PG8_STAGE(PG8_SB(0, 1), cB + hstepB, voffB); PG8_STAGE(PG8_SA(0, 0), cA, voffA); PG8_STAGE(PG8_SA(0, 1), cA + hstepA, voffA);
        if (wr == 1) PG8_BAR;
        PG8_WAIT_V(2); PG8_BAR;
        PG8_STAGE(PG8_SB(1, 0), cB + kstep, voffB); PG8_STAGE(PG8_SA(1, 0), cA + kstep, voffA); PG8_STAGE(PG8_SB(1, 1), cB + hstepB + kstep, voffB);
        PG8_WAIT_V(6); PG8_BAR;
    } else {
        PG8_STAGE(PG8_SB(0, 0), cB, voffB); PG8_STAGE(PG8_SA(0, 0), cA, voffA); PG8_STAGE(PG8_SB(0, 1), cB + hstepB, voffB); PG8_STAGE(PG8_SA(0, 1), cA + hstepA, voffA);
        if (wr == 1) PG8_BAR;
        PG8_WAIT_V(4); PG8_BAR;
        PG8_STAGE(PG8_SB(1, 0), cB + kstep, voffB); PG8_STAGE(PG8_SA(1, 0), cA + kstep, voffA); PG8_STAGE(PG8_SB(1, 1), cB + hstepB + kstep, voffB);
        PG8_WAIT_V(6); PG8_BAR;
    }
    for (;;) {
        const bool has_next = S.next(ui + 1, nxt);
        const char* nA = has_next ? (const char*)g.A + (size_t)nxt.pm * tstepA + nxt.koff : cA; const char* nB = has_next ? (const char*)g.Bt + (size_t)nxt.pn * tstepB + nxt.koff : cB;
        for (int t = 0; t < nt; t += 2) {
            const bool last = (t == nt - 2);
            const char* a1 = cA + (size_t)(t + 1) * kstep;
            const char* a2 = last ? nA : cA + (size_t)(t + 2) * kstep; const char* b2 = last ? nB : cB + (size_t)(t + 2) * kstep;
            const char* a3 = a2 + kstep; const char* b3 = b2 + kstep;
            if (last && has_next) S.a_ready(nxt);
            if constexpr (SP2) {
            PG8_LDB(B0, 0, 0); PG8_LDB(B1, 0, 1); PG8_SCHED; PG8_LDA(At, 0, 0); PG8_STAGE(PG8_SA(1, 1), a1 + hstepA, voffA);
            PG8_WAIT_V(8); PG8_WAIT_L(0); PG8_BAR; PG8_MMA(0, 0, At, B0); PG8_MMA(0, 1, At, B1); PG8_BAR; PG8_SCHED;
            PG8_LDA(At, 0, 1); PG8_STAGE(PG8_SB(0, 0), b2, voffB); PG8_STAGE(PG8_SB(0, 1), b2 + hstepB, voffB); PG8_STAGE(PG8_SA(0, 0), a2, voffA);
            PG8_WAIT_V(8); PG8_WAIT_L(0); PG8_BAR; PG8_MMA(1, 0, At, B0); PG8_MMA(1, 1, At, B1); PG8_BAR; PG8_SCHED;
            PG8_LDB(B0, 1, 0); PG8_LDB(B1, 1, 1); PG8_SCHED; PG8_LDA(At, 1, 0); PG8_STAGE(PG8_SA(0, 1), a2 + hstepA, voffA);
            PG8_WAIT_V(8); PG8_WAIT_L(0); PG8_BAR; PG8_MMA(0, 0, At, B0); PG8_MMA(0, 1, At, B1); PG8_BAR; PG8_SCHED;
            PG8_LDA(At, 1, 1); PG8_STAGE(PG8_SB(1, 0), b3, voffB); PG8_STAGE(PG8_SB(1, 1), b3 + hstepB, voffB); PG8_STAGE(PG8_SA(1, 0), a3, voffA);
            PG8_WAIT_V(8); PG8_WAIT_L(0); PG8_BAR; PG8_MMA(1, 0, At, B0); PG8_MMA(1, 1, At, B1); PG8_BAR; PG8_SCHED;
            } else {
            PG8_LDB(B0, 0, 0); PG8_SCHED; PG8_LDA(At, 0, 0); PG8_STAGE(PG8_SA(1, 1), a1 + hstepA, voffA);
            PG8_WAIT_L(8); PG8_BAR; PG8_WAIT_L(0); PG8_MMA(0, 0, At, B0); PG8_BAR; PG8_SCHED;
            PG8_LDB(B1, 0, 1); PG8_STAGE(PG8_SB(0, 0), b2, voffB);
            PG8_BAR; PG8_WAIT_L(0); PG8_MMA(0, 1, At, B1); PG8_BAR;
            PG8_LDA(At, 0, 1); PG8_STAGE(PG8_SA(0, 0), a2, voffA);
            PG8_BAR; PG8_WAIT_L(0); PG8_MMA(1, 0, At, B0); PG8_BAR; PG8_SCHED;
            PG8_STAGE(PG8_SB(0, 1), b2 + hstepB, voffB);
            PG8_WAIT_V(6); PG8_BAR; PG8_MMA(1, 1, At, B1); PG8_BAR;
            PG8_LDB(B0, 1, 0); PG8_SCHED; PG8_LDA(At, 1, 0); PG8_STAGE(PG8_SA(0, 1), a2 + hstepA, voffA);
            PG8_WAIT_L(8); PG8_BAR; PG8_WAIT_L(0); PG8_MMA(0, 0, At, B0); PG8_BAR; PG8_SCHED;
            PG8_LDB(B1, 1, 1); PG8_STAGE(PG8_SB(1, 0), b3, voffB);
            PG8_BAR; PG8_WAIT_L(0); PG8_MMA(0, 1, At, B1); PG8_BAR;
            PG8_LDA(At, 1, 1); PG8_STAGE(PG8_SA(1, 0), a3, voffA);
            PG8_BAR; PG8_WAIT_L(0); PG8_MMA(1, 0, At, B0); PG8_BAR; PG8_SCHED;
            PG8_STAGE(PG8_SB(1, 1), b3 + hstepB, voffB);
            PG8_WAIT_V(6); PG8_BAR; PG8_MMA(1, 1, At, B1); PG8_BAR;
            }
        }
        if constexpr (ALIGN_EPI) { if (wr == 0) PG8_BAR; }
        if constexpr (!Epi::AFTER_DRAIN) { E(acc, cur, wr, wc, fr, fq); S.done(cur); }
        if (!has_next) break;
#pragma unroll
        for (int a = 0; a < 2; ++a)
#pragma unroll
            for (int b = 0; b < 2; ++b)
#pragma unroll
                for (int m = 0; m < 4; ++m)
#pragma unroll
                    for (int n = 0; n < 2; ++n) acc[a][b][m][n] = (f32x4){0.f, 0.f, 0.f, 0.f};
        cur = nxt; cA = nA; cB = nB; ++ui;
        if constexpr (ALIGN_EPI) { if (wr == 1) PG8_BAR; }
    }
    PG8_WAIT_V(0);
    if constexpr (!ALIGN_EPI) { if (wr == 0) PG8_BAR; }
    PG8_BAR;
    if constexpr (Epi::AFTER_DRAIN) { E.fused(acc, cur, wr, wc, fr, fq, lds, wid, lane); S.done(cur); }
#undef PG8_SA
#undef PG8_SB
#undef PG8_STAGE
#undef PG8_LDA
#undef PG8_LDB
#undef PG8_MMA
#undef PG8_WAIT_V
#undef PG8_WAIT_L
#undef PG8_BAR
#undef PG8_SCHED
}
}

constexpr int T = 32768, S = 2048, DM = 1024, NIN = 2560, FF = 4096;
constexpr float EPS = 1e-6f;
constexpr float QSCALE = 0.125f * 1.4426950408889634f;
constexpr size_t MiB = 1u << 20;
constexpr size_t WS_WIN = 1 * MiB, WS_WOUT = 6 * MiB, WS_WFF1 = 8 * MiB, WS_WFF2 = 16 * MiB, WS_W1T = 24 * MiB;
constexpr size_t WS_WSP = 26 * MiB + 768 * 1024;
constexpr size_t WS_C1 = 26 * MiB, WS_ROPEC = 26 * MiB + 64 * 1024, WS_ROPES = 26 * MiB + 320 * 1024;
constexpr size_t WS_RINV1 = 27 * MiB, WS_SSQP = 27 * MiB + 512 * 1024, WS_GATES = 30 * MiB;
constexpr size_t WS_KCMP = 33 * MiB, WS_VCMPT = 33 * MiB + 512 * 1024, WS_HID = 34 * MiB, WS_X2B = 38 * MiB;
constexpr size_t WS_XB = 102 * MiB, WS_QN = 166 * MiB, WS_QR = 198 * MiB, WS_KC = 230 * MiB, WS_VC = 238 * MiB;
constexpr size_t WS_KSL = 246 * MiB, WS_VSLT = 254 * MiB, WS_KWN = 262 * MiB, WS_VWNT = 270 * MiB, WS_ZU = 278 * MiB, WS_ZVT = 310 * MiB, WS_O = 342 * MiB;
constexpr size_t WS_H = 102 * MiB, WS_END = 406 * MiB;
constexpr size_t WS_PART = WS_X2B;
constexpr size_t WS_C1P = 26 * MiB + 576 * 1024;
constexpr int LDS_BYTES = 147456;
constexpr int NWAVES = 8;

struct Args { const float* in[16]; float* out; unsigned char* ws; int ph_lo, ph_hi; };

__device__ __forceinline__ float bf2f(bf16_t h) { return __uint_as_float(((unsigned)h) << 16); }
__device__ __forceinline__ unsigned f2bf(float f) { unsigned u = __float_as_uint(f); return (u + 0x7fffu + ((u >> 16) & 1u)) >> 16; }
__device__ __forceinline__ unsigned pk2(float lo, float hi) { return pg8::cvt_pk_bf16(lo, hi); }
__device__ __forceinline__ float wave_sum(float v) {
#pragma unroll
    for (int o = 1; o < 64; o <<= 1) v += __shfl_xor(v, o);
    return v;
}
__device__ __forceinline__ float wave_max(float v) {
#pragma unroll
    for (int o = 1; o < 64; o <<= 1) v = fmaxf(v, __shfl_xor(v, o));
    return v;
}
__device__ __forceinline__ float gelu_tanh(float x) {
    const float u = 0.7978845608028654f * (x + 0.044715f * x * x * x);
    return x / (1.f + __expf(-2.f * u));
}
__device__ __forceinline__ void store8(bf16_t* p, const float* v) {
    u32x4 w; w.x = pk2(v[0], v[1]); w.y = pk2(v[2], v[3]); w.z = pk2(v[4], v[5]); w.w = pk2(v[6], v[7]);
    *(u32x4*)p = w;
}
__device__ __forceinline__ void load8(const bf16_t* p, float* v) {
    const u32x4 w = *(const u32x4*)p;
    v[0] = __uint_as_float(w.x << 16); v[1] = __uint_as_float(w.x & 0xffff0000u);
    v[2] = __uint_as_float(w.y << 16); v[3] = __uint_as_float(w.y & 0xffff0000u);
    v[4] = __uint_as_float(w.z << 16); v[5] = __uint_as_float(w.z & 0xffff0000u);
    v[6] = __uint_as_float(w.w << 16); v[7] = __uint_as_float(w.w & 0xffff0000u);
}
__device__ __forceinline__ float head_ssq(const float (&v)[16]) {
    float s = 0.f;
#pragma unroll
    for (int i = 0; i < 16; ++i) s += v[i] * v[i];
    s += __shfl_xor(s, 16); s += __shfl_xor(s, 32);
    return s;
}

struct EpiInProj {
    static constexpr bool PERM = true, AFTER_DRAIN = false;
    const float *rinv1, *g_q, *g_k, *g_sgu, *ropec, *ropes;
    bf16_t *qn, *qr, *kc, *vc, *ksl, *vslT, *kwn, *vwnT, *zu, *zvT; float* gates;
    __device__ __forceinline__ void operator()(const f32x4 (&acc)[2][2][4][2], const pg8::Unit& u, int wr, int wc, int fr, int fq) const {
        const int cs = u.pn * 4 + wc;
        if (cs >= 37) return;
        const int d0 = 8 * fq;
        float rsv[2][4];
#pragma unroll
        for (int ai = 0; ai < 2; ++ai)
#pragma unroll
            for (int m = 0; m < 4; ++m) rsv[ai][m] = rinv1[u.pm * 256 + ai * 128 + wr * 64 + m * 16 + fr];
#pragma unroll
        for (int ai = 0; ai < 2; ++ai)
#pragma unroll
            for (int m = 0; m < 4; ++m) {
                const int row = u.pm * 256 + ai * 128 + wr * 64 + m * 16 + fr;
                const float rs = rsv[ai][m];
                float v[16];
#pragma unroll
                for (int bj = 0; bj < 2; ++bj)
#pragma unroll
                    for (int n = 0; n < 2; ++n)
#pragma unroll
                        for (int e = 0; e < 4; ++e) v[bj * 8 + n * 4 + e] = acc[ai][bj][m][n][e] * rs;
                const int b = row >> 11, s = row & 2047;
                if (cs < 8 || cs == 12 || cs == 13 || cs == 16 || cs == 17) {
                    const float* gg = cs < 8 ? g_q : (cs < 14 ? g_k + 64 : g_k + 128);
                    const float rn = rsqrtf(head_ssq(v) * (1.f / 64.f) + EPS) * (cs < 8 ? QSCALE : 1.f);
                    float y[16];
#pragma unroll
                    for (int i = 0; i < 16; ++i) y[i] = v[i] * rn * gg[32 * (i >> 3) + d0 + (i & 7)];
                    float r1[8], r2[8];
#pragma unroll
                    for (int i = 0; i < 8; ++i) { int di = d0 + i; asm volatile("" : "+v"(di));
                        const float frev = __builtin_amdgcn_exp2f(-(float)di * (13.287712379549449f / 32.f)) * 0.15915494309189535f;
                        float xr = (float)s * frev; xr -= __builtin_rintf(xr);
                        const float c = __builtin_amdgcn_cosf(xr), sn = __builtin_amdgcn_sinf(xr); r1[i] = y[i] * c - y[8 + i] * sn; r2[i] = y[8 + i] * c + y[i] * sn; }
                    if (cs < 8) {
                        bf16_t* p = qn + (size_t)row * 512 + cs * 64 + d0; store8(p, y); store8(p + 32, y + 8);
                        bf16_t* p2 = qr + (size_t)row * 512 + cs * 64 + d0; store8(p2, r1); store8(p2 + 32, r2);
                    } else {
                        bf16_t* p = (cs < 14 ? ksl : kwn) + ((size_t)(b * 2 + (cs & 1)) * 2048 + s) * 64 + d0; store8(p, r1); store8(p + 32, r2);
                    }
                } else if (cs < 12) {
                    bf16_t* p = (cs < 10 ? kc : vc) + ((size_t)(b * 2 + (cs & 1)) * 2048 + s) * 64 + d0; store8(p, v); store8(p + 32, v + 8);
                } else if (cs < 20) {
                    bf16_t* p = (cs < 16 ? vslT : vwnT) + ((size_t)(b * 2 + (cs & 1)) * 32 + (s >> 6)) * 4096 + (s & 63);
#pragma unroll
                    for (int i = 0; i < 16; ++i) p[(32 * (i >> 3) + d0 + (i & 7)) * 64] = (bf16_t)f2bf(v[i]);
                } else if (cs < 28) {
                    float y[16];
#pragma unroll
                    for (int i = 0; i < 16; ++i) y[i] = gelu_tanh(v[i]);
                    bf16_t* p = zu + (size_t)row * 512 + (cs - 20) * 64 + d0; store8(p, y); store8(p + 32, y + 8);
                } else if (cs < 36) {
                    const int g = cs - 28;
                    float y[16];
#pragma unroll
                    for (int i = 0; i < 16; ++i) y[i] = gelu_tanh(v[i]);
                    const float rn = rsqrtf(head_ssq(y) * (1.f / 64.f) + EPS);
                    bf16_t* p = zvT + (((size_t)b * 16 + (s >> 7)) * 8 + g) * 8192 + (s & 127);
#pragma unroll
                    for (int i = 0; i < 16; ++i) { const int d = 32 * (i >> 3) + d0 + (i & 7); p[d * 128] = (bf16_t)f2bf(y[i] * rn * g_sgu[g * 64 + d]); }
                } else {
                    if (fq < 3) {
#pragma unroll
                        for (int i = 0; i < 8; ++i) gates[(size_t)row * 24 + d0 + i] = 1.f / (1.f + __expf(-v[i]));
                    }
                }
            }
    }
};

struct EpiPart {
    static constexpr bool PERM = true, AFTER_DRAIN = false;
    float* part;
    __device__ __forceinline__ void operator()(const f32x4 (&acc)[2][2][4][2], const pg8::Unit& u, int wr, int wc, int fr, int fq) const {
        float* base = part + (size_t)(u.koff >> 10) * 8192 * 256;
#pragma unroll
        for (int ai = 0; ai < 2; ++ai)
#pragma unroll
            for (int m = 0; m < 4; ++m) {
                const int row = u.pm * 256 + ai * 128 + wr * 64 + m * 16 + fr;
#pragma unroll
                for (int bj = 0; bj < 2; ++bj) {
                    float* p = base + (size_t)row * 256 + 128 * bj + 32 * wc + 8 * fq;
                    *(f32x4*)p = acc[ai][bj][m][0]; *(f32x4*)(p + 4) = acc[ai][bj][m][1];
                }
            }
    }
};

struct EpiWout {
    static constexpr bool PERM = true, AFTER_DRAIN = false;
    const bf16_t* xb; bf16_t* x2b; float* ssqp; LAS float* red;
    __device__ __forceinline__ void operator()(const f32x4 (&acc)[2][2][4][2], const pg8::Unit& u, int wr, int wc, int fr, int fq) const {
        u32x4 xr[2][4][2];
#pragma unroll
        for (int ai = 0; ai < 2; ++ai)
#pragma unroll
            for (int m = 0; m < 4; ++m)
#pragma unroll
                for (int bj = 0; bj < 2; ++bj)
                    xr[ai][m][bj] = *(const u32x4*)(xb + (size_t)(u.pm * 256 + ai * 128 + wr * 64 + m * 16 + fr) * DM + u.pn * 256 + 128 * bj + 32 * wc + 8 * fq);
        __builtin_amdgcn_sched_barrier(0);
#pragma unroll
        for (int ai = 0; ai < 2; ++ai)
#pragma unroll
            for (int m = 0; m < 4; ++m) {
                const int row = u.pm * 256 + ai * 128 + wr * 64 + m * 16 + fr;
                float ss = 0.f;
#pragma unroll
                for (int bj = 0; bj < 2; ++bj) {
                    const size_t off = (size_t)row * DM + u.pn * 256 + 128 * bj + 32 * wc + 8 * fq;
                    const u32x4 w = xr[ai][m][bj];
                    float y[8];
                    y[0] = __uint_as_float(w.x << 16) + acc[ai][bj][m][0].x; y[1] = __uint_as_float(w.x & 0xffff0000u) + acc[ai][bj][m][0].y;
                    y[2] = __uint_as_float(w.y << 16) + acc[ai][bj][m][0].z; y[3] = __uint_as_float(w.y & 0xffff0000u) + acc[ai][bj][m][0].w;
                    y[4] = __uint_as_float(w.z << 16) + acc[ai][bj][m][1].x; y[5] = __uint_as_float(w.z & 0xffff0000u) + acc[ai][bj][m][1].y;
                    y[6] = __uint_as_float(w.w << 16) + acc[ai][bj][m][1].z; y[7] = __uint_as_float(w.w & 0xffff0000u) + acc[ai][bj][m][1].w;
                    store8(x2b + off, y);
#pragma unroll
                    for (int i = 0; i < 8; ++i) ss += y[i] * y[i];
                }
                ss += __shfl_xor(ss, 16); ss += __shfl_xor(ss, 32);
                if (fq == 0) red[wc * 256 + (row & 255)] = ss;
            }
        __syncthreads();
        { const int tid = threadIdx.x;
          if (tid < 256) ssqp[(size_t)(u.pm * 256 + tid) * 4 + u.pn] = (red[tid] + red[256 + tid]) + (red[512 + tid] + red[768 + tid]); }
    }
};

struct EpiFF1 {
    static constexpr bool PERM = true, AFTER_DRAIN = false;
    const float* ssqp; bf16_t* H;
    __device__ __forceinline__ void operator()(const f32x4 (&acc)[2][2][4][2], const pg8::Unit& u, int wr, int wc, int fr, int fq) const {
        f32x4 sq[2][4];
#pragma unroll
        for (int ai = 0; ai < 2; ++ai)
#pragma unroll
            for (int m = 0; m < 4; ++m) sq[ai][m] = *(const f32x4*)(ssqp + (size_t)(u.pm * 256 + ai * 128 + wr * 64 + m * 16 + fr) * 4);
        __builtin_amdgcn_sched_barrier(0);
#pragma unroll
        for (int ai = 0; ai < 2; ++ai)
#pragma unroll
            for (int m = 0; m < 4; ++m) {
                const int row = u.pm * 256 + ai * 128 + wr * 64 + m * 16 + fr;
                const float tot = (sq[ai][m].x + sq[ai][m].y) + (sq[ai][m].z + sq[ai][m].w);
                const float rn = rsqrtf(tot * (1.f / 1024.f) + EPS);
#pragma unroll
                for (int bj = 0; bj < 2; ++bj) {
                    float y[8];
#pragma unroll
                    for (int n = 0; n < 2; ++n)
#pragma unroll
                        for (int e = 0; e < 4; ++e) { const float h = fmaxf(acc[ai][bj][m][n][e] * rn, 0.f); y[n * 4 + e] = h * h; }
                    store8(H + (size_t)row * FF + u.pn * 256 + 128 * bj + 32 * wc + 8 * fq, y);
                }
            }
    }
};

struct EpiFF2 {
    static constexpr bool PERM = true, AFTER_DRAIN = false;
    const bf16_t* x2b; float* out;
    __device__ __forceinline__ void operator()(const f32x4 (&acc)[2][2][4][2], const pg8::Unit& u, int wr, int wc, int fr, int fq) const {
        u32x4 xr[2][4][2];
#pragma unroll
        for (int ai = 0; ai < 2; ++ai)
#pragma unroll
            for (int m = 0; m < 4; ++m)
#pragma unroll
                for (int bj = 0; bj < 2; ++bj)
                    xr[ai][m][bj] = *(const u32x4*)(x2b + (size_t)(u.pm * 256 + ai * 128 + wr * 64 + m * 16 + fr) * DM + u.pn * 256 + 128 * bj + 32 * wc + 8 * fq);
        __builtin_amdgcn_sched_barrier(0);
#pragma unroll
        for (int ai = 0; ai < 2; ++ai)
#pragma unroll
            for (int m = 0; m < 4; ++m) {
                const int row = u.pm * 256 + ai * 128 + wr * 64 + m * 16 + fr;
#pragma unroll
                for (int bj = 0; bj < 2; ++bj) {
                    const size_t off = (size_t)row * DM + u.pn * 256 + 128 * bj + 32 * wc + 8 * fq;
                    const u32x4 w = xr[ai][m][bj];
                    f32x4 ya = acc[ai][bj][m][0], yb = acc[ai][bj][m][1];
                    ya.x += __uint_as_float(w.x << 16); ya.y += __uint_as_float(w.x & 0xffff0000u); ya.z += __uint_as_float(w.y << 16); ya.w += __uint_as_float(w.y & 0xffff0000u);
                    yb.x += __uint_as_float(w.z << 16); yb.y += __uint_as_float(w.z & 0xffff0000u); yb.z += __uint_as_float(w.w << 16); yb.w += __uint_as_float(w.w & 0xffff0000u);
                    *(f32x4*)(out + off) = ya; *(f32x4*)(out + off + 4) = yb;
                }
            }
    }
};

__device__ __forceinline__ int win_src_col(int nphys) {
    const int pn = nphys >> 8, Pp = nphys & 255, bj = Pp >> 7, wc = (Pp & 127) >> 5, r = Pp & 31;
    const int lc = (pn << 8) + 64 * wc + 32 * bj + r;
    if (lc < 1280) return lc;
    if (lc < 2304) return lc + 24;
    if (lc < 2328) return lc - 1024;
    return -1;
}
template <int MAP>
__device__ __forceinline__ void transpose_item(const float* W, int K, int N, bf16_t* WT, const float* gk, LAS float* scr, int item, int nblk, int lane) {
    const int kb = item / nblk, nb = item % nblk, k0 = 64 * kb, n0 = 32 * nb;
    const int src = MAP ? win_src_col(n0 + (lane & 31)) : n0 + (lane & 31);
    float tv[32];
#pragma unroll
    for (int i = 0; i < 32; ++i) { const int kk = 2 * i + (lane >> 5); tv[i] = (src >= 0) ? __builtin_nontemporal_load(W + (size_t)(k0 + kk) * N + src) : 0.f; }
    if (gk) {
#pragma unroll
        for (int i = 0; i < 32; ++i) tv[i] *= gk[k0 + 2 * i + (lane >> 5)]; }
#pragma unroll
    for (int i = 0; i < 32; ++i) scr[(2 * i + (lane >> 5)) * 33 + (lane & 31)] = tv[i];
    asm volatile("s_waitcnt lgkmcnt(0)" ::: "memory");
    const int c = lane & 7;
#pragma unroll
    for (int j = 0; j < 4; ++j) { const int n = (lane >> 3) + 8 * j; const LAS float* s = scr + (8 * c) * 33 + n;
        u32x4 o; o.x = pk2(s[0 * 33], s[1 * 33]); o.y = pk2(s[2 * 33], s[3 * 33]); o.z = pk2(s[4 * 33], s[5 * 33]); o.w = pk2(s[6 * 33], s[7 * 33]);
        *(u32x4*)(WT + (size_t)(n0 + n) * K + k0 + 8 * c) = o; }
    asm volatile("s_waitcnt lgkmcnt(0)" ::: "memory");
}

__device__ __forceinline__ void phase0(const Args& a, LAS unsigned char* lds) {
    const int tid = threadIdx.x, lane = tid & 63, wave = tid >> 6;
    unsigned char* ws = a.ws;
    LAS float* scr = (LAS float*)(lds + wave * 16384);
    const int gw = blockIdx.x * NWAVES + wave, NGW = gridDim.x * NWAVES;
    constexpr int I_IN = 16 * 80, I_C = 32 * 8;
    constexpr int NITEMS = I_IN + 2 * I_C;
    for (int it = gw; it < NITEMS; it += NGW) {
        int r = it;
        if (r < I_IN) { transpose_item<1>(a.in[2], 1024, 2328, (bf16_t*)(ws + WS_WIN), a.in[1], scr, r, 80, lane); continue; } r -= I_IN;
        if (r < I_C) { transpose_item<0>(a.in[6], 2048, 256, (bf16_t*)(ws + WS_W1T), nullptr, scr, r, 8, lane); continue; } r -= I_C;
        transpose_item<0>(a.in[6] + (size_t)2048 * 256, 2048, 256, (bf16_t*)(ws + WS_W1T) + (size_t)256 * 2048, nullptr, scr, r, 8, lane);
    }
    {
        const float* x = a.in[0]; bf16_t* xb = (bf16_t*)(ws + WS_XB); float* rinv1 = (float*)(ws + WS_RINV1);
        for (int m = gw; m < T; m += 2 * NGW) {
            const int m2 = m + NGW;
            const bool has2 = m2 < T;
            const f32x4* xr = (const f32x4*)(x + (size_t)m * DM) + lane;
            const f32x4* xr2 = (const f32x4*)(x + (size_t)(has2 ? m2 : m) * DM) + lane;
            f32x4 v[4], u[4]; float s = 0.f, s2 = 0.f;
#pragma unroll
            for (int j = 0; j < 4; ++j) { v[j] = __builtin_nontemporal_load(xr + 64 * j); u[j] = __builtin_nontemporal_load(xr2 + 64 * j); }
#pragma unroll
            for (int j = 0; j < 4; ++j) { s += (v[j].x * v[j].x + v[j].y * v[j].y) + (v[j].z * v[j].z + v[j].w * v[j].w); s2 += (u[j].x * u[j].x + u[j].y * u[j].y) + (u[j].z * u[j].z + u[j].w * u[j].w); }
            s = wave_sum(s); s2 = wave_sum(s2);
            if (lane == 0) { rinv1[m] = rsqrtf(s * (1.f / 1024.f) + EPS); if (has2) rinv1[m2] = rsqrtf(s2 * (1.f / 1024.f) + EPS); }
            unsigned long long* o8 = (unsigned long long*)(xb + (size_t)m * DM) + lane;
#pragma unroll
            for (int j = 0; j < 4; ++j) o8[64 * j] = (unsigned long long)pk2(v[j].x, v[j].y) | ((unsigned long long)pk2(v[j].z, v[j].w) << 32);
            if (has2) { unsigned long long* o82 = (unsigned long long*)(xb + (size_t)m2 * DM) + lane;
#pragma unroll
                for (int j = 0; j < 4; ++j) o82[64 * j] = (unsigned long long)pk2(u[j].x, u[j].y) | ((unsigned long long)pk2(u[j].z, u[j].w) << 32); }
        }
    }
    {
        bf16_t* Wsp = (bf16_t*)(ws + WS_WSP); const float* spw = a.in[9];
        for (int idx = blockIdx.x * 512 + tid; idx < 8 * 128 * 128; idx += gridDim.x * 512) { const int tq = (idx >> 7) & 127, sq = idx & 127; Wsp[idx] = (bf16_t)f2bf(sq <= tq ? spw[idx] : 0.f); }
    }
    {
        if ((gw & 3) == 0 && (gw >> 2) < 512) {
            const int item = gw >> 2, kv = item >> 8, cg4 = (item >> 6) & 3, kch = item & 63;
            const float* pe = a.in[5] + kv * 2048 + kch * 32; const float* w1 = a.in[6] + ((size_t)kv * 2048 + kch * 32) * 256 + cg4 * 64 + lane;
            float wv[32];
#pragma unroll
            for (int k = 0; k < 32; ++k) wv[k] = w1[(size_t)k * 256];
            float acc = 0.f;
#pragma unroll
            for (int k = 0; k < 32; ++k) acc += pe[k] * wv[k];
            ((float*)(ws + WS_C1P))[kch * 512 + kv * 256 + cg4 * 64 + lane] = acc;
        }
    }
}

__device__ __forceinline__ void phase3(const Args& a, LAS unsigned char* lds) {
    const int tid = threadIdx.x, lane = tid & 63, wave = tid >> 6;
    unsigned char* ws = a.ws;
    const float* part = (const float*)(ws + WS_PART); const float* c1p = (const float*)(ws + WS_C1P);
    bf16_t* kcmp = (bf16_t*)(ws + WS_KCMP); bf16_t* vcmpT = (bf16_t*)(ws + WS_VCMPT);
    LAS float* w2s = (LAS float*)lds;
    LAS float* c1s = w2s + 256 * 64;
    LAS float* hids = c1s + 256;
    const int nchunk = 8192 / 32;
    for (int item = blockIdx.x; item < nchunk; item += gridDim.x) {
        const int kv = (item * 32) >> 12;
        __syncthreads();
        { const f32x4* src = (const f32x4*)(a.in[7] + (size_t)kv * 256 * 64);
#pragma unroll
          for (int i = 0; i < 8; ++i) ((LAS f32x4*)w2s)[tid + 512 * i] = src[tid + 512 * i]; }
        if (tid < 256) { float t = 0.f;
#pragma unroll
            for (int kch = 0; kch < 64; ++kch) t += c1p[kch * 512 + kv * 256 + tid];
            c1s[tid] = t; }
        __syncthreads();
#pragma unroll 1
        for (int rr = 0; rr < 4; ++rr) {
            const int R = item * 32 + wave * 4 + rr, bh = (R >> 7) & 31, n = R & 127;
            f32x4 h4 = *(const LAS f32x4*)(c1s + 4 * lane);
#pragma unroll
            for (int kc = 0; kc < 4; ++kc) h4 += *(const f32x4*)(part + ((size_t)kc * 8192 + R) * 256 + 4 * lane);
            h4.x = gelu_tanh(h4.x); h4.y = gelu_tanh(h4.y); h4.z = gelu_tanh(h4.z); h4.w = gelu_tanh(h4.w);
            *(LAS f32x4*)(hids + wave * 256 + 4 * lane) = h4;
            asm volatile("s_waitcnt lgkmcnt(0)" ::: "memory");
            float acc = 0.f;
#pragma unroll 8
            for (int c = 0; c < 256; ++c) acc += hids[wave * 256 + c] * w2s[c * 64 + lane];
            if (kv == 0) {
                const float ss = wave_sum(acc * acc);
                const float y = acc * rsqrtf(ss * (1.f / 64.f) + EPS) * a.in[4][lane];
                kcmp[((size_t)bh * 128 + n) * 64 + lane] = (bf16_t)f2bf(n < 127 ? y : 0.f);
            } else {
                vcmpT[((size_t)bh * 64 + lane) * 128 + n] = (bf16_t)f2bf(n < 127 ? acc : 0.f);
            }
        }
    }
    if (gridDim.x < 256) {
        LAS float* scr = (LAS float*)(lds + 77824 + wave * 8704);
        const int gw = blockIdx.x * NWAVES + wave, NGW = gridDim.x * NWAVES;
        constexpr int I_O = 16 * 32, I_1 = 16 * 128, I_2 = 64 * 32;
        for (int it = gw; it < I_O + I_1 + I_2; it += NGW) {
            int r = it;
            if (r < I_O) { transpose_item<0>(a.in[12], 1024, 1024, (bf16_t*)(ws + WS_WOUT), a.in[11], scr, r, 32, lane); continue; } r -= I_O;
            if (r < I_1) { transpose_item<0>(a.in[14], 1024, 4096, (bf16_t*)(ws + WS_WFF1), a.in[13], scr, r, 128, lane); continue; } r -= I_1;
            transpose_item<0>(a.in[15], 4096, 1024, (bf16_t*)(ws + WS_WFF2), nullptr, scr, r, 32, lane);
        }
    }
}

typedef short bf16x8_t __attribute__((ext_vector_type(8)));
typedef short s16x4_t __attribute__((ext_vector_type(4)));
typedef float f32x16 __attribute__((ext_vector_type(16)));
typedef __bf16 bf16x2_t __attribute__((ext_vector_type(2)));
typedef float f32x2_t __attribute__((ext_vector_type(2)));
typedef unsigned u32x2 __attribute__((ext_vector_type(2)));
#define MFMA32(a, b, c) __builtin_amdgcn_mfma_f32_32x32x16_bf16((a), (b), (c), 0, 0, 0)
__device__ __forceinline__ unsigned cvtpk(float lo, float hi) { f32x2_t v = {lo, hi}; bf16x2_t b = __builtin_convertvector(v, bf16x2_t); return __builtin_bit_cast(unsigned, b); }
__device__ __forceinline__ float ex2(float x) { return __builtin_amdgcn_exp2f(x); }
__device__ __forceinline__ f32x16 zero16() { f32x16 z;
#pragma unroll
    for (int i = 0; i < 16; ++i) z[i] = 0.f; return z; }
__device__ __forceinline__ bf16x8_t pack8(const f32x16& x, int s8) {
    u32x4 w; w.x = cvtpk(x[s8 + 0], x[s8 + 1]); w.y = cvtpk(x[s8 + 2], x[s8 + 3]); w.z = cvtpk(x[s8 + 4], x[s8 + 5]); w.w = cvtpk(x[s8 + 6], x[s8 + 7]);
    return __builtin_bit_cast(bf16x8_t, w);
}
constexpr int A_KSTR = 144, A_VSTR = 136, A_CVSTR = 264, A_IMPSTR = 33;
constexpr int A_KT = 128 * A_KSTR, A_VT = 64 * A_CVSTR;
constexpr int A_KBUF = 0, A_VBUF = 2 * A_KT, A_CMPK = A_VBUF + 2 * A_VT, A_CMPV = A_CMPK + 18432, A_IMP = A_CMPV + 16896, A_SELM = A_IMP + 4 * 64 * A_IMPSTR * 4, A_SSQ = A_SELM + 256, A_END = A_SSQ + 4096;
static_assert(A_END <= LDS_BYTES - 64, "attention LDS map");

template <int MODE>
__device__ __forceinline__ void attn_tile(const LAS unsigned char* Kb, const LAS unsigned char* Vb, const bf16x8_t (&qf)[4], f32x16 (&oacc)[2], float& l_run,
                                          int r, int h, int dlt0, int dlt1, bool hiw) {
    const unsigned ulim = (MODE == 0) ? 0x80000000u : 512u;
    float ls = 0.f;
#pragma unroll
    for (int mt = 0; mt < 4; ++mt) {
        if (mt == 0) { if (hiw) __builtin_amdgcn_s_setprio(1); else __builtin_amdgcn_s_setprio(0); }
        if (mt == 2) { if (hiw) __builtin_amdgcn_s_setprio(0); else __builtin_amdgcn_s_setprio(1); }
        const int dl = mt < 2 ? dlt0 : dlt1;
        f32x16 sacc = zero16();
#pragma unroll
        for (int ks = 0; ks < 4; ++ks) { const bf16x8_t ka = *(const LAS bf16x8_t*)(Kb + (32 * mt + r) * A_KSTR + 32 * ks + 16 * h); sacc = MFMA32(ka, qf[ks], sacc); }
#pragma unroll
        for (int i = 0; i < 16; ++i) {
            float p;
            if (MODE == 2) p = ex2(sacc[i]);
            else if (MODE == 3) p = ex2(sacc[i] + __int_as_float(dl));
            else { const int ci = 32 * mt + (i & 3) + 8 * (i >> 2); p = ((unsigned)(dl - ci) < ulim) ? ex2(sacc[i]) : 0.f; }
            sacc[i] = p; ls += p;
        }
#pragma unroll
        for (int s = 0; s < 2; ++s) {
            const bf16x8_t pf = pack8(sacc, 8 * s);
#pragma unroll
            for (int dt = 0; dt < 2; ++dt) {
                const LAS unsigned char* vp = Vb + (32 * dt + r) * A_CVSTR + (32 * mt + 16 * s + 4 * h) * 2;
                const s16x4_t lo = *(const LAS s16x4_t*)vp, hi = *(const LAS s16x4_t*)(vp + 16);
                oacc[dt] = MFMA32(__builtin_shufflevector(lo, hi, 0, 1, 2, 3, 4, 5, 6, 7), pf, oacc[dt]);
            }
        }
    }
    l_run += ls;
}

__device__ __forceinline__ void phase4_attn(const Args& a, LAS unsigned char* lds) {
    const int tid0 = threadIdx.x, w = __builtin_amdgcn_readfirstlane(tid0 >> 6), g = w >> 1, half = w & 1;
    unsigned char* ws = a.ws;
    const bf16_t* qn = (const bf16_t*)(ws + WS_QN); const bf16_t* qr = (const bf16_t*)(ws + WS_QR);
    const bf16_t* kcmp = (const bf16_t*)(ws + WS_KCMP); const bf16_t* vcmpT = (const bf16_t*)(ws + WS_VCMPT);
    const bf16_t* ksl = (const bf16_t*)(ws + WS_KSL); const bf16_t* vslT = (const bf16_t*)(ws + WS_VSLT);
    const bf16_t* kwn = (const bf16_t*)(ws + WS_KWN); const bf16_t* vwnT = (const bf16_t*)(ws + WS_VWNT);
    const float* gates = (const float*)(ws + WS_GATES);
    bf16_t* o = (bf16_t*)(ws + WS_O);
    LAS float* IMP = (LAS float*)(lds + A_IMP); LAS unsigned* SELM = (LAS unsigned*)(lds + A_SELM); LAS float* SSQ = (LAS float*)(lds + A_SSQ);
    for (int pr = blockIdx.x; pr < 256; pr += gridDim.x) {
        const int b = pr >> 4, tt0 = pr & 15;
#pragma unroll 1
        for (int it = 0; it < 2; ++it) {
            const int t = it ? 31 - tt0 : tt0;
            f32x16 comb[2][2];
#pragma unroll
            for (int hkv = 0; hkv < 2; ++hkv) {
                const int bh = b * 2 + hkv, head = hkv * 4 + g;
                int tid = tid0; asm volatile("" : "+v"(tid));
                const int lane = tid & 63, r = lane & 31, h = lane >> 5, ql = 32 * half + r, pos = 64 * t + ql, tok = b * 2048 + pos;
                comb[hkv][0] = zero16(); comb[hkv][1] = zero16();
                const float g0 = gates[(size_t)tok * 24 + head * 3 + 0], g1 = gates[(size_t)tok * 24 + head * 3 + 1], g2 = gates[(size_t)tok * 24 + head * 3 + 2];
                __syncthreads();
                {
                    const bf16_t* kc = kcmp + (size_t)bh * 128 * 64; const bf16_t* vc = vcmpT + (size_t)bh * 64 * 128;
#pragma unroll
                    for (int i = 0; i < 2; ++i) { const int c = tid + 512 * i;
                        const u32x4 kv = *(const u32x4*)(kc + (size_t)c * 8);
                        *(LAS u32x4*)(lds + A_CMPK + (c >> 3) * A_KSTR + (c & 7) * 16) = kv;
                        const u32x4 vv = *(const u32x4*)(vc + (size_t)c * 8);
                        LAS unsigned char* vp = lds + A_CMPV + (c >> 4) * A_CVSTR + (c & 15) * 16;
                        *(LAS u32x2*)vp = (u32x2){vv.x, vv.y}; *(LAS u32x2*)(vp + 8) = (u32x2){vv.z, vv.w}; }
                }
                bf16x8_t qf[4];
#pragma unroll
                for (int ks = 0; ks < 4; ++ks) qf[ks] = __builtin_nontemporal_load((const bf16x8_t*)(qn + (size_t)tok * 512 + head * 64 + 16 * ks + 8 * h));
                __syncthreads();
                {
                    f32x16 s4[4];
#pragma unroll
                    for (int mt = 0; mt < 4; ++mt) { s4[mt] = zero16();
#pragma unroll
                        for (int ks = 0; ks < 4; ++ks) { const bf16x8_t ka = *(const LAS bf16x8_t*)(lds + A_CMPK + (32 * mt + r) * A_KSTR + 32 * ks + 16 * h); s4[mt] = MFMA32(ka, qf[ks], s4[mt]); } }
                    const int clim = (pos - 31 - 64 * h) >> 4;
                    float ls = 0.f;
#pragma unroll
                    for (int mt = 0; mt < 4; ++mt)
#pragma unroll
                        for (int i = 0; i < 16; ++i) { const int ci = 32 * mt + (i & 3) + 8 * (i >> 2);
                            const float p = (ci <= clim) ? ex2(s4[mt][i]) : 0.f; s4[mt][i] = p; ls += p; }
                    ls += __shfl_xor(ls, 32);
                    const float inv = 1.f / fmaxf(ls, 1e-20f);
#pragma unroll
                    for (int mt = 0; mt < 4; ++mt) s4[mt] *= inv;
                    if (t >= 16) {
                        float oprev = 0.f;
#pragma unroll
                        for (int idx = 0; idx < 16; ++idx) {
                            const int mt = idx >> 2, ap = idx & 3;
                            const float tail = 0.5f * s4[mt][4 * ap + 3];
                            const float ot = __shfl_xor(tail, 32);
                            const float inner = s4[mt][4 * ap] + s4[mt][4 * ap + 1] + s4[mt][4 * ap + 2] + tail;
                            const float prev = h ? ot : oprev;
                            oprev = ot;
                            IMP[(g * 64 + ql) * A_IMPSTR + 8 * mt + 2 * ap + h] = inner + prev;
                        }
                    }
                    f32x16 oc[2]; oc[0] = zero16(); oc[1] = zero16();
#pragma unroll
                    for (int mt = 0; mt < 4; ++mt)
#pragma unroll
                        for (int s = 0; s < 2; ++s) {
                            const bf16x8_t pf = pack8(s4[mt], 8 * s);
#pragma unroll
                            for (int dt = 0; dt < 2; ++dt) {
                                const LAS unsigned char* vp = lds + A_CMPV + (32 * dt + r) * A_CVSTR + (32 * mt + 16 * s + 4 * h) * 2;
                                const s16x4_t lo = *(const LAS s16x4_t*)vp, hi = *(const LAS s16x4_t*)(vp + 16);
                                oc[dt] = MFMA32(__builtin_shufflevector(lo, hi, 0, 1, 2, 3, 4, 5, 6, 7), pf, oc[dt]);
                            }
                        }
                    comb[hkv][0] += oc[0] * g0; comb[hkv][1] += oc[1] * g0;
                }
                if (t >= 16) {
                    __syncthreads();
                    const int qloc = tid >> 3, jg = tid & 7;
                    unsigned bits = 0u;
                    float xe[4]; int cnt[4];
#pragma unroll
                    for (int e = 0; e < 4; ++e) { const int j = 4 * jg + e; const LAS float* ip = IMP + qloc * A_IMPSTR + j;
                        float x = (ip[0] + ip[64 * A_IMPSTR]) + (ip[128 * A_IMPSTR] + ip[192 * A_IMPSTR]);
                        if (j == 0 || j == t || j == t - 1) x = 1e9f;
                        if (j > t) x = -INFINITY;
                        xe[e] = x; cnt[e] = 0; }
#pragma unroll 4
                    for (int i = 0; i < 32; ++i) { const LAS float* ip = IMP + qloc * A_IMPSTR + i;
                        float vi = (ip[0] + ip[64 * A_IMPSTR]) + (ip[128 * A_IMPSTR] + ip[192 * A_IMPSTR]);
                        if (i == 0 || i == t || i == t - 1) vi = 1e9f;
                        if (i > t) vi = -INFINITY;
#pragma unroll
                        for (int e = 0; e < 4; ++e) cnt[e] += (vi > xe[e] || (vi == xe[e] && i < 4 * jg + e)) ? 1 : 0; }
#pragma unroll
                    for (int e = 0; e < 4; ++e) if (cnt[e] < 16 && xe[e] > -INFINITY) bits |= 1u << (4 * jg + e);
                    bits |= __shfl_xor(bits, 1); bits |= __shfl_xor(bits, 2); bits |= __shfl_xor(bits, 4);
                    if (jg == 0) SELM[qloc] = bits;
                    __syncthreads();
                }
                const unsigned selw = (t >= 16) ? SELM[ql] : ((2u << t) - 1u);
#pragma unroll
                for (int ks = 0; ks < 4; ++ks) qf[ks] = __builtin_nontemporal_load((const bf16x8_t*)(qr + (size_t)tok * 512 + head * 64 + 16 * ks + 8 * h));
                const int kt_lo = t >= 8 ? t - 8 : 0, wlo = kt_lo >> 1, n_sel = (t >> 1) + 1, n_all = n_sel + ((t >> 1) - wlo + 1);
                const bf16_t* Ks = ksl + (size_t)bh * 2048 * 64; const bf16_t* Vs = vslT + (size_t)bh * 64 * 2048;
                const bf16_t* Kw = kwn + (size_t)bh * 2048 * 64; const bf16_t* Vw = vwnT + (size_t)bh * 64 * 2048;
#define A_ISSUE(idx) do { const int i1_ = (idx); const bool sel1_ = i1_ < n_sel; const int st1_ = sel1_ ? i1_ : wlo + (i1_ - n_sel); \
        int tv_ = tid; asm volatile("" : "+v"(tv_)); \
        const bf16_t* Kg_ = (sel1_ ? Ks : Kw) + (size_t)st1_ * 8192; const bf16_t* Vg_ = (sel1_ ? Vs : Vw) + (size_t)st1_ * 8192; \
        kR0 = *(const u32x4*)(Kg_ + (size_t)tv_ * 8); kR1 = *(const u32x4*)(Kg_ + (size_t)(tv_ + 512) * 8); \
        vR0 = *(const u32x4*)(Vg_ + (size_t)tv_ * 8); vR1 = *(const u32x4*)(Vg_ + (size_t)(tv_ + 512) * 8); } while (0)
#define A_STAGE(bufi) do { int tv_ = tid; asm volatile("" : "+v"(tv_)); \
        LAS unsigned char* kp_ = lds + A_KBUF + (bufi) * A_KT + (tv_ >> 3) * A_KSTR + (tv_ & 7) * 16; \
        *(LAS u32x4*)kp_ = kR0; *(LAS u32x4*)(kp_ + 64 * A_KSTR) = kR1; \
        LAS unsigned char* vp_ = lds + A_VBUF + (bufi) * A_VT + (tv_ >> 3) * A_CVSTR + (tv_ & 7) * 16; \
        *(LAS u32x2*)vp_ = (u32x2){vR0.x, vR0.y}; *(LAS u32x2*)(vp_ + 8) = (u32x2){vR0.z, vR0.w}; \
        *(LAS u32x2*)(vp_ + 128) = (u32x2){vR1.x, vR1.y}; *(LAS u32x2*)(vp_ + 136) = (u32x2){vR1.z, vR1.w}; } while (0)
                u32x4 kR0, kR1, vR0, vR1;
                A_ISSUE(0);
                A_STAGE(0);
                __syncthreads();
                f32x16 oacc[2]; oacc[0] = zero16(); oacc[1] = zero16();
                float l_run = 0.f;
#pragma unroll 1
                for (int i = 0; i < n_all; ++i) {
                    const int bufo = i & 1;
                    if (i + 1 < n_all) A_ISSUE(i + 1);
                    const LAS unsigned char* Kb = lds + A_KBUF + bufo * A_KT; const LAS unsigned char* Vb = lds + A_VBUF + bufo * A_VT;
                    const bool issel = i < n_sel;
                    const int st = issel ? i : wlo + (i - n_sel);
                    const int dlt = 64 * t + ql - 128 * st - 4 * h;
                    if (issel) {
                        const bool b0 = (selw >> (2 * st)) & 1u, b1 = (selw >> (2 * st + 1)) & 1u;
                        if (__ballot(b0 || b1) != 0ull) {
                            if (2 * st + 1 < t) {
                                if (__ballot(b0 && b1) == ~0ull) attn_tile<2>(Kb, Vb, qf, oacc, l_run, r, h, dlt, dlt, (w & 4) != 0);
                                else attn_tile<3>(Kb, Vb, qf, oacc, l_run, r, h, __float_as_int(b0 ? 0.f : -1e30f), __float_as_int(b1 ? 0.f : -1e30f), (w & 4) != 0);
                            } else attn_tile<0>(Kb, Vb, qf, oacc, l_run, r, h, b0 ? dlt : -1, b1 ? dlt : -1, (w & 4) != 0);
                        }
                    } else {
                        if (2 * st > t - 8 && 2 * st + 1 < t) attn_tile<2>(Kb, Vb, qf, oacc, l_run, r, h, dlt, dlt, (w & 4) != 0);
                        else attn_tile<1>(Kb, Vb, qf, oacc, l_run, r, h, dlt, dlt, (w & 4) != 0);
                    }
                    if (i == n_sel - 1 || i == n_all - 1) { const float lt = l_run + __shfl_xor(l_run, 32); const float sc = ((i == n_sel - 1) ? g1 : g2) / fmaxf(lt, 1e-20f);
                        comb[hkv][0] += oacc[0] * sc; comb[hkv][1] += oacc[1] * sc; oacc[0] = zero16(); oacc[1] = zero16(); l_run = 0.f; }
                    if (i + 1 < n_all) A_STAGE(bufo ^ 1);
                    __syncthreads();
                }
#undef A_ISSUE
#undef A_STAGE
            }
            int tid = tid0; asm volatile("" : "+v"(tid));
            const int lane = tid & 63, r = lane & 31, h = lane >> 5, ql = 32 * half + r, pos = 64 * t + ql, tok = b * 2048 + pos;
            float ss = 0.f;
#pragma unroll
            for (int hkv = 0; hkv < 2; ++hkv)
#pragma unroll
                for (int dt = 0; dt < 2; ++dt)
#pragma unroll
                    for (int i = 0; i < 16; ++i) ss += comb[hkv][dt][i] * comb[hkv][dt][i];
            ss += __shfl_xor(ss, 32);
            if (h == 0) SSQ[w * 32 + r] = ss;
            __syncthreads();
            const float tot = (SSQ[(half + 0) * 32 + r] + SSQ[(half + 2) * 32 + r]) + (SSQ[(half + 4) * 32 + r] + SSQ[(half + 6) * 32 + r]);
            const float rn = rsqrtf(tot * (1.f / 512.f) + EPS);
#pragma unroll
            for (int hkv = 0; hkv < 2; ++hkv)
#pragma unroll
                for (int dt = 0; dt < 2; ++dt)
#pragma unroll
                    for (int ap = 0; ap < 4; ++ap) {
                        u32x2 pk; pk.x = cvtpk(comb[hkv][dt][4 * ap] * rn, comb[hkv][dt][4 * ap + 1] * rn); pk.y = cvtpk(comb[hkv][dt][4 * ap + 2] * rn, comb[hkv][dt][4 * ap + 3] * rn);
                        *(u32x2*)(o + (size_t)tok * DM + (hkv * 4 + g) * 64 + 32 * dt + 8 * ap + 4 * h) = pk;
                    }
        }
    }
}

constexpr int G_TSTR = 136, G_TILE = 128 * G_TSTR, G_SSQ = 8 * G_TILE;
static_assert(G_SSQ + 8 * 128 * 4 <= LDS_BYTES - 64, "gMLP LDS map");
__device__ __forceinline__ void phase4_gmlp(const Args& a, LAS unsigned char* lds) {
    const int tid0 = threadIdx.x, g = __builtin_amdgcn_readfirstlane(tid0 >> 6);
    unsigned char* ws = a.ws;
    const bf16_t* zu = (const bf16_t*)(ws + WS_ZU); const bf16_t* zvT = (const bf16_t*)(ws + WS_ZVT); const bf16_t* Wsp = (const bf16_t*)(ws + WS_WSP);
    const float* sp_b = a.in[10];
    bf16_t* o = (bf16_t*)(ws + WS_O);
    LAS float* SSQ2 = (LAS float*)(lds + G_SSQ);
    LAS unsigned char* tile = lds + g * G_TILE;
    for (int item = blockIdx.x; item < 256; item += gridDim.x) {
        const int b = item >> 4, ch = item & 15;
        const size_t tok0 = (size_t)b * 2048 + ch * 128;
        int tid = tid0; asm volatile("" : "+v"(tid));
        const int lane = tid & 63, r = lane & 31, h = lane >> 5;
        __syncthreads();
        bf16x8_t zf[2][8];
#pragma unroll
        for (int dt = 0; dt < 2; ++dt)
#pragma unroll
            for (int ks = 0; ks < 8; ++ks) zf[dt][ks] = *(const bf16x8_t*)(zvT + ((((size_t)b * 16 + ch) * 8 + g) * 64 + 32 * dt + r) * 128 + 16 * ks + 8 * h);
        f32x16 acc[2][4];
#pragma unroll
        for (int tt = 0; tt < 4; ++tt) { acc[0][tt] = zero16(); acc[1][tt] = zero16();
            __builtin_amdgcn_sched_barrier(0);
#pragma unroll
            for (int ks = 0; ks < 2 * tt + 2; ++ks) {
                const bf16x8_t wf = *(const bf16x8_t*)(Wsp + ((size_t)g * 128 + 32 * tt + r) * 128 + 16 * ks + 8 * h);
                acc[0][tt] = MFMA32(zf[0][ks], wf, acc[0][tt]); acc[1][tt] = MFMA32(zf[1][ks], wf, acc[1][tt]);
            } }
        __builtin_amdgcn_sched_barrier(0);
#pragma unroll
        for (int hb = 0; hb < 2; ++hb) {
            u32x4 zr[8];
#pragma unroll
            for (int it = 0; it < 8; ++it) zr[it] = __builtin_nontemporal_load((const u32x4*)(zu + (tok0 + (lane >> 3) + 8 * (8 * hb + it)) * 512 + g * 64 + (lane & 7) * 8));
#pragma unroll
            for (int it = 0; it < 8; ++it) { LAS unsigned char* p = tile + ((lane >> 3) + 8 * (8 * hb + it)) * G_TSTR + (lane & 7) * 16;
                *(LAS u32x2*)p = (u32x2){zr[it].x, zr[it].y}; *(LAS u32x2*)(p + 8) = (u32x2){zr[it].z, zr[it].w}; }
        }
        asm volatile("s_waitcnt lgkmcnt(0)" ::: "memory");
#pragma unroll
        for (int tt = 0; tt < 4; ++tt) {
            const int tl = 32 * tt + r;
            const float bias = sp_b[g * 128 + tl];
            float ss = 0.f;
#pragma unroll
            for (int dt = 0; dt < 2; ++dt)
#pragma unroll
                for (int ap = 0; ap < 4; ++ap) {
                    const u32x2 zz = *(const LAS u32x2*)(tile + tl * G_TSTR + (32 * dt + 8 * ap + 4 * h) * 2);
                    const float z0 = __uint_as_float(zz.x << 16), z1 = __uint_as_float(zz.x & 0xffff0000u), z2 = __uint_as_float(zz.y << 16), z3 = __uint_as_float(zz.y & 0xffff0000u);
                    float v0 = z0 * (acc[dt][tt][4 * ap] + bias), v1 = z1 * (acc[dt][tt][4 * ap + 1] + bias), v2 = z2 * (acc[dt][tt][4 * ap + 2] + bias), v3 = z3 * (acc[dt][tt][4 * ap + 3] + bias);
                    acc[dt][tt][4 * ap] = v0; acc[dt][tt][4 * ap + 1] = v1; acc[dt][tt][4 * ap + 2] = v2; acc[dt][tt][4 * ap + 3] = v3;
                    ss += (v0 * v0 + v1 * v1) + (v2 * v2 + v3 * v3);
                }
            ss += __shfl_xor(ss, 32);
            if (h == 0) SSQ2[g * 128 + tl] = ss;
        }
        __syncthreads();
#pragma unroll
        for (int tt = 0; tt < 4; ++tt) {
            const int tl = 32 * tt + r;
            float tot = 0.f;
#pragma unroll
            for (int gg = 0; gg < 8; ++gg) tot += SSQ2[gg * 128 + tl];
            const float rn = rsqrtf(tot * (1.f / 512.f) + EPS);
#pragma unroll
            for (int dt = 0; dt < 2; ++dt)
#pragma unroll
                for (int ap = 0; ap < 4; ++ap) {
                    u32x2 pk; pk.x = cvtpk(acc[dt][tt][4 * ap] * rn, acc[dt][tt][4 * ap + 1] * rn); pk.y = cvtpk(acc[dt][tt][4 * ap + 2] * rn, acc[dt][tt][4 * ap + 3] * rn);
                    *(LAS u32x2*)(tile + tl * G_TSTR + (32 * dt + 8 * ap + 4 * h) * 2) = pk;
                }
        }
        asm volatile("s_waitcnt lgkmcnt(0)" ::: "memory");
#pragma unroll
        for (int it = 0; it < 16; ++it) { const LAS unsigned char* p = tile + ((lane >> 3) + 8 * it) * G_TSTR + (lane & 7) * 16;
            const u32x2 lo = *(const LAS u32x2*)p, hi = *(const LAS u32x2*)(p + 8);
            *(u32x4*)(o + (tok0 + (lane >> 3) + 8 * it) * DM + 512 + g * 64 + (lane & 7) * 8) = (u32x4){lo.x, lo.y, hi.x, hi.y}; }
    }
}

constexpr int BAR_BYTES = (1024 + 8 * 2304) * 4;
__device__ __forceinline__ unsigned xb_ld(unsigned* p) { return __hip_atomic_load(p, __ATOMIC_RELAXED, __HIP_MEMORY_SCOPE_AGENT); }
__device__ __forceinline__ unsigned xb_add(unsigned* p, unsigned v) { return __hip_atomic_fetch_add(p, v, __ATOMIC_RELAXED, __HIP_MEMORY_SCOPE_AGENT); }
__device__ __forceinline__ unsigned xb_xcc_id() { return (unsigned)__builtin_amdgcn_s_getreg((3 << 11) | 20) & 0xFu; }
__device__ __forceinline__ void grid_barrier(unsigned* barw, int k, volatile LAS unsigned* st) {
    asm volatile("s_waitcnt vmcnt(0)" ::: "memory");
    __syncthreads();
    if (threadIdx.x == 0) {
        __builtin_amdgcn_s_waitcnt(0);
        const unsigned x = xb_xcc_id();
        unsigned nloc = st[0], nx = st[1];
        if (nloc == 0u) {
            const unsigned G = gridDim.x;
            for (;;) { unsigned sum = 0u, cnt = 0u, mine = 0u;
#pragma unroll
                for (unsigned j = 0; j < 16; ++j) { const unsigned c = xb_ld(barw + 64 * j); sum += c; cnt += (c > 0u) ? 1u : 0u; mine = (j == x) ? c : mine; }
                if (sum == G) { nloc = mine; nx = cnt; break; }
                __builtin_amdgcn_s_sleep(1); }
            st[0] = nloc; st[1] = nx;
        }
        unsigned* sb = barw + 1024 + k * 2304;
        const unsigned old = xb_add(sb + 64 * x, 1u);
        if (old + 1u == nloc) {
            __builtin_amdgcn_fence(__ATOMIC_RELEASE, "agent");
            asm volatile("s_waitcnt vmcnt(0)" ::: "memory");
            const unsigned og = xb_add(sb + 2048, 1u);
            if (og + 1u == nx) xb_add(sb + 2112, 1u);
            else while (xb_ld(sb + 2112) == 0u) __builtin_amdgcn_s_sleep(1);
            __builtin_amdgcn_fence(__ATOMIC_ACQUIRE, "agent");
            xb_add(sb + 1024 + 64 * x, 1u);
            asm volatile("s_waitcnt vmcnt(0)" ::: "memory");
        } else {
            while (xb_ld(sb + 1024 + 64 * x) == 0u) __builtin_amdgcn_s_sleep(1);
            __builtin_amdgcn_fence(__ATOMIC_ACQUIRE, "agent");
            asm volatile("s_waitcnt vmcnt(0)" ::: "memory");
        }
    }
    __syncthreads();
}

#ifndef N_LAUNCHES
#define N_LAUNCHES 1
#endif
constexpr int NPHASE = 8;
__global__ void __launch_bounds__(NWAVES * 64, 2) fwd_kernel(Args args) {
    extern __shared__ __attribute__((aligned(16))) unsigned char lds_raw[];
    LAS unsigned char* lds = (LAS unsigned char*)lds_raw;
    unsigned char* ws = args.ws;
    const int lo = args.ph_lo, hi = args.ph_hi;
    const int G = gridDim.x;
#define IN(k) (lo <= (k) && (k) < hi)
    unsigned* barw = (unsigned*)ws;
    volatile LAS unsigned* bst = (volatile LAS unsigned*)(lds + LDS_BYTES - 64);
    if (threadIdx.x == 0) { bst[0] = 0u; bst[1] = 0u; (void)xb_add(barw + 64 * xb_xcc_id(), 1u); }
    __syncthreads();
    if (hi > NPHASE) cg::this_grid().sync();
#define SEAM(k) do { if (IN(k) && IN((k) + 1)) { grid_barrier(barw, (k), bst); } } while (0)
    if (IN(0)) { phase0(args, lds); }
    SEAM(0);
    if (IN(1)) {
        pg8::Gemm g{(const bf16_t*)(ws + WS_XB), (const bf16_t*)(ws + WS_WIN), T, NIN, DM, DM, DM};
        pg8::StaticOrder So; So.init(T, NIN, G, (int)blockIdx.x);
        EpiInProj E{(const float*)(ws + WS_RINV1), args.in[3], args.in[4], args.in[8], (const float*)(ws + WS_ROPEC), (const float*)(ws + WS_ROPES),
                    (bf16_t*)(ws + WS_QN), (bf16_t*)(ws + WS_QR), (bf16_t*)(ws + WS_KC), (bf16_t*)(ws + WS_VC), (bf16_t*)(ws + WS_KSL), (bf16_t*)(ws + WS_VSLT),
                    (bf16_t*)(ws + WS_KWN), (bf16_t*)(ws + WS_VWNT), (bf16_t*)(ws + WS_ZU), (bf16_t*)(ws + WS_ZVT), (float*)(ws + WS_GATES)};
        pg8::gemm_phase<EpiInProj, pg8::StaticOrder, true, true>(lds, g, So, E);
    }
    SEAM(1);
    if (IN(2)) {
        pg8::Gemm g{(const bf16_t*)(ws + WS_KC), (const bf16_t*)(ws + WS_W1T), 8192, 512, 512, 1024, 2048};
        if (G >= 256 && blockIdx.x >= 128) {
            const int wave = threadIdx.x >> 6, lane = threadIdx.x & 63;
            LAS float* scr = (LAS float*)(lds + wave * 8704);
            const int gw = ((int)blockIdx.x - 128) * NWAVES + wave, NGW = (G - 128) * NWAVES;
            constexpr int I_O = 16 * 32, I_1 = 16 * 128, I_2 = 64 * 32;
            for (int it = gw; it < I_O + I_1 + I_2; it += NGW) {
                int r = it;
                if (r < I_O) { transpose_item<0>(args.in[12], 1024, 1024, (bf16_t*)(ws + WS_WOUT), args.in[11], scr, r, 32, lane); continue; } r -= I_O;
                if (r < I_1) { transpose_item<0>(args.in[14], 1024, 4096, (bf16_t*)(ws + WS_WFF1), args.in[13], scr, r, 128, lane); continue; } r -= I_1;
                transpose_item<0>(args.in[15], 4096, 1024, (bf16_t*)(ws + WS_WFF2), nullptr, scr, r, 32, lane);
            }
        } else {
            pg8::CmpOrder So{G >= 256 ? 128 : G, (int)blockIdx.x};
            EpiPart E{(float*)(ws + WS_PART)};
            pg8::gemm_phase<EpiPart, pg8::CmpOrder, false, true>(lds, g, So, E);
        }
    }
    SEAM(2);
    if (IN(3)) { phase3(args, lds); }
    SEAM(3);
    if (IN(4)) { phase4_attn(args, lds); phase4_gmlp(args, lds); }
    SEAM(4);
    if (IN(5)) {
        pg8::Gemm g{(const bf16_t*)(ws + WS_O), (const bf16_t*)(ws + WS_WOUT), T, DM, DM, DM, DM};
        pg8::StaticOrder So; So.init(T, DM, G, (int)blockIdx.x);
        EpiWout E{(const bf16_t*)(ws + WS_XB), (bf16_t*)(ws + WS_X2B), (float*)(ws + WS_SSQP), (LAS float*)(lds + 131072)};
        pg8::gemm_phase<EpiWout, pg8::StaticOrder, true, true>(lds, g, So, E);
    }
    SEAM(5);
    if (IN(6)) {
        pg8::Gemm g{(const bf16_t*)(ws + WS_X2B), (const bf16_t*)(ws + WS_WFF1), T, FF, DM, DM, DM};
        pg8::StaticOrder So; So.init(T, FF, G, (int)blockIdx.x);
        EpiFF1 E{(const float*)(ws + WS_SSQP), (bf16_t*)(ws + WS_H)};
        pg8::gemm_phase<EpiFF1, pg8::StaticOrder, true, true>(lds, g, So, E);
    }
    SEAM(6);
    if (IN(7)) {
        pg8::Gemm g{(const bf16_t*)(ws + WS_H), (const bf16_t*)(ws + WS_WFF2), T, DM, FF, FF, FF};
        pg8::StaticOrder So; So.init(T, DM, G, (int)blockIdx.x);
        EpiFF2 E{(const bf16_t*)(ws + WS_X2B), args.out};
        pg8::gemm_phase<EpiFF2, pg8::StaticOrder, true, true>(lds, g, So, E);
    }
#undef IN
#undef SEAM
}

extern "C" void kernel_launch(void* const* d_in, const int* in_sizes, int n_in, void* d_out, int out_size, void* d_ws, size_t ws_size, hipStream_t stream) {
    static int grid = 0;
    if (grid == 0) {
        if (n_in != 16 || out_size != T * DM || ws_size < WS_END) { fprintf(stderr, "kernel_launch: unexpected shapes (n_in %d out %d ws %zu)\n", n_in, out_size, ws_size); grid = -1; return; }
        int dev = 0, cus = 0, per_cu = 0;
        hipGetDevice(&dev); hipDeviceGetAttribute(&cus, hipDeviceAttributeMultiprocessorCount, dev);
        if (hipFuncSetAttribute((const void*)fwd_kernel, hipFuncAttributeMaxDynamicSharedMemorySize, LDS_BYTES) != hipSuccess) { fprintf(stderr, "kernel_launch: hipFuncSetAttribute failed\n"); grid = -1; return; }
        if (hipOccupancyMaxActiveBlocksPerMultiprocessor(&per_cu, (const void*)fwd_kernel, NWAVES * 64, LDS_BYTES) != hipSuccess || per_cu < 1) { fprintf(stderr, "kernel_launch: occupancy query says %d\n", per_cu); per_cu = 1; }
        (void)hipGetLastError();
        grid = cus * per_cu;
        fprintf(stderr, "kernel_launch: grid %d (cus %d x %d)\n", grid, cus, per_cu);
    }
    if (grid < 0) return;
    if (hipMemsetAsync(d_ws, 0, BAR_BYTES, stream) != hipSuccess) { fprintf(stderr, "kernel_launch: memset of the barrier words failed\n"); return; }
    Args a{};
    for (int i = 0; i < 16; ++i) a.in[i] = (const float*)d_in[i];
    a.out = (float*)d_out; a.ws = (unsigned char*)d_ws;
#if N_LAUNCHES == 1
    a.ph_lo = 0; a.ph_hi = NPHASE;
    void* kargs[] = {&a};
    hipError_t e = hipLaunchCooperativeKernel((const void*)fwd_kernel, dim3(grid), dim3(NWAVES * 64), kargs, LDS_BYTES, stream);
    if (e != hipSuccess) fprintf(stderr, "kernel_launch: cooperative launch failed: %s (grid %d)\n", hipGetErrorString(e), grid);
#else
    for (int p = 0; p < NPHASE; ++p) {
        a.ph_lo = p; a.ph_hi = p + 1;
        hipLaunchKernelGGL(fwd_kernel, dim3(grid), dim3(NWAVES * 64), LDS_BYTES, stream, a);
    }
#endif
}
```

```cpp
#include <hip/hip_runtime.h>
#include <hip/hip_cooperative_groups.h>
#include <cstdio>
#include <cstdint>
namespace cg = cooperative_groups;

#define LAS __attribute__((address_space(3)))
typedef unsigned short bf16_t;
typedef unsigned u32x4 __attribute__((ext_vector_type(4)));
typedef float f32x4 __attribute__((ext_vector_type(4)));

namespace pg8 {
#define PG8_LAS __attribute__((address_space(3)))
typedef short bf16x8 __attribute__((ext_vector_type(8)));
constexpr int BM = 256, BK = 64, HALF = 128, HTB = HALF * BK * 2, STAGE_BYTES = 8 * HTB, NXCD = 8, WGM = 4;
__host__ __device__ __forceinline__ int lds_byte(int r, int c) { const int st = (r >> 4) * 2 + (c >> 5), rr = r & 15, cc = c & 31, ob = rr * 64 + cc * 2; return st * 1024 + (ob ^ (((ob >> 9) & 1) << 5)); }
__host__ __device__ __forceinline__ void stage_rc(int b, int& R, int& C) { const int st = b / 1024, sb = b % 1024, swz = sb ^ (((sb >> 9) & 1) << 5); R = (st >> 1) * 16 + swz / 64; C = (st & 1) * 32 + (swz % 64) / 2; }
__host__ __device__ __forceinline__ int perm32(int rho) { const int n = rho >> 4, i = rho & 15; return 8 * (i >> 2) + 4 * n + (i & 3); }
struct Unit { int pm, pn, koff; };
struct Gemm { const bf16_t* A; const bf16_t* Bt; int M, N, K, lda, ldb; };
struct StaticOrder {
    int nM, nN, nwg, G, c;
    __host__ __device__ void init(int M, int N, int G_, int c_) { nM = M / BM; nN = N / BM; nwg = nM * nN; G = G_; c = c_; }
    __host__ __device__ bool next(int i, Unit& u) const {
        const long L = (long)i * G + c; if (L >= nwg) return false;
        int wgid = (int)L; { const int q = nwg / NXCD, r = nwg % NXCD, xcd = wgid % NXCD, off = wgid / NXCD; wgid = (xcd < r ? xcd * (q + 1) : r * (q + 1) + (xcd - r) * q) + off; }
        const int nig = WGM * nN, gid = wgid / nig, fm = gid * WGM, gsz = (nM - fm) < WGM ? (nM - fm) : WGM;
        u.pm = fm + ((wgid % nig) % gsz); u.pn = (wgid % nig) / gsz; u.koff = 0; return true;
    }
    __device__ __forceinline__ void a_ready(const Unit&) const {}
    __device__ __forceinline__ void done(const Unit&) const {}
};
struct CmpOrder {
    int G, c;
    __device__ bool next(int i, Unit& u) const { const long L = (long)i * G + c; if (L >= 128) return false; u.pm = (int)L & 31; u.pn = u.pm >> 4; u.koff = ((int)L >> 5) * 1024; return true; }
    __device__ __forceinline__ void a_ready(const Unit&) const {}
    __device__ __forceinline__ void done(const Unit&) const {}
};
__device__ __forceinline__ unsigned cvt_pk_bf16(float lo, float hi) { unsigned r; asm volatile("v_cvt_pk_bf16_f32 %0, %1, %2" : "=v"(r) : "v"(lo), "v"(hi)); return r; }
template <class Epi, class Sched, bool ALIGN_EPI = false, bool SP2 = false>
__device__ __forceinline__ void gemm_phase(PG8_LAS unsigned char* lds, const Gemm g, const Sched& S, const Epi& E) {
    const int tid = threadIdx.x, wid = __builtin_amdgcn_readfirstlane(tid >> 6), lane = tid & 63, wr = wid >> 2, wc = wid & 3, fr = lane & 15, fq = lane >> 4;
    const int K = g.K, nt = K / BK, lda = g.lda, ldb = g.ldb;
    unsigned voffA[2], voffB[2];
#pragma unroll
    for (int i = 0; i < 2; ++i) { int R, C; stage_rc(tid * 16 + i * 8192, R, C); const int Rb = Epi::PERM ? ((R & ~31) + perm32(R & 31)) : R;
        voffA[i] = (unsigned)(R * lda + C) * 2u; voffB[i] = (unsigned)(Rb * ldb + C) * 2u; }
    const size_t kstep = (size_t)(BK * 2);
    const size_t hstepA = (size_t)HALF * lda * 2, hstepB = (size_t)HALF * ldb * 2;
    const size_t tstepA = 2 * hstepA, tstepB = 2 * hstepB;
    const unsigned ldsw = (unsigned)wid * 1024u;
    const int aoff = lds_byte(wr * 64 + fr, fq * 8), boff = lds_byte(wc * 32 + fr, fq * 8);
#define PG8_SA(b, h) (((b) * 2 + (h)) * HTB)
#define PG8_SB(b, h) ((4 + (b) * 2 + (h)) * HTB)
#define PG8_STAGE(bufoff, gbase, voff) do { _Pragma("unroll") for (int _i = 0; _i < 2; ++_i) \
        __builtin_amdgcn_global_load_lds((const unsigned*)((const char*)(gbase) + (voff)[_i]), (PG8_LAS unsigned*)(lds + (bufoff) + ldsw + _i * 8192), 16, 0, 0); } while (0)
#define PG8_LDA(dst, b, h) do { _Pragma("unroll") for (int m = 0; m < 4; ++m) _Pragma("unroll") for (int k = 0; k < 2; ++k) dst[m][k] = *(const PG8_LAS bf16x8*)(lds + PG8_SA(b, h) + aoff + m * 2048 + k * 1024); } while (0)
#define PG8_LDB(dst, b, h) do { _Pragma("unroll") for (int n = 0; n < 2; ++n) _Pragma("unroll") for (int k = 0; k < 2; ++k) dst[n][k] = *(const PG8_LAS bf16x8*)(lds + PG8_SB(b, h) + boff + n * 2048 + k * 1024); } while (0)
#define PG8_MMA(ai, bj, At, Bt) do { __builtin_amdgcn_s_setprio(1); _Pragma("unroll") for (int m = 0; m < 4; ++m) _Pragma("unroll") for (int n = 0; n < 2; ++n) _Pragma("unroll") for (int k = 0; k < 2; ++k) \
        acc[ai][bj][m][n] = __builtin_amdgcn_mfma_f32_16x16x32_bf16(Bt[n][k], At[m][k], acc[ai][bj][m][n], 0, 0, 0); __builtin_amdgcn_s_setprio(0); } while (0)
#define PG8_WAIT_V(n) asm volatile("s_waitcnt vmcnt(" #n ")" ::: "memory")
#define PG8_WAIT_L(n) asm volatile("s_waitcnt lgkmcnt(" #n ")" ::: "memory")
#define PG8_BAR __builtin_amdgcn_s_barrier()
#define PG8_SCHED __builtin_amdgcn_sched_barrier(0)
    Unit cur, nxt; int ui = 0;
    if (!S.next(0, cur)) return;
    f32x4 acc[2][2][4][2];
#pragma unroll
    for (int a = 0; a < 2; ++a)
#pragma unroll
        for (int b = 0; b < 2; ++b)
#pragma unroll
            for (int m = 0; m < 4; ++m)
#pragma unroll
                for (int n = 0; n < 2; ++n) acc[a][b][m][n] = (f32x4){0.f, 0.f, 0.f, 0.f};
    bf16x8 At[4][2], B0[2][2], B1[2][2];
    const char* cA = (const char*)g.A + (size_t)cur.pm * tstepA + cur.koff; const char* cB = (const char*)g.Bt + (size_t)cur.pn * tstepB + cur.koff;
    S.a_ready(cur);
    if constexpr (SP2) {
        PG8_STAGE(PG8_SB(0, 0), cB, voffB); PG8_STAGE(PG8_SB(0, 1), cB + hstepB, voffB); PG8_STAGE(PG8_SA(0, 0), cA, voffA); PG8_STAGE(PG8_SA(0, 1), cA + hstepA, voffA);
        if (wr == 1) PG8_BAR;
        PG8_WAIT_V(2); PG8_BAR;
        PG8_STAGE(PG8_SB(1, 0), cB + kstep, voffB); PG8_STAGE(PG8_SA(1, 0), cA + kstep, voffA); PG8_STAGE(PG8_SB(1, 1), cB + hstepB + kstep, voffB);
        PG8_WAIT_V(6); PG8_BAR;
    } else {
        PG8_STAGE(PG8_SB(0, 0), cB, voffB); PG8_STAGE(PG8_SA(0, 0), cA, voffA); PG8_STAGE(PG8_SB(0, 1), cB + hstepB, voffB); PG8_STAGE(PG8_SA(0, 1), cA + hstepA, voffA);
        if (wr == 1) PG8_BAR;
        PG8_WAIT_V(4); PG8_BAR;
        PG8_STAGE(PG8_SB(1, 0), cB + kstep, voffB); PG8_STAGE(PG8_SA(1, 0), cA + kstep, voffA); PG8_STAGE(PG8_SB(1, 1), cB + hstepB + kstep, voffB);
        PG8_WAIT_V(6); PG8_BAR;
    }
    for (;;) {
        const bool has_next = S.next(ui + 1, nxt);
        const char* nA = has_next ? (const char*)g.A + (size_t)nxt.pm * tstepA + nxt.koff : cA; const char* nB = has_next ? (const char*)g.Bt + (size_t)nxt.pn * tstepB + nxt.koff : cB;
        for (int t = 0; t < nt; t += 2) {
            const bool last = (t == nt - 2);
            const char* a1 = cA + (size_t)(t + 1) * kstep;
            const char* a2 = last ? nA : cA + (size_t)(t + 2) * kstep; const char* b2 = last ? nB : cB + (size_t)(t + 2) * kstep;
            const char* a3 = a2 + kstep; const char* b3 = b2 + kstep;
            if (last && has_next) S.a_ready(nxt);
            if constexpr (SP2) {
            PG8_LDB(B0, 0, 0); PG8_LDB(B1, 0, 1); PG8_SCHED; PG8_LDA(At, 0, 0); PG8_STAGE(PG8_SA(1, 1), a1 + hstepA, voffA);
            PG8_WAIT_V(8); PG8_WAIT_L(0); PG8_BAR; PG8_MMA(0, 0, At, B0); PG8_MMA(0, 1, At, B1); PG8_BAR; PG8_SCHED;
            PG8_LDA(At, 0, 1); PG8_STAGE(PG8_SB(0, 0), b2, voffB); PG8_STAGE(PG8_SB(0, 1), b2 + hstepB, voffB); PG8_STAGE(PG8_SA(0, 0), a2, voffA);
            PG8_WAIT_V(8); PG8_WAIT_L(0); PG8_BAR; PG8_MMA(1, 0, At, B0); PG8_MMA(1, 1, At, B1); PG8_BAR; PG8_SCHED;
            PG8_LDB(B0, 1, 0); PG8_LDB(B1, 1, 1); PG8_SCHED; PG8_LDA(At, 1, 0); PG8_STAGE(PG8_SA(0, 1), a2 + hstepA, voffA);
            PG8_WAIT_V(8); PG8_WAIT_L(0); PG8_BAR; PG8_MMA(0, 0, At, B0); PG8_MMA(0, 1, At, B1); PG8_BAR; PG8_SCHED;
            PG8_LDA(At, 1, 1); PG8_STAGE(PG8_SB(1, 0), b3, voffB); PG8_STAGE(PG8_SB(1, 1), b3 + hstepB, voffB); PG8_STAGE(PG8_SA(1, 0), a3, voffA);
            PG8_WAIT_V(8); PG8_WAIT_L(0); PG8_BAR; PG8_MMA(1, 0, At, B0); PG8_MMA(1, 1, At, B1); PG8_BAR; PG8_SCHED;
            } else {
            PG8_LDB(B0, 0, 0); PG8_SCHED; PG8_LDA(At, 0, 0); PG8_STAGE(PG8_SA(1, 1), a1 + hstepA, voffA);
            PG8_WAIT_L(8); PG8_BAR; PG8_WAIT_L(0); PG8_MMA(0, 0, At, B0); PG8_BAR; PG8_SCHED;
            PG8_LDB(B1, 0, 1); PG8_STAGE(PG8_SB(0, 0), b2, voffB);
            PG8_BAR; PG8_WAIT_L(0); PG8_MMA(0, 1, At, B1); PG8_BAR;
            PG8_LDA(At, 0, 1); PG8_STAGE(PG8_SA(0, 0), a2, voffA);
            PG8_BAR; PG8_WAIT_L(0); PG8_MMA(1, 0, At, B0); PG8_BAR; PG8_SCHED;
            PG8_STAGE(PG8_SB(0, 1), b2 + hstepB, voffB);
            PG8_WAIT_V(6); PG8_BAR; PG8_MMA(1, 1, At, B1); PG8_BAR;
            PG8_LDB(B0, 1, 0); PG8_SCHED; PG8_LDA(At, 1, 0); PG8_STAGE(PG8_SA(0, 1), a2 + hstepA, voffA);
            PG8_WAIT_L(8); PG8_BAR; PG8_WAIT_L(0); PG8_MMA(0, 0, At, B0); PG8_BAR; PG8_SCHED;
            PG8_LDB(B1, 1, 1); PG8_STAGE(PG8_SB(1, 0), b3, voffB);
            PG8_BAR; PG8_WAIT_L(0); PG8_MMA(0, 1, At, B1); PG8_BAR;
            PG8_LDA(At, 1, 1); PG8_STAGE(PG8_SA(1, 0), a3, voffA);
            PG8_BAR; PG8_WAIT_L(0); PG8_MMA(1, 0, At, B0); PG8_BAR; PG8_SCHED;
            PG8_STAGE(PG8_SB(1, 1), b3 + hstepB, voffB);
            PG8_WAIT_V(6); PG8_BAR; PG8_MMA(1, 1, At, B1); PG8_BAR;
            }
        }
        if constexpr (ALIGN_EPI) { if (wr == 0) PG8_BAR; }
        if constexpr (!Epi::AFTER_DRAIN) { E(acc, cur, wr, wc, fr, fq); S.done(cur); }
        if (!has_next) break;
#pragma unroll
        for (int a = 0; a < 2; ++a)
#pragma unroll
            for (int b = 0; b < 2; ++b)
#pragma unroll
                for (int m = 0; m < 4; ++m)
#pragma unroll
                    for (int n = 0; n < 2; ++n) acc[a][b][m][n] = (f32x4){0.f, 0.f, 0.f, 0.f};
        cur = nxt; cA = nA; cB = nB; ++ui;
        if constexpr (ALIGN_EPI) { if (wr == 1) PG8_BAR; }
    }
    PG8_WAIT_V(0);
    if constexpr (!ALIGN_EPI) { if (wr == 0) PG8_BAR; }
    PG8_BAR;
    if constexpr (Epi::AFTER_DRAIN) { E.fused(acc, cur, wr, wc, fr, fq, lds, wid, lane); S.done(cur); }
#undef PG8_SA
#undef PG8_SB
#undef PG8_STAGE
#undef PG8_LDA
#undef PG8_LDB
#undef PG8_MMA
#undef PG8_WAIT_V
#undef PG8_WAIT_L
#undef PG8_BAR
#undef PG8_SCHED
}
}

constexpr int T = 32768, S = 2048, DM = 1024, NIN = 2560, FF = 4096;
constexpr float EPS = 1e-6f;
constexpr float QSCALE = 0.125f * 1.4426950408889634f;
constexpr size_t MiB = 1u << 20;
constexpr size_t WS_WIN = 1 * MiB, WS_WOUT = 6 * MiB, WS_WFF1 = 8 * MiB, WS_WFF2 = 16 * MiB, WS_W1T = 24 * MiB;
constexpr size_t WS_WSP = 26 * MiB + 768 * 1024;
constexpr size_t WS_C1 = 26 * MiB, WS_ROPEC = 26 * MiB + 64 * 1024, WS_ROPES = 26 * MiB + 320 * 1024;
constexpr size_t WS_RINV1 = 27 * MiB, WS_SSQP = 27 * MiB + 512 * 1024, WS_GATES = 30 * MiB;
constexpr size_t WS_KCMP = 33 * MiB, WS_VCMPT = 33 * MiB + 512 * 1024, WS_HID = 34 * MiB, WS_X2B = 38 * MiB;
constexpr size_t WS_XB = 102 * MiB, WS_QN = 166 * MiB, WS_QR = 198 * MiB, WS_KC = 230 * MiB, WS_VC = 238 * MiB;
constexpr size_t WS_KSL = 246 * MiB, WS_VSLT = 254 * MiB, WS_KWN = 262 * MiB, WS_VWNT = 270 * MiB, WS_ZU = 278 * MiB, WS_ZVT = 310 * MiB, WS_O = 342 * MiB;
constexpr size_t WS_H = 102 * MiB, WS_END = 406 * MiB;
constexpr size_t WS_PART = WS_X2B;
constexpr size_t WS_C1P = 26 * MiB + 576 * 1024;
constexpr int LDS_BYTES = 147456;
constexpr int NWAVES = 8;

struct Args { const float* in[16]; float* out; unsigned char* ws; int ph_lo, ph_hi; };

__device__ __forceinline__ float bf2f(bf16_t h) { return __uint_as_float(((unsigned)h) << 16); }
__device__ __forceinline__ unsigned f2bf(float f) { unsigned u = __float_as_uint(f); return (u + 0x7fffu + ((u >> 16) & 1u)) >> 16; }
__device__ __forceinline__ unsigned pk2(float lo, float hi) { return pg8::cvt_pk_bf16(lo, hi); }
__device__ __forceinline__ float wave_sum(float v) {
#pragma unroll
    for (int o = 1; o < 64; o <<= 1) v += __shfl_xor(v, o);
    return v;
}
__device__ __forceinline__ float wave_max(float v) {
#pragma unroll
    for (int o = 1; o < 64; o <<= 1) v = fmaxf(v, __shfl_xor(v, o));
    return v;
}
__device__ __forceinline__ float gelu_tanh(float x) {
    const float u = 0.7978845608028654f * (x + 0.044715f * x * x * x);
    return x / (1.f + __expf(-2.f * u));
}
__device__ __forceinline__ void store8(bf16_t* p, const float* v) {
    u32x4 w; w.x = pk2(v[0], v[1]); w.y = pk2(v[2], v[3]); w.z = pk2(v[4], v[5]); w.w = pk2(v[6], v[7]);
    *(u32x4*)p = w;
}
__device__ __forceinline__ void load8(const bf16_t* p, float* v) {
    const u32x4 w = *(const u32x4*)p;
    v[0] = __uint_as_float(w.x << 16); v[1] = __uint_as_float(w.x & 0xffff0000u);
    v[2] = __uint_as_float(w.y << 16); v[3] = __uint_as_float(w.y & 0xffff0000u);
    v[4] = __uint_as_float(w.z << 16); v[5] = __uint_as_float(w.z & 0xffff0000u);
    v[6] = __uint_as_float(w.w << 16); v[7] = __uint_as_float(w.w & 0xffff0000u);
}
__device__ __forceinline__ float head_ssq(const float (&v)[16]) {
    float s = 0.f;
#pragma unroll
    for (int i = 0; i < 16; ++i) s += v[i] * v[i];
    s += __shfl_xor(s, 16); s += __shfl_xor(s, 32);
    return s;
}

struct EpiInProj {
    static constexpr bool PERM = true, AFTER_DRAIN = false;
    const float *rinv1, *g_q, *g_k, *g_sgu, *ropec, *ropes;
    bf16_t *qn, *qr, *kc, *vc, *ksl, *vslT, *kwn, *vwnT, *zu, *zvT; float* gates;
    __device__ __forceinline__ void operator()(const f32x4 (&acc)[2][2][4][2], const pg8::Unit& u, int wr, int wc, int fr, int fq) const {
        const int cs = u.pn * 4 + wc;
        if (cs >= 37) return;
        const int d0 = 8 * fq;
        float rsv[2][4];
#pragma unroll
        for (int ai = 0; ai < 2; ++ai)
#pragma unroll
            for (int m = 0; m < 4; ++m) rsv[ai][m] = rinv1[u.pm * 256 + ai * 128 + wr * 64 + m * 16 + fr];
#pragma unroll
        for (int ai = 0; ai < 2; ++ai)
#pragma unroll
            for (int m = 0; m < 4; ++m) {
                const int row = u.pm * 256 + ai * 128 + wr * 64 + m * 16 + fr;
                const float rs = rsv[ai][m];
                float v[16];
#pragma unroll
                for (int bj = 0; bj < 2; ++bj)
#pragma unroll
                    for (int n = 0; n < 2; ++n)
#pragma unroll
                        for (int e = 0; e < 4; ++e) v[bj * 8 + n * 4 + e] = acc[ai][bj][m][n][e] * rs;
                const int b = row >> 11, s = row & 2047;
                if (cs < 8 || cs == 12 || cs == 13 || cs == 16 || cs == 17) {
                    const float* gg = cs < 8 ? g_q : (cs < 14 ? g_k + 64 : g_k + 128);
                    const float rn = rsqrtf(head_ssq(v) * (1.f / 64.f) + EPS) * (cs < 8 ? QSCALE : 1.f);
                    float y[16];
#pragma unroll
                    for (int i = 0; i < 16; ++i) y[i] = v[i] * rn * gg[32 * (i >> 3) + d0 + (i & 7)];
                    float r1[8], r2[8];
#pragma unroll
                    for (int i = 0; i < 8; ++i) { int di = d0 + i; asm volatile("" : "+v"(di));
                        const float frev = __builtin_amdgcn_exp2f(-(float)di * (13.287712379549449f / 32.f)) * 0.15915494309189535f;
                        float xr = (float)s * frev; xr -= __builtin_rintf(xr);
                        const float c = __builtin_amdgcn_cosf(xr), sn = __builtin_amdgcn_sinf(xr); r1[i] = y[i] * c - y[8 + i] * sn; r2[i] = y[8 + i] * c + y[i] * sn; }
                    if (cs < 8) {
                        bf16_t* p = qn + (size_t)row * 512 + cs * 64 + d0; store8(p, y); store8(p + 32, y + 8);
                        bf16_t* p2 = qr + (size_t)row * 512 + cs * 64 + d0; store8(p2, r1); store8(p2 + 32, r2);
                    } else {
                        bf16_t* p = (cs < 14 ? ksl : kwn) + ((size_t)(b * 2 + (cs & 1)) * 2048 + s) * 64 + d0; store8(p, r1); store8(p + 32, r2);
                    }
                } else if (cs < 12) {
                    bf16_t* p = (cs < 10 ? kc : vc) + ((size_t)(b * 2 + (cs & 1)) * 2048 + s) * 64 + d0; store8(p, v); store8(p + 32, v + 8);
                } else if (cs < 20) {
                    bf16_t* p = (cs < 16 ? vslT : vwnT) + ((size_t)(b * 2 + (cs & 1)) * 32 + (s >> 6)) * 4096 + (s & 63);
#pragma unroll
                    for (int i = 0; i < 16; ++i) p[(32 * (i >> 3) + d0 + (i & 7)) * 64] = (bf16_t)f2bf(v[i]);
                } else if (cs < 28) {
                    float y[16];
#pragma unroll
                    for (int i = 0; i < 16; ++i) y[i] = gelu_tanh(v[i]);
                    bf16_t* p = zu + (size_t)row * 512 + (cs - 20) * 64 + d0; store8(p, y); store8(p + 32, y + 8);
                } else if (cs < 36) {
                    const int g = cs - 28;
                    float y[16];
#pragma unroll
                    for (int i = 0; i < 16; ++i) y[i] = gelu_tanh(v[i]);
                    const float rn = rsqrtf(head_ssq(y) * (1.f / 64.f) + EPS);
                    bf16_t* p = zvT + (((size_t)b * 16 + (s >> 7)) * 8 + g) * 8192 + (s & 127);
#pragma unroll
                    for (int i = 0; i < 16; ++i) { const int d = 32 * (i >> 3) + d0 + (i & 7); p[d * 128] = (bf16_t)f2bf(y[i] * rn * g_sgu[g * 64 + d]); }
                } else {
                    if (fq < 3) {
#pragma unroll
                        for (int i = 0; i < 8; ++i) gates[(size_t)row * 24 + d0 + i] = 1.f / (1.f + __expf(-v[i]));
                    }
                }
            }
    }
};

struct EpiPart {
    static constexpr bool PERM = true, AFTER_DRAIN = false;
    float* part;
    __device__ __forceinline__ void operator()(const f32x4 (&acc)[2][2][4][2], const pg8::Unit& u, int wr, int wc, int fr, int fq) const {
        float* base = part + (size_t)(u.koff >> 10) * 8192 * 256;
#pragma unroll
        for (int ai = 0; ai < 2; ++ai)
#pragma unroll
            for (int m = 0; m < 4; ++m) {
                const int row = u.pm * 256 + ai * 128 + wr * 64 + m * 16 + fr;
#pragma unroll
                for (int bj = 0; bj < 2; ++bj) {
                    float* p = base + (size_t)row * 256 + 128 * bj + 32 * wc + 8 * fq;
                    *(f32x4*)p = acc[ai][bj][m][0]; *(f32x4*)(p + 4) = acc[ai][bj][m][1];
                }
            }
    }
};

struct EpiWout {
    static constexpr bool PERM = true, AFTER_DRAIN = false;
    const bf16_t* xb; bf16_t* x2b; float* ssqp; LAS float* red;
    __device__ __forceinline__ void operator()(const f32x4 (&acc)[2][2][4][2], const pg8::Unit& u, int wr, int wc, int fr, int fq) const {
        u32x4 xr[2][4][2];
#pragma unroll
        for (int ai = 0; ai < 2; ++ai)
#pragma unroll
            for (int m = 0; m < 4; ++m)
#pragma unroll
                for (int bj = 0; bj < 2; ++bj)
                    xr[ai][m][bj] = *(const u32x4*)(xb + (size_t)(u.pm * 256 + ai * 128 + wr * 64 + m * 16 + fr) * DM + u.pn * 256 + 128 * bj + 32 * wc + 8 * fq);
        __builtin_amdgcn_sched_barrier(0);
#pragma unroll
        for (int ai = 0; ai < 2; ++ai)
#pragma unroll
            for (int m = 0; m < 4; ++m) {
                const int row = u.pm * 256 + ai * 128 + wr * 64 + m * 16 + fr;
                float ss = 0.f;
#pragma unroll
                for (int bj = 0; bj < 2; ++bj) {
                    const size_t off = (size_t)row * DM + u.pn * 256 + 128 * bj + 32 * wc + 8 * fq;
                    const u32x4 w = xr[ai][m][bj];
                    float y[8];
                    y[0] = __uint_as_float(w.x << 16) + acc[ai][bj][m][0].x; y[1] = __uint_as_float(w.x & 0xffff0000u) + acc[ai][bj][m][0].y;
                    y[2] = __uint_as_float(w.y << 16) + acc[ai][bj][m][0].z; y[3] = __uint_as_float(w.y & 0xffff0000u) + acc[ai][bj][m][0].w;
                    y[4] = __uint_as_float(w.z << 16) + acc[ai][bj][m][1].x; y[5] = __uint_as_float(w.z & 0xffff0000u) + acc[ai][bj][m][1].y;
                    y[6] = __uint_as_float(w.w << 16) + acc[ai][bj][m][1].z; y[7] = __uint_as_float(w.w & 0xffff0000u) + acc[ai][bj][m][1].w;
                    store8(x2b + off, y);
#pragma unroll
                    for (int i = 0; i < 8; ++i) ss += y[i] * y[i];
                }
                ss += __shfl_xor(ss, 16); ss += __shfl_xor(ss, 32);
                if (fq == 0) red[wc * 256 + (row & 255)] = ss;
            }
        __syncthreads();
        { const int tid = threadIdx.x;
          if (tid < 256) ssqp[(size_t)(u.pm * 256 + tid) * 4 + u.pn] = (red[tid] + red[256 + tid]) + (red[512 + tid] + red[768 + tid]); }
    }
};

struct EpiFF1 {
    static constexpr bool PERM = true, AFTER_DRAIN = false;
    const float* ssqp; bf16_t* H;
    __device__ __forceinline__ void operator()(const f32x4 (&acc)[2][2][4][2], const pg8::Unit& u, int wr, int wc, int fr, int fq) const {
        f32x4 sq[2][4];
#pragma unroll
        for (int ai = 0; ai < 2; ++ai)
#pragma unroll
            for (int m = 0; m < 4; ++m) sq[ai][m] = *(const f32x4*)(ssqp + (size_t)(u.pm * 256 + ai * 128 + wr * 64 + m * 16 + fr) * 4);
        __builtin_amdgcn_sched_barrier(0);
#pragma unroll
        for (int ai = 0; ai < 2; ++ai)
#pragma unroll
            for (int m = 0; m < 4; ++m) {
                const int row = u.pm * 256 + ai * 128 + wr * 64 + m * 16 + fr;
                const float tot = (sq[ai][m].x + sq[ai][m].y) + (sq[ai][m].z + sq[ai][m].w);
                const float rn = rsqrtf(tot * (1.f / 1024.f) + EPS);
#pragma unroll
                for (int bj = 0; bj < 2; ++bj) {
                    float y[8];
#pragma unroll
                    for (int n = 0; n < 2; ++n)
#pragma unroll
                        for (int e = 0; e < 4; ++e) { const float h = fmaxf(acc[ai][bj][m][n][e] * rn, 0.f); y[n * 4 + e] = h * h; }
                    store8(H + (size_t)row * FF + u.pn * 256 + 128 * bj + 32 * wc + 8 * fq, y);
                }
            }
    }
};

struct EpiFF2 {
    static constexpr bool PERM = true, AFTER_DRAIN = false;
    const bf16_t* x2b; float* out;
    __device__ __forceinline__ void operator()(const f32x4 (&acc)[2][2][4][2], const pg8::Unit& u, int wr, int wc, int fr, int fq) const {
        u32x4 xr[2][4][2];
#pragma unroll
        for (int ai = 0; ai < 2; ++ai)
#pragma unroll
            for (int m = 0; m < 4; ++m)
#pragma unroll
                for (int bj = 0; bj < 2; ++bj)
                    xr[ai][m][bj] = *(const u32x4*)(x2b + (size_t)(u.pm * 256 + ai * 128 + wr * 64 + m * 16 + fr) * DM + u.pn * 256 + 128 * bj + 32 * wc + 8 * fq);
        __builtin_amdgcn_sched_barrier(0);
#pragma unroll
        for (int ai = 0; ai < 2; ++ai)
#pragma unroll
            for (int m = 0; m < 4; ++m) {
                const int row = u.pm * 256 + ai * 128 + wr * 64 + m * 16 + fr;
#pragma unroll
                for (int bj = 0; bj < 2; ++bj) {
                    const size_t off = (size_t)row * DM + u.pn * 256 + 128 * bj + 32 * wc + 8 * fq;
                    const u32x4 w = xr[ai][m][bj];
                    f32x4 ya = acc[ai][bj][m][0], yb = acc[ai][bj][m][1];
                    ya.x += __uint_as_float(w.x << 16); ya.y += __uint_as_float(w.x & 0xffff0000u); ya.z += __uint_as_float(w.y << 16); ya.w += __uint_as_float(w.y & 0xffff0000u);
                    yb.x += __uint_as_float(w.z << 16); yb.y += __uint_as_float(w.z & 0xffff0000u); yb.z += __uint_as_float(w.w << 16); yb.w += __uint_as_float(w.w & 0xffff0000u);
                    *(f32x4*)(out + off) = ya; *(f32x4*)(out + off + 4) = yb;
                }
            }
    }
};

__device__ __forceinline__ int win_src_col(int nphys) {
    const int pn = nphys >> 8, Pp = nphys & 255, bj = Pp >> 7, wc = (Pp & 127) >> 5, r = Pp & 31;
    const int lc = (pn << 8) + 64 * wc + 32 * bj + r;
    if (lc < 1280) return lc;
    if (lc < 2304) return lc + 24;
    if (lc < 2328) return lc - 1024;
    return -1;
}
template <int MAP>
__device__ __forceinline__ void transpose_item(const float* W, int K, int N, bf16_t* WT, const float* gk, LAS float* scr, int item, int nblk, int lane) {
    const int kb = item / nblk, nb = item % nblk, k0 = 64 * kb, n0 = 32 * nb;
    const int src = MAP ? win_src_col(n0 + (lane & 31)) : n0 + (lane & 31);
    float tv[32];
#pragma unroll
    for (int i = 0; i < 32; ++i) { const int kk = 2 * i + (lane >> 5); tv[i] = (src >= 0) ? __builtin_nontemporal_load(W + (size_t)(k0 + kk) * N + src) : 0.f; }
    if (gk) {
#pragma unroll
        for (int i = 0; i < 32; ++i) tv[i] *= gk[k0 + 2 * i + (lane >> 5)]; }
#pragma unroll
    for (int i = 0; i < 32; ++i) scr[(2 * i + (lane >> 5)) * 33 + (lane & 31)] = tv[i];
    asm volatile("s_waitcnt lgkmcnt(0)" ::: "memory");
    const int c = lane & 7;
#pragma unroll
    for (int j = 0; j < 4; ++j) { const int n = (lane >> 3) + 8 * j; const LAS float* s = scr + (8 * c) * 33 + n;
        u32x4 o; o.x = pk2(s[0 * 33], s[1 * 33]); o.y = pk2(s[2 * 33], s[3 * 33]); o.z = pk2(s[4 * 33], s[5 * 33]); o.w = pk2(s[6 * 33], s[7 * 33]);
        *(u32x4*)(WT + (size_t)(n0 + n) * K + k0 + 8 * c) = o; }
    asm volatile("s_waitcnt lgkmcnt(0)" ::: "memory");
}

__device__ __forceinline__ void phase0(const Args& a, LAS unsigned char* lds) {
    const int tid = threadIdx.x, lane = tid & 63, wave = tid >> 6;
    unsigned char* ws = a.ws;
    LAS float* scr = (LAS float*)(lds + wave * 16384);
    const int gw = blockIdx.x * NWAVES + wave, NGW = gridDim.x * NWAVES;
    constexpr int I_IN = 16 * 80, I_C = 32 * 8;
    constexpr int NITEMS = I_IN + 2 * I_C;
    for (int it = gw; it < NITEMS; it += NGW) {
        int r = it;
        if (r < I_IN) { transpose_item<1>(a.in[2], 1024, 2328, (bf16_t*)(ws + WS_WIN), a.in[1], scr, r, 80, lane); continue; } r -= I_IN;
        if (r < I_C) { transpose_item<0>(a.in[6], 2048, 256, (bf16_t*)(ws + WS_W1T), nullptr, scr, r, 8, lane); continue; } r -= I_C;
        transpose_item<0>(a.in[6] + (size_t)2048 * 256, 2048, 256, (bf16_t*)(ws + WS_W1T) + (size_t)256 * 2048, nullptr, scr, r, 8, lane);
    }
    {
        const float* x = a.in[0]; bf16_t* xb = (bf16_t*)(ws + WS_XB); float* rinv1 = (float*)(ws + WS_RINV1);
        for (int m = gw; m < T; m += 2 * NGW) {
            const int m2 = m + NGW;
            const bool has2 = m2 < T;
            const f32x4* xr = (const f32x4*)(x + (size_t)m * DM) + lane;
            const f32x4* xr2 = (const f32x4*)(x + (size_t)(has2 ? m2 : m) * DM) + lane;
            f32x4 v[4], u[4]; float s = 0.f, s2 = 0.f;
#pragma unroll
            for (int j = 0; j < 4; ++j) { v[j] = __builtin_nontemporal_load(xr + 64 * j); u[j] = __builtin_nontemporal_load(xr2 + 64 * j); }
#pragma unroll
            for (int j = 0; j < 4; ++j) { s += (v[j].x * v[j].x + v[j].y * v[j].y) + (v[j].z * v[j].z + v[j].w * v[j].w); s2 += (u[j].x * u[j].x + u[j].y * u[j].y) + (u[j].z * u[j].z + u[j].w * u[j].w); }
            s = wave_sum(s); s2 = wave_sum(s2);
            if (lane == 0) { rinv1[m] = rsqrtf(s * (1.f / 1024.f) + EPS); if (has2) rinv1[m2] = rsqrtf(s2 * (1.f / 1024.f) + EPS); }
            unsigned long long* o8 = (unsigned long long*)(xb + (size_t)m * DM) + lane;
#pragma unroll
            for (int j = 0; j < 4; ++j) o8[64 * j] = (unsigned long long)pk2(v[j].x, v[j].y) | ((unsigned long long)pk2(v[j].z, v[j].w) << 32);
            if (has2) { unsigned long long* o82 = (unsigned long long*)(xb + (size_t)m2 * DM) + lane;
#pragma unroll
                for (int j = 0; j < 4; ++j) o82[64 * j] = (unsigned long long)pk2(u[j].x, u[j].y) | ((unsigned long long)pk2(u[j].z, u[j].w) << 32); }
        }
    }
    {
        bf16_t* Wsp = (bf16_t*)(ws + WS_WSP); const float* spw = a.in[9];
        for (int idx = blockIdx.x * 512 + tid; idx < 8 * 128 * 128; idx += gridDim.x * 512) { const int tq = (idx >> 7) & 127, sq = idx & 127; Wsp[idx] = (bf16_t)f2bf(sq <= tq ? spw[idx] : 0.f); }
    }
    {
        if ((gw & 3) == 0 && (gw >> 2) < 512) {
            const int item = gw >> 2, kv = item >> 8, cg4 = (item >> 6) & 3, kch = item & 63;
            const float* pe = a.in[5] + kv * 2048 + kch * 32; const float* w1 = a.in[6] + ((size_t)kv * 2048 + kch * 32) * 256 + cg4 * 64 + lane;
            float wv[32];
#pragma unroll
            for (int k = 0; k < 32; ++k) wv[k] = __builtin_nontemporal_load(w1 + (size_t)k * 256);
            float acc = 0.f;
#pragma unroll
            for (int k = 0; k < 32; ++k) acc += pe[k] * wv[k];
            ((float*)(ws + WS_C1P))[kch * 512 + kv * 256 + cg4 * 64 + lane] = acc;
        }
    }
}

__device__ __forceinline__ void phase3(const Args& a, LAS unsigned char* lds) {
    const int tid = threadIdx.x, lane = tid & 63, wave = tid >> 6;
    unsigned char* ws = a.ws;
    const float* part = (const float*)(ws + WS_PART); const float* c1p = (const float*)(ws + WS_C1P);
    bf16_t* kcmp = (bf16_t*)(ws + WS_KCMP); bf16_t* vcmpT = (bf16_t*)(ws + WS_VCMPT);
    LAS float* w2s = (LAS float*)lds;
    LAS float* c1s = w2s + 256 * 64;
    LAS float* hids = c1s + 256;
    const int nchunk = 8192 / 32;
    for (int item = blockIdx.x; item < nchunk; item += gridDim.x) {
        const int kv = (item * 32) >> 12;
        __syncthreads();
        { const f32x4* src = (const f32x4*)(a.in[7] + (size_t)kv * 256 * 64);
#pragma unroll
          for (int i = 0; i < 8; ++i) ((LAS f32x4*)w2s)[tid + 512 * i] = src[tid + 512 * i]; }
        if (tid < 256) { float t = 0.f;
#pragma unroll
            for (int kch = 0; kch < 64; ++kch) t += c1p[kch * 512 + kv * 256 + tid];
            c1s[tid] = t; }
        __syncthreads();
#pragma unroll 1
        for (int rr = 0; rr < 4; ++rr) {
            const int R = item * 32 + wave * 4 + rr, bh = (R >> 7) & 31, n = R & 127;
            f32x4 h4 = *(const LAS f32x4*)(c1s + 4 * lane);
#pragma unroll
            for (int kc = 0; kc < 4; ++kc) h4 += *(const f32x4*)(part + ((size_t)kc * 8192 + R) * 256 + 4 * lane);
            h4.x = gelu_tanh(h4.x); h4.y = gelu_tanh(h4.y); h4.z = gelu_tanh(h4.z); h4.w = gelu_tanh(h4.w);
            *(LAS f32x4*)(hids + wave * 256 + 4 * lane) = h4;
            asm volatile("s_waitcnt lgkmcnt(0)" ::: "memory");
            float acc = 0.f;
#pragma unroll 8
            for (int c = 0; c < 256; ++c) acc += hids[wave * 256 + c] * w2s[c * 64 + lane];
            if (kv == 0) {
                const float ss = wave_sum(acc * acc);
                const float y = acc * rsqrtf(ss * (1.f / 64.f) + EPS) * a.in[4][lane];
                kcmp[((size_t)bh * 128 + n) * 64 + lane] = (bf16_t)f2bf(n < 127 ? y : 0.f);
            } else {
                vcmpT[((size_t)bh * 64 + lane) * 128 + n] = (bf16_t)f2bf(n < 127 ? acc : 0.f);
            }
        }
    }
    if (gridDim.x < 256) {
        LAS float* scr = (LAS float*)(lds + 77824 + wave * 8704);
        const int gw = blockIdx.x * NWAVES + wave, NGW = gridDim.x * NWAVES;
        constexpr int I_O = 16 * 32, I_1 = 16 * 128, I_2 = 64 * 32;
        for (int it = gw; it < I_O + I_1 + I_2; it += NGW) {
            int r = it;
            if (r < I_O) { transpose_item<0>(a.in[12], 1024, 1024, (bf16_t*)(ws + WS_WOUT), a.in[11], scr, r, 32, lane); continue; } r -= I_O;
            if (r < I_1) { transpose_item<0>(a.in[14], 1024, 4096, (bf16_t*)(ws + WS_WFF1), a.in[13], scr, r, 128, lane); continue; } r -= I_1;
            transpose_item<0>(a.in[15], 4096, 1024, (bf16_t*)(ws + WS_WFF2), nullptr, scr, r, 32, lane);
        }
    }
}

typedef short bf16x8_t __attribute__((ext_vector_type(8)));
typedef short s16x4_t __attribute__((ext_vector_type(4)));
typedef float f32x16 __attribute__((ext_vector_type(16)));
typedef __bf16 bf16x2_t __attribute__((ext_vector_type(2)));
typedef float f32x2_t __attribute__((ext_vector_type(2)));
typedef unsigned u32x2 __attribute__((ext_vector_type(2)));
#define MFMA32(a, b, c) __builtin_amdgcn_mfma_f32_32x32x16_bf16((a), (b), (c), 0, 0, 0)
__device__ __forceinline__ unsigned cvtpk(float lo, float hi) { f32x2_t v = {lo, hi}; bf16x2_t b = __builtin_convertvector(v, bf16x2_t); return __builtin_bit_cast(unsigned, b); }
__device__ __forceinline__ float ex2(float x) { return __builtin_amdgcn_exp2f(x); }
__device__ __forceinline__ f32x16 zero16() { f32x16 z;
#pragma unroll
    for (int i = 0; i < 16; ++i) z[i] = 0.f; return z; }
__device__ __forceinline__ bf16x8_t pack8(const f32x16& x, int s8) {
    u32x4 w; w.x = cvtpk(x[s8 + 0], x[s8 + 1]); w.y = cvtpk(x[s8 + 2], x[s8 + 3]); w.z = cvtpk(x[s8 + 4], x[s8 + 5]); w.w = cvtpk(x[s8 + 6], x[s8 + 7]);
    return __builtin_bit_cast(bf16x8_t, w);
}
constexpr int A_KSTR = 144, A_VSTR = 136, A_CVSTR = 264, A_IMPSTR = 33;
constexpr int A_KT = 128 * A_KSTR, A_VT = 64 * A_CVSTR;
constexpr int A_KBUF = 0, A_VBUF = 2 * A_KT, A_CMPK = A_VBUF + 2 * A_VT, A_CMPV = A_CMPK + 18432, A_IMP = A_CMPV + 16896, A_SELM = A_IMP + 4 * 64 * A_IMPSTR * 4, A_SSQ = A_SELM + 256, A_END = A_SSQ + 4096;
static_assert(A_END <= LDS_BYTES - 64, "attention LDS map");

template <int MODE>
__device__ __forceinline__ void attn_tile(const LAS unsigned char* Kb, const LAS unsigned char* Vb, const bf16x8_t (&qf)[4], f32x16 (&oacc)[2], float& l_run,
                                          int r, int h, int dlt0, int dlt1, bool hiw) {
    const unsigned ulim = (MODE == 0) ? 0x80000000u : 512u;
    float ls = 0.f;
#pragma unroll
    for (int mt = 0; mt < 4; ++mt) {
        if (mt == 0) { if (hiw) __builtin_amdgcn_s_setprio(1); else __builtin_amdgcn_s_setprio(0); }
        if (mt == 2) { if (hiw) __builtin_amdgcn_s_setprio(0); else __builtin_amdgcn_s_setprio(1); }
        const int dl = mt < 2 ? dlt0 : dlt1;
        f32x16 sacc = zero16();
#pragma unroll
        for (int ks = 0; ks < 4; ++ks) { const bf16x8_t ka = *(const LAS bf16x8_t*)(Kb + (32 * mt + r) * A_KSTR + 32 * ks + 16 * h); sacc = MFMA32(ka, qf[ks], sacc); }
#pragma unroll
        for (int i = 0; i < 16; ++i) {
            float p;
            if (MODE == 2) p = ex2(sacc[i]);
            else if (MODE == 3) p = ex2(sacc[i] + __int_as_float(dl));
            else { const int ci = 32 * mt + (i & 3) + 8 * (i >> 2); p = ((unsigned)(dl - ci) < ulim) ? ex2(sacc[i]) : 0.f; }
            sacc[i] = p; ls += p;
        }
#pragma unroll
        for (int s = 0; s < 2; ++s) {
            const bf16x8_t pf = pack8(sacc, 8 * s);
#pragma unroll
            for (int dt = 0; dt < 2; ++dt) {
                const LAS unsigned char* vp = Vb + (32 * dt + r) * A_CVSTR + (32 * mt + 16 * s + 4 * h) * 2;
                const s16x4_t lo = *(const LAS s16x4_t*)vp, hi = *(const LAS s16x4_t*)(vp + 16);
                oacc[dt] = MFMA32(__builtin_shufflevector(lo, hi, 0, 1, 2, 3, 4, 5, 6, 7), pf, oacc[dt]);
            }
        }
    }
    l_run += ls;
}

__device__ __forceinline__ void phase4_attn(const Args& a, LAS unsigned char* lds) {
    const int tid0 = threadIdx.x, w = __builtin_amdgcn_readfirstlane(tid0 >> 6), g = w >> 1, half = w & 1;
    unsigned char* ws = a.ws;
    const bf16_t* qn = (const bf16_t*)(ws + WS_QN); const bf16_t* qr = (const bf16_t*)(ws + WS_QR);
    const bf16_t* kcmp = (const bf16_t*)(ws + WS_KCMP); const bf16_t* vcmpT = (const bf16_t*)(ws + WS_VCMPT);
    const bf16_t* ksl = (const bf16_t*)(ws + WS_KSL); const bf16_t* vslT = (const bf16_t*)(ws + WS_VSLT);
    const bf16_t* kwn = (const bf16_t*)(ws + WS_KWN); const bf16_t* vwnT = (const bf16_t*)(ws + WS_VWNT);
    const float* gates = (const float*)(ws + WS_GATES);
    bf16_t* o = (bf16_t*)(ws + WS_O);
    LAS float* IMP = (LAS float*)(lds + A_IMP); LAS unsigned* SELM = (LAS unsigned*)(lds + A_SELM); LAS float* SSQ = (LAS float*)(lds + A_SSQ);
    for (int pr = blockIdx.x; pr < 256; pr += gridDim.x) {
        const int b = pr >> 4, tt0 = pr & 15;
#pragma unroll 1
        for (int it = 0; it < 2; ++it) {
            const int t = it ? 31 - tt0 : tt0;
            f32x16 comb[2][2];
#pragma unroll
            for (int hkv = 0; hkv < 2; ++hkv) {
                const int bh = b * 2 + hkv, head = hkv * 4 + g;
                int tid = tid0; asm volatile("" : "+v"(tid));
                const int lane = tid & 63, r = lane & 31, h = lane >> 5, ql = 32 * half + r, pos = 64 * t + ql, tok = b * 2048 + pos;
                comb[hkv][0] = zero16(); comb[hkv][1] = zero16();
                const float g0 = gates[(size_t)tok * 24 + head * 3 + 0], g1 = gates[(size_t)tok * 24 + head * 3 + 1], g2 = gates[(size_t)tok * 24 + head * 3 + 2];
                __syncthreads();
                {
                    const bf16_t* kc = kcmp + (size_t)bh * 128 * 64; const bf16_t* vc = vcmpT + (size_t)bh * 64 * 128;
#pragma unroll
                    for (int i = 0; i < 2; ++i) { const int c = tid + 512 * i;
                        const u32x4 kv = *(const u32x4*)(kc + (size_t)c * 8);
                        *(LAS u32x4*)(lds + A_CMPK + (c >> 3) * A_KSTR + (c & 7) * 16) = kv;
                        const u32x4 vv = *(const u32x4*)(vc + (size_t)c * 8);
                        LAS unsigned char* vp = lds + A_CMPV + (c >> 4) * A_CVSTR + (c & 15) * 16;
                        *(LAS u32x2*)vp = (u32x2){vv.x, vv.y}; *(LAS u32x2*)(vp + 8) = (u32x2){vv.z, vv.w}; }
                }
                bf16x8_t qf[4];
#pragma unroll
                for (int ks = 0; ks < 4; ++ks) qf[ks] = __builtin_nontemporal_load((const bf16x8_t*)(qn + (size_t)tok * 512 + head * 64 + 16 * ks + 8 * h));
                __syncthreads();
                {
                    f32x16 s4[4];
#pragma unroll
                    for (int mt = 0; mt < 4; ++mt) { s4[mt] = zero16();
#pragma unroll
                        for (int ks = 0; ks < 4; ++ks) { const bf16x8_t ka = *(const LAS bf16x8_t*)(lds + A_CMPK + (32 * mt + r) * A_KSTR + 32 * ks + 16 * h); s4[mt] = MFMA32(ka, qf[ks], s4[mt]); } }
                    const int clim = (pos - 31 - 64 * h) >> 4;
                    float ls = 0.f;
#pragma unroll
                    for (int mt = 0; mt < 4; ++mt)
#pragma unroll
                        for (int i = 0; i < 16; ++i) { const int ci = 32 * mt + (i & 3) + 8 * (i >> 2);
                            const float p = (ci <= clim) ? ex2(s4[mt][i]) : 0.f; s4[mt][i] = p; ls += p; }
                    ls += __shfl_xor(ls, 32);
                    const float inv = 1.f / fmaxf(ls, 1e-20f);
#pragma unroll
                    for (int mt = 0; mt < 4; ++mt) s4[mt] *= inv;
                    if (t >= 16) {
                        float oprev = 0.f;
#pragma unroll
                        for (int idx = 0; idx < 16; ++idx) {
                            const int mt = idx >> 2, ap = idx & 3;
                            const float tail = 0.5f * s4[mt][4 * ap + 3];
                            const float ot = __shfl_xor(tail, 32);
                            const float inner = s4[mt][4 * ap] + s4[mt][4 * ap + 1] + s4[mt][4 * ap + 2] + tail;
                            const float prev = h ? ot : oprev;
                            oprev = ot;
                            IMP[(g * 64 + ql) * A_IMPSTR + 8 * mt + 2 * ap + h] = inner + prev;
                        }
                    }
                    f32x16 oc[2]; oc[0] = zero16(); oc[1] = zero16();
#pragma unroll
                    for (int mt = 0; mt < 4; ++mt)
#pragma unroll
                        for (int s = 0; s < 2; ++s) {
                            const bf16x8_t pf = pack8(s4[mt], 8 * s);
#pragma unroll
                            for (int dt = 0; dt < 2; ++dt) {
                                const LAS unsigned char* vp = lds + A_CMPV + (32 * dt + r) * A_CVSTR + (32 * mt + 16 * s + 4 * h) * 2;
                                const s16x4_t lo = *(const LAS s16x4_t*)vp, hi = *(const LAS s16x4_t*)(vp + 16);
                                oc[dt] = MFMA32(__builtin_shufflevector(lo, hi, 0, 1, 2, 3, 4, 5, 6, 7), pf, oc[dt]);
                            }
                        }
                    comb[hkv][0] += oc[0] * g0; comb[hkv][1] += oc[1] * g0;
                }
                if (t >= 16) {
                    __syncthreads();
                    const int qloc = tid >> 3, jg = tid & 7;
                    unsigned bits = 0u;
                    float xe[4]; int cnt[4];
#pragma unroll
                    for (int e = 0; e < 4; ++e) { const int j = 4 * jg + e; const LAS float* ip = IMP + qloc * A_IMPSTR + j;
                        float x = (ip[0] + ip[64 * A_IMPSTR]) + (ip[128 * A_IMPSTR] + ip[192 * A_IMPSTR]);
                        if (j == 0 || j == t || j == t - 1) x = 1e9f;
                        if (j > t) x = -INFINITY;
                        xe[e] = x; cnt[e] = 0; }
#pragma unroll 4
                    for (int i = 0; i < 32; ++i) { const LAS float* ip = IMP + qloc * A_IMPSTR + i;
                        float vi = (ip[0] + ip[64 * A_IMPSTR]) + (ip[128 * A_IMPSTR] + ip[192 * A_IMPSTR]);
                        if (i == 0 || i == t || i == t - 1) vi = 1e9f;
                        if (i > t) vi = -INFINITY;
#pragma unroll
                        for (int e = 0; e < 4; ++e) cnt[e] += (vi > xe[e] || (vi == xe[e] && i < 4 * jg + e)) ? 1 : 0; }
#pragma unroll
                    for (int e = 0; e < 4; ++e) if (cnt[e] < 16 && xe[e] > -INFINITY) bits |= 1u << (4 * jg + e);
                    bits |= __shfl_xor(bits, 1); bits |= __shfl_xor(bits, 2); bits |= __shfl_xor(bits, 4);
                    if (jg == 0) SELM[qloc] = bits;
                    __syncthreads();
                }
                const unsigned selw = (t >= 16) ? SELM[ql] : ((2u << t) - 1u);
#pragma unroll
                for (int ks = 0; ks < 4; ++ks) qf[ks] = __builtin_nontemporal_load((const bf16x8_t*)(qr + (size_t)tok * 512 + head * 64 + 16 * ks + 8 * h));
                const int kt_lo = t >= 8 ? t - 8 : 0, wlo = kt_lo >> 1, n_sel = (t >> 1) + 1, n_all = n_sel + ((t >> 1) - wlo + 1);
                const bf16_t* Ks = ksl + (size_t)bh * 2048 * 64; const bf16_t* Vs = vslT + (size_t)bh * 64 * 2048;
                const bf16_t* Kw = kwn + (size_t)bh * 2048 * 64; const bf16_t* Vw = vwnT + (size_t)bh * 64 * 2048;
#define A_ISSUE(idx) do { const int i1_ = (idx); const bool sel1_ = i1_ < n_sel; const int st1_ = sel1_ ? i1_ : wlo + (i1_ - n_sel); \
        int tv_ = tid; asm volatile("" : "+v"(tv_)); \
        const bf16_t* Kg_ = (sel1_ ? Ks : Kw) + (size_t)st1_ * 8192; const bf16_t* Vg_ = (sel1_ ? Vs : Vw) + (size_t)st1_ * 8192; \
        kR0 = *(const u32x4*)(Kg_ + (size_t)tv_ * 8); kR1 = *(const u32x4*)(Kg_ + (size_t)(tv_ + 512) * 8); \
        vR0 = *(const u32x4*)(Vg_ + (size_t)tv_ * 8); vR1 = *(const u32x4*)(Vg_ + (size_t)(tv_ + 512) * 8); } while (0)
#define A_STAGE(bufi) do { int tv_ = tid; asm volatile("" : "+v"(tv_)); \
        LAS unsigned char* kp_ = lds + A_KBUF + (bufi) * A_KT + (tv_ >> 3) * A_KSTR + (tv_ & 7) * 16; \
        *(LAS u32x4*)kp_ = kR0; *(LAS u32x4*)(kp_ + 64 * A_KSTR) = kR1; \
        LAS unsigned char* vp_ = lds + A_VBUF + (bufi) * A_VT + (tv_ >> 3) * A_CVSTR + (tv_ & 7) * 16; \
        *(LAS u32x2*)vp_ = (u32x2){vR0.x, vR0.y}; *(LAS u32x2*)(vp_ + 8) = (u32x2){vR0.z, vR0.w}; \
        *(LAS u32x2*)(vp_ + 128) = (u32x2){vR1.x, vR1.y}; *(LAS u32x2*)(vp_ + 136) = (u32x2){vR1.z, vR1.w}; } while (0)
                u32x4 kR0, kR1, vR0, vR1;
                A_ISSUE(0);
                A_STAGE(0);
                __syncthreads();
                f32x16 oacc[2]; oacc[0] = zero16(); oacc[1] = zero16();
                float l_run = 0.f;
#pragma unroll 1
                for (int i = 0; i < n_all; ++i) {
                    const int bufo = i & 1;
                    if (i + 1 < n_all) A_ISSUE(i + 1);
                    const LAS unsigned char* Kb = lds + A_KBUF + bufo * A_KT; const LAS unsigned char* Vb = lds + A_VBUF + bufo * A_VT;
                    const bool issel = i < n_sel;
                    const int st = issel ? i : wlo + (i - n_sel);
                    const int dlt = 64 * t + ql - 128 * st - 4 * h;
                    if (issel) {
                        const bool b0 = (selw >> (2 * st)) & 1u, b1 = (selw >> (2 * st + 1)) & 1u;
                        if (__ballot(b0 || b1) != 0ull) {
                            if (2 * st + 1 < t) {
                                if (__ballot(b0 && b1) == ~0ull) attn_tile<2>(Kb, Vb, qf, oacc, l_run, r, h, dlt, dlt, (w & 4) != 0);
                                else attn_tile<3>(Kb, Vb, qf, oacc, l_run, r, h, __float_as_int(b0 ? 0.f : -1e30f), __float_as_int(b1 ? 0.f : -1e30f), (w & 4) != 0);
                            } else attn_tile<0>(Kb, Vb, qf, oacc, l_run, r, h, b0 ? dlt : -1, b1 ? dlt : -1, (w & 4) != 0);
                        }
                    } else {
                        if (2 * st > t - 8 && 2 * st + 1 < t) attn_tile<2>(Kb, Vb, qf, oacc, l_run, r, h, dlt, dlt, (w & 4) != 0);
                        else attn_tile<1>(Kb, Vb, qf, oacc, l_run, r, h, dlt, dlt, (w & 4) != 0);
                    }
                    if (i == n_sel - 1 || i == n_all - 1) { const float lt = l_run + __shfl_xor(l_run, 32); const float sc = ((i == n_sel - 1) ? g1 : g2) / fmaxf(lt, 1e-20f);
                        comb[hkv][0] += oacc[0] * sc; comb[hkv][1] += oacc[1] * sc; oacc[0] = zero16(); oacc[1] = zero16(); l_run = 0.f; }
                    if (i + 1 < n_all) A_STAGE(bufo ^ 1);
                    __syncthreads();
                }
#undef A_ISSUE
#undef A_STAGE
            }
            int tid = tid0; asm volatile("" : "+v"(tid));
            const int lane = tid & 63, r = lane & 31, h = lane >> 5, ql = 32 * half + r, pos = 64 * t + ql, tok = b * 2048 + pos;
            float ss = 0.f;
#pragma unroll
            for (int hkv = 0; hkv < 2; ++hkv)
#pragma unroll
                for (int dt = 0; dt < 2; ++dt)
#pragma unroll
                    for (int i = 0; i < 16; ++i) ss += comb[hkv][dt][i] * comb[hkv][dt][i];
            ss += __shfl_xor(ss, 32);
            if (h == 0) SSQ[w * 32 + r] = ss;
            __syncthreads();
            const float tot = (SSQ[(half + 0) * 32 + r] + SSQ[(half + 2) * 32 + r]) + (SSQ[(half + 4) * 32 + r] + SSQ[(half + 6) * 32 + r]);
            const float rn = rsqrtf(tot * (1.f / 512.f) + EPS);
#pragma unroll
            for (int hkv = 0; hkv < 2; ++hkv)
#pragma unroll
                for (int dt = 0; dt < 2; ++dt)
#pragma unroll
                    for (int ap = 0; ap < 4; ++ap) {
                        u32x2 pk; pk.x = cvtpk(comb[hkv][dt][4 * ap] * rn, comb[hkv][dt][4 * ap + 1] * rn); pk.y = cvtpk(comb[hkv][dt][4 * ap + 2] * rn, comb[hkv][dt][4 * ap + 3] * rn);
                        *(u32x2*)(o + (size_t)tok * DM + (hkv * 4 + g) * 64 + 32 * dt + 8 * ap + 4 * h) = pk;
                    }
        }
    }
}

constexpr int G_TSTR = 136, G_TILE = 128 * G_TSTR, G_SSQ = 8 * G_TILE;
static_assert(G_SSQ + 8 * 128 * 4 <= LDS_BYTES - 64, "gMLP LDS map");
__device__ __forceinline__ void phase4_gmlp(const Args& a, LAS unsigned char* lds) {
    const int tid0 = threadIdx.x, g = __builtin_amdgcn_readfirstlane(tid0 >> 6);
    unsigned char* ws = a.ws;
    const bf16_t* zu = (const bf16_t*)(ws + WS_ZU); const bf16_t* zvT = (const bf16_t*)(ws + WS_ZVT); const bf16_t* Wsp = (const bf16_t*)(ws + WS_WSP);
    const float* sp_b = a.in[10];
    bf16_t* o = (bf16_t*)(ws + WS_O);
    LAS float* SSQ2 = (LAS float*)(lds + G_SSQ);
    LAS unsigned char* tile = lds + g * G_TILE;
    for (int item = blockIdx.x; item < 256; item += gridDim.x) {
        const int b = item >> 4, ch = item & 15;
        const size_t tok0 = (size_t)b * 2048 + ch * 128;
        int tid = tid0; asm volatile("" : "+v"(tid));
        const int lane = tid & 63, r = lane & 31, h = lane >> 5;
        __syncthreads();
        bf16x8_t zf[2][8];
#pragma unroll
        for (int dt = 0; dt < 2; ++dt)
#pragma unroll
            for (int ks = 0; ks < 8; ++ks) zf[dt][ks] = *(const bf16x8_t*)(zvT + ((((size_t)b * 16 + ch) * 8 + g) * 64 + 32 * dt + r) * 128 + 16 * ks + 8 * h);
        f32x16 acc[2][4];
#pragma unroll
        for (int tt = 0; tt < 4; ++tt) { acc[0][tt] = zero16(); acc[1][tt] = zero16();
            __builtin_amdgcn_sched_barrier(0);
#pragma unroll
            for (int ks = 0; ks < 2 * tt + 2; ++ks) {
                const bf16x8_t wf = *(const bf16x8_t*)(Wsp + ((size_t)g * 128 + 32 * tt + r) * 128 + 16 * ks + 8 * h);
                acc[0][tt] = MFMA32(zf[0][ks], wf, acc[0][tt]); acc[1][tt] = MFMA32(zf[1][ks], wf, acc[1][tt]);
            } }
        __builtin_amdgcn_sched_barrier(0);
#pragma unroll
        for (int hb = 0; hb < 2; ++hb) {
            u32x4 zr[8];
#pragma unroll
            for (int it = 0; it < 8; ++it) zr[it] = __builtin_nontemporal_load((const u32x4*)(zu + (tok0 + (lane >> 3) + 8 * (8 * hb + it)) * 512 + g * 64 + (lane & 7) * 8));
#pragma unroll
            for (int it = 0; it < 8; ++it) { LAS unsigned char* p = tile + ((lane >> 3) + 8 * (8 * hb + it)) * G_TSTR + (lane & 7) * 16;
                *(LAS u32x2*)p = (u32x2){zr[it].x, zr[it].y}; *(LAS u32x2*)(p + 8) = (u32x2){zr[it].z, zr[it].w}; }
        }
        asm volatile("s_waitcnt lgkmcnt(0)" ::: "memory");
#pragma unroll
        for (int tt = 0; tt < 4; ++tt) {
            const int tl = 32 * tt + r;
            const float bias = sp_b[g * 128 + tl];
            float ss = 0.f;
#pragma unroll
            for (int dt = 0; dt < 2; ++dt)
#pragma unroll
                for (int ap = 0; ap < 4; ++ap) {
                    const u32x2 zz = *(const LAS u32x2*)(tile + tl * G_TSTR + (32 * dt + 8 * ap + 4 * h) * 2);
                    const float z0 = __uint_as_float(zz.x << 16), z1 = __uint_as_float(zz.x & 0xffff0000u), z2 = __uint_as_float(zz.y << 16), z3 = __uint_as_float(zz.y & 0xffff0000u);
                    float v0 = z0 * (acc[dt][tt][4 * ap] + bias), v1 = z1 * (acc[dt][tt][4 * ap + 1] + bias), v2 = z2 * (acc[dt][tt][4 * ap + 2] + bias), v3 = z3 * (acc[dt][tt][4 * ap + 3] + bias);
                    acc[dt][tt][4 * ap] = v0; acc[dt][tt][4 * ap + 1] = v1; acc[dt][tt][4 * ap + 2] = v2; acc[dt][tt][4 * ap + 3] = v3;
                    ss += (v0 * v0 + v1 * v1) + (v2 * v2 + v3 * v3);
                }
            ss += __shfl_xor(ss, 32);
            if (h == 0) SSQ2[g * 128 + tl] = ss;
        }
        __syncthreads();
#pragma unroll
        for (int tt = 0; tt < 4; ++tt) {
            const int tl = 32 * tt + r;
            float tot = 0.f;
#pragma unroll
            for (int gg = 0; gg < 8; ++gg) tot += SSQ2[gg * 128 + tl];
            const float rn = rsqrtf(tot * (1.f / 512.f) + EPS);
#pragma unroll
            for (int dt = 0; dt < 2; ++dt)
#pragma unroll
                for (int ap = 0; ap < 4; ++ap) {
                    u32x2 pk; pk.x = cvtpk(acc[dt][tt][4 * ap] * rn, acc[dt][tt][4 * ap + 1] * rn); pk.y = cvtpk(acc[dt][tt][4 * ap + 2] * rn, acc[dt][tt][4 * ap + 3] * rn);
                    *(LAS u32x2*)(tile + tl * G_TSTR + (32 * dt + 8 * ap + 4 * h) * 2) = pk;
                }
        }
        asm volatile("s_waitcnt lgkmcnt(0)" ::: "memory");
#pragma unroll
        for (int it = 0; it < 16; ++it) { const LAS unsigned char* p = tile + ((lane >> 3) + 8 * it) * G_TSTR + (lane & 7) * 16;
            const u32x2 lo = *(const LAS u32x2*)p, hi = *(const LAS u32x2*)(p + 8);
            *(u32x4*)(o + (tok0 + (lane >> 3) + 8 * it) * DM + 512 + g * 64 + (lane & 7) * 8) = (u32x4){lo.x, lo.y, hi.x, hi.y}; }
    }
}

constexpr int BAR_BYTES = (1024 + 8 * 2304) * 4;
__device__ __forceinline__ unsigned xb_ld(unsigned* p) { return __hip_atomic_load(p, __ATOMIC_RELAXED, __HIP_MEMORY_SCOPE_AGENT); }
__device__ __forceinline__ unsigned xb_add(unsigned* p, unsigned v) { return __hip_atomic_fetch_add(p, v, __ATOMIC_RELAXED, __HIP_MEMORY_SCOPE_AGENT); }
__device__ __forceinline__ unsigned xb_xcc_id() { return (unsigned)__builtin_amdgcn_s_getreg((3 << 11) | 20) & 0xFu; }
__device__ __forceinline__ void grid_barrier(unsigned* barw, int k, volatile LAS unsigned* st) {
    asm volatile("s_waitcnt vmcnt(0)" ::: "memory");
    __syncthreads();
    if (threadIdx.x == 0) {
        __builtin_amdgcn_s_waitcnt(0);
        const unsigned x = xb_xcc_id();
        unsigned nloc = st[0], nx = st[1];
        if (nloc == 0u) {
            const unsigned G = gridDim.x;
            for (;;) { unsigned sum = 0u, cnt = 0u, mine = 0u;
#pragma unroll
                for (unsigned j = 0; j < 16; ++j) { const unsigned c = xb_ld(barw + 64 * j); sum += c; cnt += (c > 0u) ? 1u : 0u; mine = (j == x) ? c : mine; }
                if (sum == G) { nloc = mine; nx = cnt; break; }
                __builtin_amdgcn_s_sleep(1); }
            st[0] = nloc; st[1] = nx;
        }
        unsigned* sb = barw + 1024 + k * 2304;
        const unsigned old = xb_add(sb + 64 * x, 1u);
        if (old + 1u == nloc) {
            __builtin_amdgcn_fence(__ATOMIC_RELEASE, "agent");
            asm volatile("s_waitcnt vmcnt(0)" ::: "memory");
            const unsigned og = xb_add(sb + 2048, 1u);
            if (og + 1u == nx) xb_add(sb + 2112, 1u);
            else while (xb_ld(sb + 2112) == 0u) __builtin_amdgcn_s_sleep(1);
            __builtin_amdgcn_fence(__ATOMIC_ACQUIRE, "agent");
            xb_add(sb + 1024 + 64 * x, 1u);
            asm volatile("s_waitcnt vmcnt(0)" ::: "memory");
        } else {
            while (xb_ld(sb + 1024 + 64 * x) == 0u) __builtin_amdgcn_s_sleep(1);
            __builtin_amdgcn_fence(__ATOMIC_ACQUIRE, "agent");
            asm volatile("s_waitcnt vmcnt(0)" ::: "memory");
        }
    }
    __syncthreads();
}

#ifndef N_LAUNCHES
#define N_LAUNCHES 1
#endif
constexpr int NPHASE = 8;
__global__ void __launch_bounds__(NWAVES * 64, 2) fwd_kernel(Args args) {
    extern __shared__ __attribute__((aligned(16))) unsigned char lds_raw[];
    LAS unsigned char* lds = (LAS unsigned char*)lds_raw;
    unsigned char* ws = args.ws;
    const int lo = args.ph_lo, hi = args.ph_hi;
    const int G = gridDim.x;
#define IN(k) (lo <= (k) && (k) < hi)
    unsigned* barw = (unsigned*)ws;
    volatile LAS unsigned* bst = (volatile LAS unsigned*)(lds + LDS_BYTES - 64);
    if (threadIdx.x == 0) { bst[0] = 0u; bst[1] = 0u; (void)xb_add(barw + 64 * xb_xcc_id(), 1u); }
    __syncthreads();
    if (hi > NPHASE) cg::this_grid().sync();
#define SEAM(k) do { if (IN(k) && IN((k) + 1)) { grid_barrier(barw, (k), bst); } } while (0)
    if (IN(0)) { phase0(args, lds); }
    SEAM(0);
    if (IN(1)) {
        pg8::Gemm g{(const bf16_t*)(ws + WS_XB), (const bf16_t*)(ws + WS_WIN), T, NIN, DM, DM, DM};
        pg8::StaticOrder So; So.init(T, NIN, G, (int)blockIdx.x);
        EpiInProj E{(const float*)(ws + WS_RINV1), args.in[3], args.in[4], args.in[8], (const float*)(ws + WS_ROPEC), (const float*)(ws + WS_ROPES),
                    (bf16_t*)(ws + WS_QN), (bf16_t*)(ws + WS_QR), (bf16_t*)(ws + WS_KC), (bf16_t*)(ws + WS_VC), (bf16_t*)(ws + WS_KSL), (bf16_t*)(ws + WS_VSLT),
                    (bf16_t*)(ws + WS_KWN), (bf16_t*)(ws + WS_VWNT), (bf16_t*)(ws + WS_ZU), (bf16_t*)(ws + WS_ZVT), (float*)(ws + WS_GATES)};
        pg8::gemm_phase<EpiInProj, pg8::StaticOrder, true, true>(lds, g, So, E);
    }
    SEAM(1);
    if (IN(2)) {
        pg8::Gemm g{(const bf16_t*)(ws + WS_KC), (const bf16_t*)(ws + WS_W1T), 8192, 512, 512, 1024, 2048};
        if (G >= 256 && blockIdx.x >= 128) {
            const int wave = threadIdx.x >> 6, lane = threadIdx.x & 63;
            LAS float* scr = (LAS float*)(lds + wave * 8704);
            const int gw = ((int)blockIdx.x - 128) * NWAVES + wave, NGW = (G - 128) * NWAVES;
            constexpr int I_O = 16 * 32, I_1 = 16 * 128, I_2 = 64 * 32;
            for (int it = gw; it < I_O + I_1 + I_2; it += NGW) {
                int r = it;
                if (r < I_O) { transpose_item<0>(args.in[12], 1024, 1024, (bf16_t*)(ws + WS_WOUT), args.in[11], scr, r, 32, lane); continue; } r -= I_O;
                if (r < I_1) { transpose_item<0>(args.in[14], 1024, 4096, (bf16_t*)(ws + WS_WFF1), args.in[13], scr, r, 128, lane); continue; } r -= I_1;
                transpose_item<0>(args.in[15], 4096, 1024, (bf16_t*)(ws + WS_WFF2), nullptr, scr, r, 32, lane);
            }
        } else {
            pg8::CmpOrder So{G >= 256 ? 128 : G, (int)blockIdx.x};
            EpiPart E{(float*)(ws + WS_PART)};
            pg8::gemm_phase<EpiPart, pg8::CmpOrder, false, true>(lds, g, So, E);
        }
    }
    SEAM(2);
    if (IN(3)) { phase3(args, lds); }
    SEAM(3);
    if (IN(4)) { phase4_attn(args, lds); phase4_gmlp(args, lds); }
    SEAM(4);
    if (IN(5)) {
        pg8::Gemm g{(const bf16_t*)(ws + WS_O), (const bf16_t*)(ws + WS_WOUT), T, DM, DM, DM, DM};
        pg8::StaticOrder So; So.init(T, DM, G, (int)blockIdx.x);
        EpiWout E{(const bf16_t*)(ws + WS_XB), (bf16_t*)(ws + WS_X2B), (float*)(ws + WS_SSQP), (LAS float*)(lds + 131072)};
        pg8::gemm_phase<EpiWout, pg8::StaticOrder, true, true>(lds, g, So, E);
    }
    SEAM(5);
    if (IN(6)) {
        pg8::Gemm g{(const bf16_t*)(ws + WS_X2B), (const bf16_t*)(ws + WS_WFF1), T, FF, DM, DM, DM};
        pg8::StaticOrder So; So.init(T, FF, G, (int)blockIdx.x);
        EpiFF1 E{(const float*)(ws + WS_SSQP), (bf16_t*)(ws + WS_H)};
        pg8::gemm_phase<EpiFF1, pg8::StaticOrder, true, true>(lds, g, So, E);
    }
    SEAM(6);
    if (IN(7)) {
        pg8::Gemm g{(const bf16_t*)(ws + WS_H), (const bf16_t*)(ws + WS_WFF2), T, DM, FF, FF, FF};
        pg8::StaticOrder So; So.init(T, DM, G, (int)blockIdx.x);
        EpiFF2 E{(const bf16_t*)(ws + WS_X2B), args.out};
        pg8::gemm_phase<EpiFF2, pg8::StaticOrder, true, true>(lds, g, So, E);
    }
#undef IN
#undef SEAM
}

extern "C" void kernel_launch(void* const* d_in, const int* in_sizes, int n_in, void* d_out, int out_size, void* d_ws, size_t ws_size, hipStream_t stream) {
    static int grid = 0;
    if (grid == 0) {
        if (n_in != 16 || out_size != T * DM || ws_size < WS_END) { fprintf(stderr, "kernel_launch: unexpected shapes (n_in %d out %d ws %zu)\n", n_in, out_size, ws_size); grid = -1; return; }
        int dev = 0, cus = 0, per_cu = 0;
        hipGetDevice(&dev); hipDeviceGetAttribute(&cus, hipDeviceAttributeMultiprocessorCount, dev);
        if (hipFuncSetAttribute((const void*)fwd_kernel, hipFuncAttributeMaxDynamicSharedMemorySize, LDS_BYTES) != hipSuccess) { fprintf(stderr, "kernel_launch: hipFuncSetAttribute failed\n"); grid = -1; return; }
        if (hipOccupancyMaxActiveBlocksPerMultiprocessor(&per_cu, (const void*)fwd_kernel, NWAVES * 64, LDS_BYTES) != hipSuccess || per_cu < 1) { fprintf(stderr, "kernel_launch: occupancy query says %d\n", per_cu); per_cu = 1; }
        (void)hipGetLastError();
        grid = cus * per_cu;
        fprintf(stderr, "kernel_launch: grid %d (cus %d x %d)\n", grid, cus, per_cu);
    }
    if (grid < 0) return;
    if (hipMemsetAsync(d_ws, 0, BAR_BYTES, stream) != hipSuccess) { fprintf(stderr, "kernel_launch: memset of the barrier words failed\n"); return; }
    Args a{};
    for (int i = 0; i < 16; ++i) a.in[i] = (const float*)d_in[i];
    a.out = (float*)d_out; a.ws = (unsigned char*)d_ws;
#if N_LAUNCHES == 1
    a.ph_lo = 0; a.ph_hi = NPHASE;
    void* kargs[] = {&a};
    hipError_t e = hipLaunchCooperativeKernel((const void*)fwd_kernel, dim3(grid), dim3(NWAVES * 64), kargs, LDS_BYTES, stream);
    if (e != hipSuccess) fprintf(stderr, "kernel_launch: cooperative launch failed: %s (grid %d)\n", hipGetErrorString(e), grid);
#else
    for (int p = 0; p < NPHASE; ++p) {
        a.ph_lo = p; a.ph_hi = p + 1;
        hipLaunchKernelGGL(fwd_kernel, dim3(grid), dim3(NWAVES * 64), LDS_BYTES, stream, a);
    }
#endif
}
```
